# Optimizing an MI355X kernel written in HIP

```python
import jax
import jax.numpy as jnp
from jax import lax
import numpy as np

D_MODEL = 2048
BATCH = 8
SEQ = 2048
DEPTH = 1

GRID_W = 64
CTX_LEN = 256
MIX_GROUP = D_MODEL // 2
HEADS = 8
HEAD_DIM = MIX_GROUP // HEADS
N_PARTS = 8
P_QN, P_KN, P_VN, P_QH, P_FF, P_FB, P_IH, P_GH = range(N_PARTS)
WIN_R = 8
WIN_C = 16
Q_COLS = 16
K_COLS = 32
CHUNK = 64
ROPE_THETA = 10000.0
N_EXPERTS = 32
TOP_K = 4
MOE_FF = D_MODEL
SWIGLU_LIMIT = 7.0
SWIGLU_ALPHA = 1.702
MOE_BLOCK = 128
EPS = 1e-6

kernel_name = 'hybrid_natten_hgrn2_moe_block'


def rms_norm(x, gain):
    xf = x.astype(jnp.float32)
    y = xf * lax.rsqrt(jnp.mean(xf * xf, axis=-1, keepdims=True) + EPS)
    return (y * gain.astype(jnp.float32)).astype(x.dtype)


def modulate(h, shift, scale):
    return h * (1.0 + scale) + shift


def flip(a):
    return jnp.flip(a, axis=1)


def in_proj(h, w_in, parts):
    w = w_in.reshape(w_in.shape[0], N_PARTS, MIX_GROUP)[:, np.asarray(parts)]
    p = jnp.einsum('bld,dpe->pble', h, w)
    b, l = h.shape[0], h.shape[1]
    return {name: p[i].reshape(b, l, HEADS, HEAD_DIM) for i, name in enumerate(parts)}


def axial_rope_angles(l):
    t = jnp.arange(l)
    n_freq = HEAD_DIM // 4
    inv_freq = ROPE_THETA ** (-jnp.arange(n_freq, dtype=jnp.float32) / n_freq)
    ang_row = (t // GRID_W).astype(jnp.float32)[:, None] * inv_freq
    ang_col = (t % GRID_W).astype(jnp.float32)[:, None] * inv_freq
    return ang_row, ang_col


def rotate(x, ang):
    half = x.shape[-1] // 2
    cos = jnp.cos(ang)[:, None, :]
    sin = jnp.sin(ang)[:, None, :]
    x1, x2 = x[..., :half], x[..., half:]
    return jnp.concatenate([x1 * cos - x2 * sin, x2 * cos + x1 * sin], axis=-1)


def axial_rope(x, ang_row, ang_col):
    half = x.shape[-1] // 2
    return jnp.concatenate([rotate(x[..., :half], ang_row), rotate(x[..., half:], ang_col)], axis=-1)


def neighborhood_attention(q, k, v, k_ctx, v_ctx, rpb):
    b, l, h, dh = q.shape
    rows = l // GRID_W
    kr = min(WIN_R, rows)
    ncb = GRID_W // Q_COLS
    r = np.arange(rows)
    key_rows = np.clip(r - kr // 2, 0, rows - kr)[:, None] + np.arange(kr)
    kc0 = np.clip(np.arange(ncb) * Q_COLS - WIN_C // 2, 0, GRID_W - K_COLS)
    key_cols = kc0[:, None] + np.arange(K_COLS)
    nk = kr * K_COLS
    key_idx = (key_rows[:, None, :, None] * GRID_W + key_cols[None, :, None, :]).reshape(rows, ncb, nk)
    kg = k[:, key_idx]
    vg = v[:, key_idx]
    qb = q.reshape(b, rows, ncb, Q_COLS, h, dh)
    scale = dh ** -0.5
    s_win = jnp.einsum('brjqhd,brjkhd->bhrjqk', qb, kg).astype(jnp.float32) * scale
    q_cols = np.arange(GRID_W).reshape(ncb, Q_COLS)
    col_start = np.clip(q_cols - WIN_C // 2, 0, GRID_W - WIN_C)
    kcol = np.tile(key_cols, (1, kr))
    krow = np.repeat(key_rows, K_COLS, axis=1)
    in_win = (kcol[:, None, :] >= col_start[:, :, None]) & (kcol[:, None, :] < col_start[:, :, None] + WIN_C)
    d_row = krow - r[:, None] + WIN_R - 1
    d_col = np.clip(kcol[:, None, :] - q_cols[:, :, None] + WIN_C - 1, 0, 2 * WIN_C - 2)
    bias = rpb[:, d_row[:, None, None, :], d_col[None, :, :, :]].astype(jnp.float32)
    s_win = jnp.where(in_win[None, None, None], s_win + bias[None], -jnp.inf)
    s_ctx = jnp.einsum('brjqhd,bchd->bhrjqc', qb, k_ctx).astype(jnp.float32) * scale
    p = jax.nn.softmax(jnp.concatenate([s_win, s_ctx], axis=-1), axis=-1).astype(v.dtype)
    o = (jnp.einsum('bhrjqk,brjkhd->brjqhd', p[..., :nk], vg)
         + jnp.einsum('bhrjqc,bchd->brjqhd', p[..., nk:], v_ctx))
    return o.reshape(b, l, h, dh)


def context_attention(q, k, v):
    s = jnp.einsum('bqhd,bkhd->bhqk', q, k).astype(jnp.float32) * (q.shape[-1] ** -0.5)
    p = jax.nn.softmax(s, axis=-1).astype(v.dtype)
    return jnp.einsum('bhqk,bkhd->bqhd', p, v)


def forget_gate(f_raw, lb):
    f_raw = f_raw.astype(jnp.float32)
    log_f = jnp.log(lb + (1.0 - lb) * jax.nn.sigmoid(f_raw))
    key = (1.0 - lb) * jax.nn.sigmoid(-f_raw)
    return log_f, key


def gla_chunk_scan(q, k, v, g, s0):
    b, l, h, dk = q.shape
    dv = v.shape[-1]
    n = l // CHUNK
    mask = jnp.tril(jnp.ones((CHUNK, CHUNK), dtype=bool))[None, :, :, None, None]

    def to_chunks(a):
        return jnp.moveaxis(a.reshape(b, n, CHUNK, h, a.shape[-1]), 1, 0)

    def step(s, inp):
        qc, kc, vc, gc = inp
        cum = jnp.cumsum(gc, axis=1)
        cum_last = cum[:, -1]
        o_inter = jnp.einsum('bthk,bhkv->bthv', qc * jnp.exp(cum), s)
        decay = jnp.exp(jnp.where(mask, cum[:, :, None] - cum[:, None, :], -jnp.inf))
        att = jnp.sum(qc[:, :, None] * kc[:, None] * decay, axis=-1)
        o_intra = jnp.einsum('btsh,bshv->bthv', att, vc)
        k_dec = kc * jnp.exp(cum_last[:, None] - cum)
        s_new = jnp.exp(cum_last)[..., None] * s + jnp.einsum('bshk,bshv->bhkv', k_dec, vc)
        return s_new, o_inter + o_intra

    s_final, o = lax.scan(step, s0, (to_chunks(q), to_chunks(k), to_chunks(v), to_chunks(g)))
    return jnp.moveaxis(o, 0, 1).reshape(b, l, h, dv), s_final


def gla_final_state(k, v, g):
    cum = jnp.cumsum(g, axis=1)
    return jnp.einsum('blhk,blhv->bhkv', k * jnp.exp(cum[:, -1:] - cum), v)


def hgrn2_output(o, gate, gain, dtype):
    return (rms_norm(o, gain) * jax.nn.silu(gate.astype(jnp.float32))).astype(dtype)


def hybrid_mixer(hx, hc, w_in, lb, hg_gain, rpb, w_out, ang_row, ang_col, with_ctx_out):
    b, l, _ = hx.shape
    px = in_proj(hx, w_in, tuple(range(N_PARTS)))
    ctx_parts = tuple(range(N_PARTS)) if with_ctx_out else (P_KN, P_VN, P_FF, P_FB, P_IH)
    pc = in_proj(hc, w_in, ctx_parts)
    o_na = neighborhood_attention(px[P_QN], px[P_KN], px[P_VN], pc[P_KN], pc[P_VN], rpb)
    lb_f, lb_b = lb.reshape(2, HEADS, HEAD_DIM)
    gf_c, kf_c = forget_gate(pc[P_FF], lb_f)
    gb_c, kb_c = forget_gate(pc[P_FB], lb_b)
    v_c = pc[P_IH].astype(jnp.float32)
    if with_ctx_out:
        q_c = pc[P_QH].astype(jnp.float32)
        zero = jnp.zeros((b, HEADS, HEAD_DIM, HEAD_DIM), jnp.float32)
        oc_f, s_f = gla_chunk_scan(q_c, kf_c, v_c, gf_c, zero)
        oc_b, s_b = gla_chunk_scan(flip(q_c), flip(kb_c), flip(v_c), flip(gb_c), zero)
        oc_hg = oc_f + flip(oc_b)
    else:
        s_f = gla_final_state(kf_c, v_c, gf_c)
        s_b = gla_final_state(flip(kb_c), flip(v_c), flip(gb_c))
    gf, kf = forget_gate(px[P_FF], lb_f)
    gb, kb = forget_gate(px[P_FB], lb_b)
    q_x = axial_rope(px[P_QH].astype(jnp.float32), ang_row, ang_col)
    kf = axial_rope(kf, ang_row, ang_col)
    kb = axial_rope(kb, ang_row, ang_col)
    v_x = px[P_IH].astype(jnp.float32)
    o_f, _ = gla_chunk_scan(q_x, kf, v_x, gf, s_f)
    o_b, _ = gla_chunk_scan(flip(q_x), flip(kb), flip(v_x), flip(gb), s_b)
    o_hg = hgrn2_output(o_f + flip(o_b), px[P_GH], hg_gain, hx.dtype)
    y = jnp.concatenate([o_na.reshape(b, l, MIX_GROUP), o_hg.reshape(b, l, MIX_GROUP)], axis=-1) @ w_out
    if not with_ctx_out:
        return y, None
    lc = hc.shape[1]
    oc_na = context_attention(pc[P_QN], pc[P_KN], pc[P_VN])
    oc_hg = hgrn2_output(oc_hg, pc[P_GH], hg_gain, hc.dtype)
    yc = jnp.concatenate([oc_na.reshape(b, lc, MIX_GROUP), oc_hg.reshape(b, lc, MIX_GROUP)], axis=-1) @ w_out
    return y, yc


def moe_ffn(h, w_router, b_router, w_gu, b_gu, w_down, b_down):
    t, d = h.shape
    logits = (h @ w_router + b_router).astype(jnp.float32)
    top_val, top_idx = lax.top_k(logits, TOP_K)
    gate = jax.nn.softmax(top_val, axis=-1)
    a = t * TOP_K
    exp_flat = top_idx.reshape(a)
    order = jnp.argsort(exp_flat)
    e_sorted = exp_flat[order]
    tok_sorted = (order // TOP_K).astype(jnp.int32)
    w_sorted = gate.reshape(a)[order].astype(h.dtype)
    counts = jnp.bincount(exp_flat, length=N_EXPERTS)
    padded = (counts + MOE_BLOCK - 1) // MOE_BLOCK * MOE_BLOCK
    start = jnp.cumsum(counts) - counts
    pad_end = jnp.cumsum(padded)
    pad_start = pad_end - padded
    dest = pad_start[e_sorted] + (jnp.arange(a) - start[e_sorted])
    n_blocks = -(-(a + N_EXPERTS * (MOE_BLOCK - 1)) // MOE_BLOCK)
    cap = n_blocks * MOE_BLOCK
    slot_tok = jnp.full((cap,), t, jnp.int32).at[dest].set(tok_sorted)
    slot_w = jnp.zeros((cap,), h.dtype).at[dest].set(w_sorted)
    block_exp = jnp.minimum(jnp.searchsorted(pad_end, jnp.arange(n_blocks) * MOE_BLOCK, side='right'), N_EXPERTS - 1)
    h_pad = jnp.concatenate([h, jnp.zeros((1, d), h.dtype)], axis=0)
    xb = h_pad[slot_tok].reshape(n_blocks, MOE_BLOCK, d)

    def expert_block(args):
        xe, e = args
        gu = xe @ w_gu[e] + b_gu[e]
        x_glu = jnp.minimum(gu[:, :MOE_FF], SWIGLU_LIMIT)
        x_lin = jnp.clip(gu[:, MOE_FF:], -SWIGLU_LIMIT, SWIGLU_LIMIT)
        y = x_glu * jax.nn.sigmoid(SWIGLU_ALPHA * x_glu) * (x_lin + 1.0)
        return y @ w_down[e] + b_down[e]

    yb = lax.map(expert_block, (xb, block_exp)).reshape(cap, d)
    out = jnp.zeros((t + 1, d), h.dtype).at[slot_tok].add(yb * slot_w[:, None])
    return out[:t]


def setup_inputs(seed: int = 0) -> dict:
    key = jax.random.key(seed)
    ks = jax.random.split(key, 20)
    d = D_MODEL

    def nrm(k, shape, s):
        return jax.random.normal(k, shape, jnp.float32) * s

    return {
        'x': nrm(ks[0], (BATCH, SEQ, d), 1.0),
        'c': nrm(ks[1], (BATCH, d), 1.0),
        'ctx': nrm(ks[2], (BATCH, CTX_LEN, d), 1.0),
        'c_ctx': nrm(ks[3], (d,), 1.0),
        'w_ada': nrm(ks[4], (DEPTH, d, 6 * d), 0.5 * d ** -0.5),
        'b_ada': nrm(ks[5], (DEPTH, 6 * d), 0.02),
        'norm_mix': 1.0 + nrm(ks[6], (DEPTH, d), 0.02),
        'norm_ffn': 1.0 + nrm(ks[7], (DEPTH, d), 0.02),
        'w_in': nrm(ks[8], (DEPTH, d, N_PARTS * MIX_GROUP), d ** -0.5),
        'lb_table': nrm(ks[9], (DEPTH + 1, 2 * MIX_GROUP), 0.5),
        'hg_norm': 1.0 + nrm(ks[10], (DEPTH, HEAD_DIM), 0.02),
        'rpb': nrm(ks[11], (DEPTH, HEADS, 2 * WIN_R - 1, 2 * WIN_C - 1), 0.02),
        'w_out': nrm(ks[12], (DEPTH, 2 * MIX_GROUP, d), (2 * MIX_GROUP) ** -0.5),
        'w_router': nrm(ks[13], (DEPTH, d, N_EXPERTS), d ** -0.5),
        'b_router': nrm(ks[14], (DEPTH, N_EXPERTS), 0.01),
        'w_gu': nrm(ks[15], (DEPTH, N_EXPERTS, d, 2 * MOE_FF), d ** -0.5),
        'b_gu': nrm(ks[16], (DEPTH, N_EXPERTS, 2 * MOE_FF), 0.01),
        'w_down': nrm(ks[17], (DEPTH, N_EXPERTS, MOE_FF, d), MOE_FF ** -0.5),
        'b_down': nrm(ks[18], (DEPTH, N_EXPERTS, d), 0.01),
        'norm_final': 1.0 + nrm(ks[19], (d,), 0.02),
    }


def reference(x, c, ctx, c_ctx, w_ada, b_ada, norm_mix, norm_ffn, w_in, lb_table, hg_norm, rpb,
              w_out, w_router, b_router, w_gu, b_gu, w_down, b_down, norm_final):
    b, l, d = x.shape
    lc = ctx.shape[1]
    ang_row, ang_col = axial_rope_angles(l)
    lower_bounds = jnp.cumsum(jax.nn.softmax(lb_table.astype(jnp.float32), axis=0), axis=0)
    cond = jax.nn.silu(c)
    cond_ctx = jax.nn.silu(c_ctx)
    h_ctx = ctx
    for layer in range(DEPTH):
        last = layer == DEPTH - 1
        mod = cond @ w_ada[layer] + b_ada[layer]
        sh1, sc1, g1, sh2, sc2, g2 = jnp.split(mod[:, None, :], 6, axis=-1)
        n_ctx_mod = 2 if last else 6
        mod_ctx = jnp.split(cond_ctx @ w_ada[layer][:, :n_ctx_mod * d] + b_ada[layer][:n_ctx_mod * d], n_ctx_mod)
        hx = modulate(rms_norm(x, norm_mix[layer]), sh1, sc1)
        hc = modulate(rms_norm(h_ctx, norm_mix[layer]), mod_ctx[0], mod_ctx[1])
        y, yc = hybrid_mixer(hx, hc, w_in[layer], lower_bounds[layer], hg_norm[layer], rpb[layer],
                             w_out[layer], ang_row, ang_col, not last)
        x = x + g1 * y
        hx = modulate(rms_norm(x, norm_ffn[layer]), sh2, sc2)
        moe_params = (w_router[layer], b_router[layer], w_gu[layer], b_gu[layer], w_down[layer], b_down[layer])
        if last:
            x = x + g2 * moe_ffn(hx.reshape(b * l, d), *moe_params).reshape(b, l, d)
        else:
            h_ctx = h_ctx + mod_ctx[2] * yc
            hc = modulate(rms_norm(h_ctx, norm_ffn[layer]), mod_ctx[3], mod_ctx[4])
            tokens = jnp.concatenate([hc.reshape(b * lc, d), hx.reshape(b * l, d)], axis=0)
            out = moe_ffn(tokens, *moe_params)
            h_ctx = h_ctx + mod_ctx[5] * out[:b * lc].reshape(b, lc, d)
            x = x + g2 * out[b * lc:].reshape(b, l, d)
    return rms_norm(x, norm_final)
```

```cpp
#include <hip/hip_runtime.h>
#include <cstdio>
#include <cstdint>
namespace pg8 {
#define PG8_LAS __attribute__((address_space(3)))
typedef unsigned short bf16_t;
typedef short bf16x8 __attribute__((ext_vector_type(8)));
typedef float f32x4 __attribute__((ext_vector_type(4)));
typedef unsigned u32x4 __attribute__((ext_vector_type(4)));
constexpr int BM = 256, BK = 64, HALF = 128, HTB = HALF * BK * 2  , STAGE_BYTES = 8 * HTB, NXCD = 8, WGM = 8;

__host__ __device__ __forceinline__ int lds_byte(int r, int c) { const int st = (r >> 4) * 2 + (c >> 5), rr = r & 15, cc = c & 31, ob = rr * 64 + cc * 2; return st * 1024 + (ob ^ (((ob >> 9) & 1) << 5)); }
__host__ __device__ __forceinline__ void stage_rc(int b, int& R, int& C) { const int st = b / 1024, sb = b % 1024, swz = sb ^ (((sb >> 9) & 1) << 5); R = (st >> 1) * 16 + swz / 64; C = (st & 1) * 32 + (swz % 64) / 2; }
__host__ __device__ __forceinline__ int perm32(int rho) { const int n = rho >> 4, i = rho & 15; return 8 * (i >> 2) + 4 * n + (i & 3); }

struct Unit { int pm, pn; };
struct Gemm { const bf16_t* A; const bf16_t* Bt; int M, N, K; };

struct StaticOrder {
    int nM, nN, nwg, G, c;
    __host__ __device__ void init(int M, int N, int G_, int c_) { nM = M / BM; nN = N / BM; nwg = nM * nN; G = G_; c = c_; }
    __host__ __device__ bool next(int i, Unit& u) const {
        const long L = (long)i * G + c; if (L >= nwg) return false;
        int wgid = (int)L; { const int q = nwg / NXCD, r = nwg % NXCD, xcd = wgid % NXCD, off = wgid / NXCD; wgid = (xcd < r ? xcd * (q + 1) : r * (q + 1) + (xcd - r) * q) + off; }
        const int nig = WGM * nN, gid = wgid / nig, fm = gid * WGM, gsz = (nM - fm) < WGM ? (nM - fm) : WGM;
        u.pm = fm + ((wgid % nig) % gsz); u.pn = (wgid % nig) / gsz; return true;
    }
    __device__ __forceinline__ void a_ready(const Unit&) const {}
    __device__ __forceinline__ void done(const Unit&) const {}
};

__device__ __forceinline__ unsigned cvt_pk_bf16(float lo, float hi) { unsigned r; asm volatile("v_cvt_pk_bf16_f32 %0, %1, %2" : "=v"(r) : "v"(lo), "v"(hi)); return r; }
template <class Epi, class Sched, bool ALIGN_EPI = false, bool SP2 = false>
__device__ __forceinline__ void gemm_phase(PG8_LAS unsigned char* lds, const Gemm g, const Sched& S, const Epi& E) {
    const int tid = threadIdx.x, wid = __builtin_amdgcn_readfirstlane(tid >> 6), lane = tid & 63, wr = wid >> 2, wc = wid & 3, fr = lane & 15, fq = lane >> 4;
    const int K = g.K, nt = K / BK;
    unsigned voffA[2], voffB[2];
#pragma unroll
    for (int i = 0; i < 2; ++i) { int R, C; stage_rc(tid * 16 + i * 8192, R, C); const int Rb = Epi::PERM ? ((R & ~31) + perm32(R & 31)) : R;
        voffA[i] = (unsigned)(R * K + C) * 2u; voffB[i] = (unsigned)(Rb * K + C) * 2u; }
    const size_t kstep = (size_t)(BK * 2);
    const size_t hstep = (size_t)HALF * K * 2;
    const size_t tstep = 2 * hstep;
    const unsigned ldsw = (unsigned)wid * 1024u;
    const int aoff = lds_byte(wr * 64 + fr, fq * 8), boff = lds_byte(wc * 32 + fr, fq * 8);
#define PG8_SA(b, h) (((b) * 2 + (h)) * HTB)
#define PG8_SB(b, h) ((4 + (b) * 2 + (h)) * HTB)
#define PG8_STAGE(bufoff, gbase, voff) do { _Pragma("unroll") for (int _i = 0; _i < 2; ++_i) \
        __builtin_amdgcn_global_load_lds((const unsigned*)((const char*)(gbase) + (voff)[_i]), (PG8_LAS unsigned*)(lds + (bufoff) + ldsw + _i * 8192), 16, 0, 0); } while (0)
#define PG8_LDA(dst, b, h) do { _Pragma("unroll") for (int m = 0; m < 4; ++m) _Pragma("unroll") for (int k = 0; k < 2; ++k) dst[m][k] = *(const PG8_LAS bf16x8*)(lds + PG8_SA(b, h) + aoff + m * 2048 + k * 1024); } while (0)
#define PG8_LDB(dst, b, h) do { _Pragma("unroll") for (int n = 0; n < 2; ++n) _Pragma("unroll") for (int k = 0; k < 2; ++k) dst[n][k] = *(const PG8_LAS bf16x8*)(lds + PG8_SB(b, h) + boff + n * 2048 + k * 1024); } while (0)
#define PG8_MMA(ai, bj, At, Bt) do { __builtin_amdgcn_s_setprio(1); _Pragma("unroll") for (int m = 0; m < 4; ++m) _Pragma("unroll") for (int n = 0; n < 2; ++n) _Pragma("unroll") for (int k = 0; k < 2; ++k) \
        acc[ai][bj][m][n] = __builtin_amdgcn_mfma_f32_16x16x32_bf16(Bt[n][k], At[m][k], acc[ai][bj][m][n], 0, 0, 0); __builtin_amdgcn_s_setprio(0); } while (0)
#define PG8_WAIT_V(n) asm volatile("s_waitcnt vmcnt(" #n ")" ::: "memory")
#define PG8_WAIT_L(n) asm volatile("s_waitcnt lgkmcnt(" #n ")" ::: "memory")
#define PG8_BAR __builtin_amdgcn_s_barrier()
#define PG8_SCHED __builtin_amdgcn_sched_barrier(0)
    Unit cur, nxt; int ui = 0;
    if (!S.next(0, cur)) return;
    f32x4 acc[2][2][4][2];
#pragma unroll
    for (int a = 0; a < 2; ++a)
#pragma unroll
        for (int b = 0; b < 2; ++b)
#pragma unroll
            for (int m = 0; m < 4; ++m)
#pragma unroll
                for (int n = 0; n < 2; ++n) acc[a][b][m][n] = (f32x4){0.f, 0.f, 0.f, 0.f};
    bf16x8 At[4][2], B0[2][2], B1[2][2];
    const char* cA = (const char*)g.A + (size_t)cur.pm * tstep; const char* cB = (const char*)g.Bt + (size_t)cur.pn * tstep;
    S.a_ready(cur);
    if constexpr (SP2) {
        PG8_STAGE(PG8_SB(0, 0), cB, voffB); PG8_STAGE(PG8_SB(0, 1), cB + hstep, voffB); PG8_STAGE(PG8_SA(0, 0), cA, voffA); PG8_STAGE(PG8_SA(0, 1), cA + hstep, voffA);
        if (wr == 1) PG8_BAR;
        PG8_WAIT_V(2); PG8_BAR;
        PG8_STAGE(PG8_SB(1, 0), cB + kstep, voffB); PG8_STAGE(PG8_SA(1, 0), cA + kstep, voffA); PG8_STAGE(PG8_SB(1, 1), cB + hstep + kstep, voffB);
        PG8_WAIT_V(6); PG8_BAR;
    } else {
        PG8_STAGE(PG8_SB(0, 0), cB, voffB); PG8_STAGE(PG8_SA(0, 0), cA, voffA); PG8_STAGE(PG8_SB(0, 1), cB + hstep, voffB); PG8_STAGE(PG8_SA(0, 1), cA + hstep, voffA);
        if (wr == 1) PG8_BAR;
        PG8_WAIT_V(4); PG8_BAR;
        PG8_STAGE(PG8_SB(1, 0), cB + kstep, voffB); PG8_STAGE(PG8_SA(1, 0), cA + kstep, voffA); PG8_STAGE(PG8_SB(1, 1), cB + hstep + kstep, voffB);
        PG8_WAIT_V(6); PG8_BAR;
    }
    for (;;) {
        const bool has_next = S.next(ui + 1, nxt);
        const char* nA = has_next ? (const char*)g.A + (size_t)nxt.pm * tstep : cA; const char* nB = has_next ? (const char*)g.Bt + (size_t)nxt.pn * tstep : cB;
        for (int t = 0; t < nt; t += 2) {
            const bool last = (t == nt - 2);
            const char* a1 = cA + (size_t)(t + 1) * kstep;
            const char* a2 = last ? nA : cA + (size_t)(t + 2) * kstep; const char* b2 = last ? nB : cB + (size_t)(t + 2) * kstep;
            const char* a3 = a2 + kstep; const char* b3 = b2 + kstep;
            if (last && has_next) S.a_ready(nxt);
            if constexpr (SP2) {
            PG8_LDB(B0, 0, 0); PG8_LDB(B1, 0, 1); PG8_SCHED; PG8_LDA(At, 0, 0); PG8_STAGE(PG8_SA(1, 1), a1 + hstep, voffA);
            PG8_WAIT_V(8); PG8_WAIT_L(0); PG8_BAR; PG8_MMA(0, 0, At, B0); PG8_MMA(0, 1, At, B1); PG8_BAR; PG8_SCHED;
            PG8_LDA(At, 0, 1); PG8_STAGE(PG8_SB(0, 0), b2, voffB); PG8_STAGE(PG8_SB(0, 1), b2 + hstep, voffB); PG8_STAGE(PG8_SA(0, 0), a2, voffA);
            PG8_WAIT_V(8); PG8_WAIT_L(0); PG8_BAR; PG8_MMA(1, 0, At, B0); PG8_MMA(1, 1, At, B1); PG8_BAR; PG8_SCHED;
            PG8_LDB(B0, 1, 0); PG8_LDB(B1, 1, 1); PG8_SCHED; PG8_LDA(At, 1, 0); PG8_STAGE(PG8_SA(0, 1), a2 + hstep, voffA);
            PG8_WAIT_V(8); PG8_WAIT_L(0); PG8_BAR; PG8_MMA(0, 0, At, B0); PG8_MMA(0, 1, At, B1); PG8_BAR; PG8_SCHED;
            PG8_LDA(At, 1, 1); PG8_STAGE(PG8_SB(1, 0), b3, voffB); PG8_STAGE(PG8_SB(1, 1), b3 + hstep, voffB); PG8_STAGE(PG8_SA(1, 0), a3, voffA);
            PG8_WAIT_V(8); PG8_WAIT_L(0); PG8_BAR; PG8_MMA(1, 0, At, B0); PG8_MMA(1, 1, At, B1); PG8_BAR; PG8_SCHED;
            } else {
            PG8_LDB(B0, 0, 0); PG8_SCHED; PG8_LDA(At, 0, 0); PG8_STAGE(PG8_SA(1, 1), a1 + hstep, voffA);
            PG8_WAIT_L(8); PG8_BAR; PG8_WAIT_L(0); PG8_MMA(0, 0, At, B0); PG8_BAR; PG8_SCHED;
            PG8_LDB(B1, 0, 1); PG8_STAGE(PG8_SB(0, 0), b2, voffB);
            PG8_BAR; PG8_WAIT_L(0); PG8_MMA(0, 1, At, B1); PG8_BAR;
            PG8_LDA(At, 0, 1); PG8_STAGE(PG8_SA(0, 0), a2, voffA);
            PG8_BAR; PG8_WAIT_L(0); PG8_MMA(1, 0, At, B0); PG8_BAR; PG8_SCHED;
            PG8_STAGE(PG8_SB(0, 1), b2 + hstep, voffB);
            PG8_WAIT_V(6); PG8_BAR; PG8_MMA(1, 1, At, B1); PG8_BAR;
            PG8_LDB(B0, 1, 0); PG8_SCHED; PG8_LDA(At, 1, 0); PG8_STAGE(PG8_SA(0, 1), a2 + hstep, voffA);
            PG8_WAIT_L(8); PG8_BAR; PG8_WAIT_L(0); PG8_MMA(0, 0, At, B0); PG8_BAR; PG8_SCHED;
            PG8_LDB(B1, 1, 1); PG8_STAGE(PG8_SB(1, 0), b3, voffB);
            PG8_BAR; PG8_WAIT_L(0); PG8_MMA(0, 1, At, B1); PG8_BAR;
            PG8_LDA(At, 1, 1); PG8_STAGE(PG8_SA(1, 0), a3, voffA);
            PG8_BAR; PG8_WAIT_L(0); PG8_MMA(1, 0, At, B0); PG8_BAR; PG8_SCHED;
            PG8_STAGE(PG8_SB(1, 1), b3 + hstep, voffB);
            PG8_WAIT_V(6); PG8_BAR; PG8_MMA(1, 1, At, B1); PG8_BAR;
            }
        }
        if constexpr (ALIGN_EPI) { if (wr == 0) PG8_BAR; }
        if constexpr (!Epi::AFTER_DRAIN) { E(acc, cur, wr, wc, fr, fq); S.done(cur); }
        if (!has_next) break;
#pragma unroll
        for (int a = 0; a < 2; ++a)
#pragma unroll
            for (int b = 0; b < 2; ++b)
#pragma unroll
                for (int m = 0; m < 4; ++m)
#pragma unroll
                    for (int n = 0; n < 2; ++n) acc[a][b][m][n] = (f32x4){0.f, 0.f, 0.f, 0.f};
        cur = nxt; cA = nA; cB = nB; ++ui;
        if constexpr (ALIGN_EPI) { if (wr == 1) PG8_BAR; }
    }
    PG8_WAIT_V(0);
    if constexpr (!ALIGN_EPI) { if (wr == 0) PG8_BAR; }
    PG8_BAR;
    if constexpr (Epi::AFTER_DRAIN) { E.fused(acc, cur, wr, wc, fr, fq, lds, wid, lane); S.done(cur); }
#undef PG8_SA
#undef PG8_SB
#undef PG8_STAGE
#undef PG8_LDA
#undef PG8_LDB
#undef PG8_MMA
#undef PG8_WAIT_V
#undef PG8_WAIT_L
#undef PG8_BAR
#undef PG8_SCHED
}
}

#ifndef PG8_SP2
#define PG8_SP2 true
#endif
#ifndef PG8_ALIGN
#define PG8_ALIGN true
#endif
constexpr int NWAVES = 8;
#ifndef MK_N_LAUNCHES
#define MK_N_LAUNCHES 1
#endif
constexpr int NPHASE = 11;
constexpr int N_LAUNCHES = MK_N_LAUNCHES;
static_assert(N_LAUNCHES == 1 || N_LAUNCHES == NPHASE, "MK_N_LAUNCHES is 1 or 11");

constexpr int D = 2048, NB = 8, SEQ = 2048, T = NB * SEQ, LC = 256, TC = NB * LC, MTOT = T + TC;
constexpr int HEADS = 8, HD = 128, MIXG = 1024;
constexpr int PXW = 10240;
constexpr int PQN = 0, PKN = 1024, PVN = 2048, PQH = 3072, PKF = 4096, PKB = 5120, PIH = 6144, PGH = 7168, PGF = 8192, PGB = 9216;
constexpr int NE = 32, TOPK = 4, FF = 2048;
constexpr int CAP_TILES = 288, CAP = CAP_TILES * 256;
constexpr float EPS = 1e-6f;

constexpr size_t MiB = 1u << 20;
constexpr size_t WS_CTL = 0, CTL_ZERO_BYTES = 1 * MiB;
constexpr size_t WS_MODP = 4 * MiB;
constexpr size_t WS_MODF = 6 * MiB;
constexpr size_t WS_WRT = 7 * MiB;
constexpr size_t WS_WIN = 8 * MiB;
constexpr size_t WS_WOUT = 40 * MiB;
constexpr size_t WS_HXN = 48 * MiB;
constexpr size_t WS_PX = 120 * MiB;
constexpr size_t WS_A2 = 480 * MiB;
constexpr size_t WS_OF = 544 * MiB;
constexpr size_t WS_OB = 608 * MiB;
constexpr size_t WS_X1 = 672 * MiB;
constexpr size_t WS_HX2 = 800 * MiB;
constexpr size_t WS_RT = 864 * MiB;
constexpr size_t WS_XG = 866 * MiB;
constexpr size_t WS_H = 1154 * MiB;
constexpr size_t WS_Y = 1442 * MiB;
constexpr size_t WS_WGU = 1730 * MiB;
constexpr size_t WS_WD = 2242 * MiB;
constexpr size_t WS_END = 2498 * MiB;
constexpr int CW_TMO = 0;
constexpr int CW_BAR = 4096;
constexpr int CW_ATTQ = 16384;
constexpr int CW_CNT = 16448;

constexpr int RING_OFF = 0, SCR_BYTES = 139264;
constexpr int LDSCTL_OFF = SCR_BYTES, MISC_OFF = LDSCTL_OFF + 320, TILE_OFF = MISC_OFF + 128, OFFT_OFF = TILE_OFF + 320;
constexpr int LDS_BYTES = 147456;
static_assert(OFFT_OFF + 256 <= LDS_BYTES, "LDS map");

#define GAS __attribute__((address_space(1)))
#define LAS __attribute__((address_space(3)))
typedef unsigned short bf16;
typedef unsigned v4u __attribute__((ext_vector_type(4)));
typedef unsigned v2u __attribute__((ext_vector_type(2)));
typedef float f32x4 __attribute__((ext_vector_type(4)));
typedef float f32x2 __attribute__((ext_vector_type(2)));
typedef short bf16x8 __attribute__((ext_vector_type(8)));
typedef short s16x4 __attribute__((ext_vector_type(4)));
typedef __bf16 bfv2 __attribute__((ext_vector_type(2)));
typedef GAS unsigned gu32;
#define RLX_AGENT __ATOMIC_RELAXED, __HIP_MEMORY_SCOPE_AGENT
#define LDS_WAIT() asm volatile("s_waitcnt lgkmcnt(0)" ::: "memory")
#define VM_WAIT() asm volatile("s_waitcnt vmcnt(0)" ::: "memory")
__device__ __forceinline__ unsigned pk2(float lo, float hi) { f32x2 v = {lo, hi}; bfv2 b = __builtin_convertvector(v, bfv2); return __builtin_bit_cast(unsigned, b); }
__device__ __forceinline__ float bflo(unsigned u) { return __uint_as_float(u << 16); }
__device__ __forceinline__ float bfhi(unsigned u) { return __uint_as_float(u & 0xffff0000u); }
__device__ __forceinline__ float wave_sum(float v) {
#pragma unroll
    for (int o = 1; o < 64; o <<= 1) v += __shfl_xor(v, o);
    return v;
}
__device__ __forceinline__ float silu_f(float x) { return x / (1.f + __expf(-x)); }
__device__ __forceinline__ bf16x8 cat8(s16x4 a, s16x4 b) { return __builtin_shufflevector(a, b, 0, 1, 2, 3, 4, 5, 6, 7); }
__device__ __forceinline__ s16x4 tr_read(const LAS unsigned char* p) { return __builtin_amdgcn_ds_read_tr16_b64_v4i16((LAS s16x4*)p); }
__device__ __forceinline__ bf16x8 mk8(unsigned a, unsigned b, unsigned c, unsigned d) { v4u v = {a, b, c, d}; return __builtin_bit_cast(bf16x8, v); }
#define XB_TMO      128
#define XB_XCNT(j)  (256  + 64 * (j))
#define XB_XSUB(j)  (1280 + 64 * (j))
#define XB_XGEN(j)  (2304 + 64 * (j))
#define XB_TOP      3328
#define XB_TOPGEN   3392
#define XCD_BAR_WORDS 3456
#define XB_SPIN_CAP (1u << 18)

__device__ __forceinline__ unsigned xb_ld(unsigned* p)              { return __hip_atomic_load(p, __ATOMIC_RELAXED, __HIP_MEMORY_SCOPE_AGENT); }
__device__ __forceinline__ unsigned xb_add(unsigned* p, unsigned v) { return __hip_atomic_fetch_add(p, v, __ATOMIC_RELAXED, __HIP_MEMORY_SCOPE_AGENT); }
__device__ __forceinline__ unsigned xb_xcc_id() { return (unsigned)__builtin_amdgcn_s_getreg((3 << 11) | 20) & 0xFu; }
#define XB_SPIN(cond, bar) do { unsigned _sp = 0; while (cond) { __builtin_amdgcn_s_sleep(1); \
    if ((++_sp & 255u) == 0u) { if (xb_ld(&(bar)[XB_TMO])) break; if (_sp > XB_SPIN_CAP) { atomicAdd(&(bar)[XB_TMO], 1u); break; } } } } while (0)

struct XcdBarrier {
    unsigned* bar; unsigned x;
    volatile LAS unsigned* st;
};

__device__ __forceinline__ XcdBarrier xcd_barrier_post(unsigned* bar, volatile LAS unsigned* st) {
    XcdBarrier b; b.bar = bar; b.x = xb_xcc_id(); b.st = st;
    if (threadIdx.x == 0) (void)xb_add(&bar[XB_XCNT(b.x)], 1u);
    return b;
}
__device__ __forceinline__ void xcd_barrier_complete(unsigned* bar, unsigned x, unsigned& nloc, unsigned& nx) {
    const unsigned G = gridDim.x * gridDim.y * gridDim.z;
    unsigned sum, cnt, mine, sp = 0u;
    for (;;) {
        sum = 0u; cnt = 0u; mine = 0u;
#pragma unroll
        for (unsigned j = 0; j < 16; ++j) { const unsigned c = xb_ld(&bar[XB_XCNT(j)]); sum += c; cnt += (c > 0u) ? 1u : 0u; mine = (j == x) ? c : mine; }
        if (sum == G) break;
        __builtin_amdgcn_s_sleep(1);
        if ((++sp & 255u) == 0u) { if (xb_ld(&bar[XB_TMO])) break; if (sp > XB_SPIN_CAP) { atomicAdd(&bar[XB_TMO], 1u); break; } }
    }
    nloc = mine > 0u ? mine : 1u; nx = cnt > 0u ? cnt : 1u;
}

__device__ __forceinline__ void xcd_barrier(const XcdBarrier& b) {
    asm volatile("s_waitcnt vmcnt(0)" ::: "memory");
    __syncthreads();
    if (threadIdx.x == 0) {
        unsigned* bar = b.bar;
        __builtin_amdgcn_s_waitcnt(0);
        unsigned nloc = b.st[0], nx = b.st[1];
        if (nloc == 0u) { xcd_barrier_complete(bar, b.x, nloc, nx); b.st[0] = nloc; b.st[1] = nx; }
        const unsigned old = xb_add(&bar[XB_XSUB(b.x)], 1u);
        const unsigned gen = old / nloc;
        if (old + 1u == (gen + 1u) * nloc) {
            __builtin_amdgcn_fence(__ATOMIC_RELEASE, "agent");
            asm volatile("s_waitcnt vmcnt(0)" ::: "memory");
            const unsigned og = xb_add(&bar[XB_TOP], 1u);
            const unsigned tg = og / nx;
            if (og + 1u == (tg + 1u) * nx) xb_add(&bar[XB_TOPGEN], 1u);
            else XB_SPIN(xb_ld(&bar[XB_TOPGEN]) == tg, bar);
            __builtin_amdgcn_fence(__ATOMIC_ACQUIRE, "agent");
            xb_add(&bar[XB_XGEN(b.x)], 1u);
            asm volatile("s_waitcnt vmcnt(0)" ::: "memory");
        } else {
            XB_SPIN(xb_ld(&bar[XB_XGEN(b.x)]) == gen, bar);
            __builtin_amdgcn_fence(__ATOMIC_ACQUIRE, "agent");
            asm volatile("s_waitcnt vmcnt(0)" ::: "memory");
        }
    }
    __syncthreads();
}

struct Frame {
    LAS unsigned char* lds;
    volatile LAS unsigned* MISC;
    gu32* ctl;
    int tid, lane, wave;
    int vcu, G;
    const float *x, *c, *ctx, *c_ctx, *w_ada, *b_ada, *norm_mix, *norm_ffn, *w_in, *lb_table, *hg_norm, *rpb, *w_out, *w_router, *b_router, *w_gu, *b_gu, *w_down, *b_down, *norm_final;
    float* out;
    float *MODP, *MODF, *OF, *OB, *X1;
    bf16 *WRT, *WIN, *WOUT, *HXN, *PX, *A2, *HX2, *XG, *H, *Y, *WGU, *WD;
    int *RT_E, *RT_POS, *RT_SLOT; float* RT_G;
};

__device__ __forceinline__ void p0_mod_unit(Frame& F, int unit) {
    const int slab = unit >> 2, ks = unit & 3, col0 = slab * 64, k0 = ks * 512;
    LAS float* cond = (LAS float*)(F.lds);
    LAS float* red = (LAS float*)(F.lds + 9 * 512 * 4);
    for (int i = F.tid; i < 9 * 512; i += 512) { const int r = i >> 9, k = i & 511; const float v = (r < 8) ? F.c[r * D + k0 + k] : F.c_ctx[k0 + k]; cond[i] = silu_f(v); }
    __syncthreads();
    const int c4 = F.tid & 15, kl = F.tid >> 4;
    float acc[9][4];
#pragma unroll
    for (int r = 0; r < 9; ++r) { acc[r][0] = 0.f; acc[r][1] = 0.f; acc[r][2] = 0.f; acc[r][3] = 0.f; }
    const float* wp = F.w_ada + (size_t)(k0 + kl) * (6 * D) + col0 + 4 * c4;
#pragma unroll 4
    for (int it = 0; it < 16; ++it) {
        const f32x4 w = *(const f32x4*)(wp + (size_t)(32 * it) * (6 * D));
#pragma unroll
        for (int r = 0; r < 9; ++r) { const float cv = cond[r * 512 + kl + 32 * it]; acc[r][0] += cv * w.x; acc[r][1] += cv * w.y; acc[r][2] += cv * w.z; acc[r][3] += cv * w.w; }
    }
#pragma unroll
    for (int r = 0; r < 9; ++r)
#pragma unroll
        for (int j = 0; j < 4; ++j) { float v = acc[r][j]; v += __shfl_xor(v, 16); v += __shfl_xor(v, 32); if (F.lane < 16) red[F.wave * 576 + r * 64 + 4 * c4 + j] = v; }
    __syncthreads();
    for (int o = F.tid; o < 576; o += 512) { float s = 0.f;
#pragma unroll
        for (int w = 0; w < 8; ++w) s += red[w * 576 + o];
        const int r = o >> 6, cc = o & 63; F.MODP[(size_t)(ks * 9 + r) * (6 * D) + col0 + cc] = s; }
    __syncthreads();
}
__device__ __forceinline__ void p0_tr_item(const float* W, int ldw, bf16* WT, size_t dst_row0, int k0, int n0, LAS float* scr, int lane) {
#pragma unroll 4
    for (int i = 0; i < 16; ++i) { const int kk = 4 * i + (lane >> 4); const f32x4 v = *(const f32x4*)(W + (size_t)(k0 + kk) * ldw + n0 + 4 * (lane & 15));
        LAS float* s = scr + kk * 65 + 4 * (lane & 15); s[0] = v.x; s[1] = v.y; s[2] = v.z; s[3] = v.w; }
    LDS_WAIT(); asm volatile("" ::: "memory");
    const int c = lane & 7, nn = lane >> 3;
#pragma unroll
    for (int j = 0; j < 8; ++j) { const int n = 8 * j + nn; const LAS float* s = scr + (8 * c) * 65 + n;
        v4u o; o.x = pk2(s[0 * 65], s[1 * 65]); o.y = pk2(s[2 * 65], s[3 * 65]); o.z = pk2(s[4 * 65], s[5 * 65]); o.w = pk2(s[6 * 65], s[7 * 65]);
        *(v4u*)(WT + (dst_row0 + n) * 2048 + k0 + 8 * c) = o; }
    LDS_WAIT(); asm volatile("" ::: "memory");
}
__device__ __forceinline__ void p0_prologue(Frame& F) {
    for (int u = F.vcu; u < 768; u += F.G) p0_mod_unit(F, u);
    LAS float* scr = (LAS float*)(F.lds + F.wave * 16640);
    const int gw = F.vcu * NWAVES + F.wave, NGW = F.G * NWAVES;
    constexpr int I_IN = 32 * 128, I_OUT = 32 * 32, I_GU = 32 * 64, I_DN = 32 * 32;
    constexpr int NITEMS = I_IN + I_OUT + NE * I_GU + NE * I_DN;
    for (int it = gw; it < NITEMS; it += NGW) {
        int r = it;
        if (r < I_IN) { const int kb = r >> 7, nb = r & 127; p0_tr_item(F.w_in, 8192, F.WIN, (size_t)nb * 64, kb * 64, nb * 64, scr, F.lane); continue; } r -= I_IN;
        if (r < I_OUT) { const int kb = r >> 5, nb = r & 31; p0_tr_item(F.w_out, 2048, F.WOUT, (size_t)nb * 64, kb * 64, nb * 64, scr, F.lane); continue; } r -= I_OUT;
        if (r < NE * I_GU) { const int e = r >> 11, q = r & 2047, kb = q >> 6, nb = q & 63, n0 = nb * 64;
            const size_t drow = (size_t)e * 4096 + (size_t)(((n0 & 2047) >> 7) * 256 + (n0 >> 11) * 128 + (n0 & 127));
            p0_tr_item(F.w_gu + (size_t)e * 2048 * 4096, 4096, F.WGU, drow, kb * 64, n0, scr, F.lane); continue; } r -= NE * I_GU;
        { const int e = r >> 10, q = r & 1023, kb = q >> 5, nb = q & 31; p0_tr_item(F.w_down + (size_t)e * 2048 * 2048, 2048, F.WD, (size_t)e * 2048 + nb * 64, kb * 64, nb * 64, scr, F.lane); }
    }
    for (int i = F.vcu * 512 + F.tid; i < NE * D; i += F.G * 512) { const int e = i >> 11, k = i & 2047; const float w = F.w_router[k * NE + e];
        const unsigned hi = pk2(w, 0.f) & 0xffffu; const float wl = w - bflo(hi); F.WRT[i] = (bf16)hi; F.WRT[NE * D + i] = (bf16)(pk2(wl, 0.f) & 0xffffu); }
}

__device__ __forceinline__ void p1_build_vec(Frame& F, int bb, int sh_off, int sc_off, const float* gain, bool from_partials) {
    LAS float* Av = (LAS float*)(F.lds); LAS float* Bv = Av + D;
    for (int c = F.tid; c < D; c += 512) {
        float sh, sc;
        if (from_partials) { sh = F.b_ada[sh_off + c]; sc = F.b_ada[sc_off + c];
#pragma unroll
            for (int ks = 0; ks < 4; ++ks) { sh += F.MODP[(size_t)(ks * 9 + bb) * (6 * D) + sh_off + c]; sc += F.MODP[(size_t)(ks * 9 + bb) * (6 * D) + sc_off + c]; } }
        else { sh = F.MODF[(size_t)bb * (6 * D) + sh_off + c]; sc = F.MODF[(size_t)bb * (6 * D) + sc_off + c]; }
        Av[c] = gain[c] * (1.f + sc); Bv[c] = sh; }
    __syncthreads();
}
__device__ __forceinline__ void norm_row_bf16(Frame& F, const float* xrow, bf16* orow) {
    const LAS f32x4* Av = (const LAS f32x4*)(F.lds); const LAS f32x4* Bv = Av + D / 4;
    const f32x4* xr = (const f32x4*)xrow + F.lane;
    f32x4 v[8]; float s = 0.f;
#pragma unroll
    for (int j = 0; j < 8; ++j) { v[j] = xr[64 * j]; s += (v[j].x * v[j].x + v[j].y * v[j].y) + (v[j].z * v[j].z + v[j].w * v[j].w); }
    const float rstd = rsqrtf(wave_sum(s) * (1.f / D) + EPS);
    v2u* o8 = (v2u*)orow + F.lane;
#pragma unroll
    for (int j = 0; j < 8; ++j) { const f32x4 a = Av[F.lane + 64 * j], b = Bv[F.lane + 64 * j]; const f32x4 y = v[j] * rstd * a + b;
        v2u o; o.x = pk2(y.x, y.y); o.y = pk2(y.z, y.w); o8[64 * j] = o; }
}
__device__ __forceinline__ void p1_norm(Frame& F) {
    for (int i = F.vcu * 512 + F.tid; i < 9 * 6 * D; i += F.G * 512) { float s = F.b_ada[i % (6 * D)];
#pragma unroll
        for (int ks = 0; ks < 4; ++ks) s += F.MODP[(size_t)ks * 9 * 6 * D + i];
        F.MODF[i] = s; }
    for (int blk = F.vcu; blk < 256; blk += F.G) {
        const int bb = blk >> 5;
        p1_build_vec(F, bb, 0, D, F.norm_mix, true);
        for (int r = F.wave; r < 64; r += NWAVES) { const int row = blk * 64 + r; norm_row_bf16(F, F.x + (size_t)row * D, F.HXN + (size_t)row * D); }
        __syncthreads();
        p1_build_vec(F, 8, 0, D, F.norm_mix, true);
        { const int row = blk * 8 + F.wave; norm_row_bf16(F, F.ctx + (size_t)row * D, F.HXN + (size_t)(T + row) * D); }
        __syncthreads();
    }
}

struct InProjOrder {
    pg8::StaticOrder so; int G, c;
    __device__ void init(int G_, int c_) { so.init(T, 8192, G_, c_); G = G_; c = c_; }
    __device__ bool next(int i, pg8::Unit& u) const {
        const int L = i * G + c;
        if (L < 2048) return so.next(i, u);
        const int idx = L - 2048; if (idx >= 160) return false;
        const int q = idx % 20; u.pm = 64 + idx / 20; u.pn = q < 8 ? 4 + q : 8 + q; return true;
    }
    __device__ __forceinline__ void a_ready(const pg8::Unit&) const {}
    __device__ __forceinline__ void done(const pg8::Unit&) const {}
};
struct EpiInProj {
    static constexpr bool PERM = true, AFTER_DRAIN = false;
    bf16* PX; const float* lbt;
    __device__ __forceinline__ void operator()(const f32x4 (&acc)[2][2][4][2], const pg8::Unit& u, int wr, int wc, int fr, int fq) const {
        const int row0 = u.pm * 256 + wr * 64 + fr, part = u.pn >> 2, col0 = u.pn * 256 + wc * 32 + 8 * fq;
        if (part == 4 || part == 5) {
            float lb[2][8];
#pragma unroll
            for (int bj = 0; bj < 2; ++bj)
#pragma unroll
                for (int i = 0; i < 8; ++i) { const int c = col0 + bj * 128 + i - 4096; lb[bj][i] = 1.f / (1.f + __expf(lbt[2048 + c] - lbt[c])); }
#pragma unroll
            for (int ai = 0; ai < 2; ++ai)
#pragma unroll
                for (int m = 0; m < 4; ++m) { bf16* rowp = PX + (size_t)(row0 + ai * 128 + m * 16) * PXW + col0;
#pragma unroll
                    for (int bj = 0; bj < 2; ++bj) { float ky[8], gg[8];
#pragma unroll
                        for (int i = 0; i < 8; ++i) { float xv = acc[ai][bj][m][i >> 2][i & 3]; xv = fminf(fmaxf(xv, -30.f), 30.f);
                            const float sig = 1.f / (1.f + __expf(-xv)), l = lb[bj][i]; gg[i] = __logf(l + (1.f - l) * sig); ky[i] = (1.f - l) * (1.f - sig); }
                        v4u w; w.x = pk2(ky[0], ky[1]); w.y = pk2(ky[2], ky[3]); w.z = pk2(ky[4], ky[5]); w.w = pk2(ky[6], ky[7]);
                        *(v4u*)(rowp + bj * 128) = w;
                        w.x = pk2(gg[0], gg[1]); w.y = pk2(gg[2], gg[3]); w.z = pk2(gg[4], gg[5]); w.w = pk2(gg[6], gg[7]);
                        *(v4u*)(rowp + bj * 128 + 4096) = w; } }
        } else {
            const float sc = (part == 0) ? 0.08838834764831845f : 1.f;
#pragma unroll
            for (int ai = 0; ai < 2; ++ai)
#pragma unroll
                for (int m = 0; m < 4; ++m) { bf16* rowp = PX + (size_t)(row0 + ai * 128 + m * 16) * PXW + col0;
#pragma unroll
                    for (int bj = 0; bj < 2; ++bj) { const f32x4 v0 = acc[ai][bj][m][0] * sc, v1 = acc[ai][bj][m][1] * sc;
                        v4u w; w.x = pk2(v0[0], v0[1]); w.y = pk2(v0[2], v0[3]); w.z = pk2(v1[0], v1[1]); w.w = pk2(v1[2], v1[3]);
                        *(v4u*)(rowp + bj * 128) = w; } }
        }
    }
};

#define MFMA16(a, b, c) __builtin_amdgcn_mfma_f32_16x16x32_bf16((a), (b), (c), 0, 0, 0)
__device__ __forceinline__ void gla_chain(Frame& F, int chain) {
    const int b = chain >> 4, h = (chain >> 1) & 7, dir = chain & 1;
    const int lane = F.lane, wave = F.wave, tid = F.tid, kq = lane >> 4, fr = lane & 15;
    LAS unsigned char* L = F.lds;
    constexpr int PIT = 272;
    constexpr int O_QE = 0, O_QD = 17408, O_KD = 34816, O_V = 52224, O_KEX = 69632, O_ATT = 113152, O_SUB = 122368, O_DECL = 126464;
    for (int i = tid; i < 9216 / 4; i += 512) ((LAS unsigned*)(L + O_ATT))[i] = 0u;
    f32x4 S[8];
#pragma unroll
    for (int i = 0; i < 8; ++i) S[i] = (f32x4){0.f, 0.f, 0.f, 0.f};
    const int pko = dir ? PKB : PKF, pgo = dir ? PGB : PGF;
    float invf[2];
#pragma unroll
    for (int j = 0; j < 2; ++j) invf[j] = __expf(-(float)(2 * (lane & 15) + j) * (9.210340371976184f / 32.f));
    const float sgn = (lane & 16) ? 1.f : -1.f;
    float* OUT = dir ? F.OB : F.OF;
    unsigned pq[8], pk[8], pg[8]; v4u pv[2];
#define GLA_LOAD(n) do { const int _lat = (n) >= 4, _s0 = _lat ? 64 * ((n) - 4) : 64 * (n); \
        _Pragma("unroll") for (int i = 0; i < 8; ++i) { const int s = _s0 + 8 * wave + i; const int tok = _lat ? (dir ? 2047 - s : s) : (dir ? 255 - s : s); \
            const size_t grow = _lat ? (size_t)(b * SEQ + tok) : (size_t)(T + b * LC + tok); const bf16* rp = F.PX + grow * PXW + h * HD + 2 * lane; \
            pq[i] = _lat ? *(const unsigned*)(rp + PQH) : 0u; pk[i] = *(const unsigned*)(rp + pko); pg[i] = *(const unsigned*)(rp + pgo); } \
        _Pragma("unroll") for (int j = 0; j < 2; ++j) { const int p = tid + 512 * j, R = p >> 4, ch = p & 15, s = _s0 + R; const int tok = _lat ? (dir ? 2047 - s : s) : (dir ? 255 - s : s); \
            const size_t grow = _lat ? (size_t)(b * SEQ + tok) : (size_t)(T + b * LC + tok); pv[j] = *(const v4u*)(F.PX + grow * PXW + PIH + h * HD + ch * 8); } } while (0)
    GLA_LOAD(0);
    for (int n = 0; n < 36; ++n) {
        const bool lat = n >= 4;
        const int s0 = lat ? 64 * (n - 4) : 64 * n;
#pragma unroll
        for (int j = 0; j < 2; ++j) { const int p = tid + 512 * j, R = p >> 4, ch = p & 15; *(LAS v4u*)(L + O_V + R * PIT + ch * 16) = pv[j]; }
        float qa[8], qb[8], ka[8], kb[8], ca[8], cb[8];
        float ra = 0.f, rb = 0.f;
#pragma unroll
        for (int i = 0; i < 8; ++i) {
            float q0 = bflo(pq[i]), q1 = bfhi(pq[i]), k0 = bflo(pk[i]), k1 = bfhi(pk[i]);
            if (lat) {
                const int s = s0 + 8 * wave + i, tok = dir ? 2047 - s : s;
                const float pos = (float)((lane >= 32) ? (tok & 63) : (tok >> 6));
                const unsigned qp = (unsigned)__shfl_xor((int)pq[i], 16), kp = (unsigned)__shfl_xor((int)pk[i], 16);
                const float a0 = pos * invf[0], a1 = pos * invf[1];
                const float c0 = __cosf(a0), s0_ = __sinf(a0), c1 = __cosf(a1), s1_ = __sinf(a1);
                q0 = q0 * c0 + sgn * bflo(qp) * s0_; q1 = q1 * c1 + sgn * bfhi(qp) * s1_;
                k0 = k0 * c0 + sgn * bflo(kp) * s0_; k1 = k1 * c1 + sgn * bfhi(kp) * s1_;
            }
            qa[i] = q0; qb[i] = q1; ka[i] = k0; kb[i] = k1;
            ra += bflo(pg[i]); rb += bfhi(pg[i]); ca[i] = ra; cb[i] = rb;
        }
        *(LAS f32x2*)(L + O_SUB + (wave * 128 + 2 * lane) * 4) = (f32x2){ra, rb};
        __syncthreads();
        {
            float refa[4], refb[4], pa = 0.f, pb = 0.f, ta = 0.f, tb = 0.f;
#pragma unroll
            for (int w = 0; w < 8; ++w) { const f32x2 sv = *(const LAS f32x2*)(L + O_SUB + (w * 128 + 2 * lane) * 4);
                if ((w & 1) == 0) { refa[w >> 1] = ta; refb[w >> 1] = tb; }
                if (w < wave) { pa += sv.x; pb += sv.y; }
                ta += sv.x; tb += sv.y; }
            const int I = wave >> 1;
            float rIa = refa[0], rIb = refb[0];
#pragma unroll
            for (int q = 1; q < 4; ++q) if (I == q) { rIa = refa[q]; rIb = refb[q]; }
#pragma unroll
            for (int i = 0; i < 8; ++i) {
                const int R = 8 * wave + i; const float cua = pa + ca[i], cub = pb + cb[i];
                *(LAS unsigned*)(L + O_KD + R * PIT + 4 * lane) = pk2(ka[i] * __expf(ta - cua), kb[i] * __expf(tb - cub));
                if (lat) {
                    *(LAS unsigned*)(L + O_QE + R * PIT + 4 * lane) = pk2(qa[i] * __expf(cua - rIa), qb[i] * __expf(cub - rIb));
                    *(LAS unsigned*)(L + O_QD + R * PIT + 4 * lane) = pk2(qa[i] * __expf(cua), qb[i] * __expf(cub));
#pragma unroll
                    for (int Ip = 0; Ip < 4; ++Ip) if (Ip >= I) {
                        const int row = 16 * (Ip * (Ip + 1) / 2 + I) + (R & 15);
                        *(LAS unsigned*)(L + O_KEX + row * PIT + 4 * lane) = pk2(ka[i] * __expf(refa[Ip] - cua), kb[i] * __expf(refb[Ip] - cub)); }
                }
            }
            if (wave == 0) *(LAS f32x2*)(L + O_DECL + 8 * lane) = (f32x2){__expf(ta), __expf(tb)};
        }
        if (n + 1 < 36) GLA_LOAD(n + 1);
        __syncthreads();
        if (lat) {
            for (int tt = wave; tt < 10; tt += 8) {
                const int I = (tt >= 6) ? 3 : (tt >= 3) ? 2 : (tt >= 1) ? 1 : 0, J = tt - I * (I + 1) / 2;
                f32x4 X = (f32x4){0.f, 0.f, 0.f, 0.f};
#pragma unroll
                for (int ks = 0; ks < 4; ++ks) {
                    const bf16x8 a = *(const LAS bf16x8*)(L + O_KEX + (16 * tt + fr) * PIT + ks * 64 + kq * 16);
                    const bf16x8 bq = *(const LAS bf16x8*)(L + O_QE + (16 * I + fr) * PIT + ks * 64 + kq * 16);
                    X = MFMA16(a, bq, X); }
                if (J == I) {
#pragma unroll
                    for (int r = 0; r < 4; ++r) if (4 * kq + r > fr) X[r] = 0.f; }
                v2u o; o.x = pk2(X[0], X[1]); o.y = pk2(X[2], X[3]);
                *(LAS v2u*)(L + O_ATT + (16 * I + fr) * 144 + (16 * J + 4 * kq) * 2) = o;
            }
        }
        __syncthreads();
        {
            const int q4 = fr >> 2, pp = fr & 3;
            bf16x8 Vf[2];
#pragma unroll
            for (int p = 0; p < 2; ++p) { const LAS unsigned char* vb = L + O_V + (32 * p + 8 * kq + q4) * PIT + (16 * wave + 4 * pp) * 2;
                Vf[p] = cat8(tr_read(vb), tr_read(vb + 4 * PIT)); }
            if (lat) {
                bf16x8 Sb[4];
#pragma unroll
                for (int ks = 0; ks < 4; ++ks) Sb[ks] = mk8(pk2(S[2 * ks][0], S[2 * ks][1]), pk2(S[2 * ks][2], S[2 * ks][3]), pk2(S[2 * ks + 1][0], S[2 * ks + 1][1]), pk2(S[2 * ks + 1][2], S[2 * ks + 1][3]));
#pragma unroll
                for (int I = 0; I < 4; ++I) {
                    f32x4 o = (f32x4){0.f, 0.f, 0.f, 0.f};
#pragma unroll
                    for (int p = 0; p < 2; ++p) if (p <= (I >> 1)) { const bf16x8 a = *(const LAS bf16x8*)(L + O_ATT + (16 * I + fr) * 144 + p * 64 + kq * 16); o = MFMA16(a, Vf[p], o); }
#pragma unroll
                    for (int ks = 0; ks < 4; ++ks) { const LAS unsigned char* qp = L + O_QD + (16 * I + fr) * PIT + (32 * ks + 4 * kq) * 2;
                        const v2u lo = *(const LAS v2u*)qp, hi = *(const LAS v2u*)(qp + 32);
                        o = MFMA16(mk8(lo.x, lo.y, hi.x, hi.y), Sb[ks], o); }
#pragma unroll
                    for (int r = 0; r < 4; ++r) { const int s = s0 + 16 * I + 4 * kq + r, tok = dir ? 2047 - s : s;
                        OUT[(size_t)(b * SEQ + tok) * MIXG + h * HD + 16 * wave + fr] = o[r]; }
                }
            }
#pragma unroll
            for (int dkb = 0; dkb < 8; ++dkb) {
                const f32x4 dec = *(const LAS f32x4*)(L + O_DECL + (16 * dkb + 4 * kq) * 4);
                f32x4 s = S[dkb] * dec;
#pragma unroll
                for (int p = 0; p < 2; ++p) { const LAS unsigned char* kb_ = L + O_KD + (32 * p + 8 * kq + q4) * PIT + (16 * dkb + 4 * pp) * 2;
                    s = MFMA16(cat8(tr_read(kb_), tr_read(kb_ + 4 * PIT)), Vf[p], s); }
                S[dkb] = s;
            }
        }
        __syncthreads();
    }
#undef GLA_LOAD
}

__device__ __forceinline__ void attn_unit(Frame& F, int u) {
    const int b = u >> 8, h = (u >> 5) & 7, r = u & 31;
    const int lane = F.lane, wave = F.wave, tid = F.tid, kq = lane >> 4, fr = lane & 15, j = wave & 3, role = wave >> 2;
    LAS unsigned char* L = F.lds;
    constexpr int PIT = 272;
    constexpr int O_KW = 0, O_VW = 17408, O_KC = 34816, O_VC = 43520, O_RPB = 52224, O_MG = 0;
    const int kr0 = min(max(r - 4, 0), 24), kc0 = min(max(16 * j - 8, 0), 32);
    const int qcol = 16 * j + fr, cs = min(max(qcol - 8, 0), 48);
    for (int i = tid; i < 465; i += 512) ((LAS float*)(L + O_RPB))[i] = F.rpb[h * 465 + i];
    bf16x8 qf[4];
    { const bf16* qp = F.PX + (size_t)(b * SEQ + r * 64 + qcol) * PXW + PQN + h * HD + 8 * kq;
#pragma unroll
      for (int ks = 0; ks < 4; ++ks) qf[ks] = *(const bf16x8*)(qp + 32 * ks); }
    v4u st[6];
#define ATT_LOAD(s_) do { \
        _Pragma("unroll") for (int m = 0; m < 4; ++m) { const int p = tid + 512 * (m & 1), R = p >> 4, ch = p & 15; \
            st[m] = *(const v4u*)(F.PX + (size_t)(b * SEQ + (kr0 + (s_)) * 64 + R) * PXW + ((m < 2) ? PKN : PVN) + h * HD + ch * 8); } \
        _Pragma("unroll") for (int m = 4; m < 6; ++m) { const int R = tid >> 4, ch = tid & 15; \
            st[m] = *(const v4u*)(F.PX + (size_t)(T + b * LC + 32 * (s_) + R) * PXW + ((m == 4) ? PKN : PVN) + h * HD + ch * 8); } } while (0)
    ATT_LOAD(0);
    f32x4 O[8];
#pragma unroll
    for (int i = 0; i < 8; ++i) O[i] = (f32x4){0.f, 0.f, 0.f, 0.f};
    float mrun = -1e30f, lrun = 0.f;
    for (int s = 0; s < 8; ++s) {
        __syncthreads();
#pragma unroll
        for (int m = 0; m < 4; ++m) { const int p = tid + 512 * (m & 1), R = p >> 4, ch = p & 15; *(LAS v4u*)(L + ((m < 2) ? O_KW : O_VW) + R * PIT + ch * 16) = st[m]; }
#pragma unroll
        for (int m = 4; m < 6; ++m) { const int R = tid >> 4, ch = tid & 15; *(LAS v4u*)(L + ((m == 4) ? O_KC : O_VC) + R * PIT + ch * 16) = st[m]; }
        if (s < 7) ATT_LOAD(s + 1);
        __syncthreads();
        const int kbase = role ? 0 : kc0;
        const LAS unsigned char* Kt = L + (role ? O_KC : O_KW);
        const LAS unsigned char* Vt = L + (role ? O_VC : O_VW);
        f32x4 sc[2];
#pragma unroll
        for (int cb = 0; cb < 2; ++cb) { f32x4 a = (f32x4){0.f, 0.f, 0.f, 0.f};
#pragma unroll
            for (int ks = 0; ks < 4; ++ks) a = MFMA16(*(const LAS bf16x8*)(Kt + (kbase + 16 * cb + fr) * PIT + ks * 64 + kq * 16), qf[ks], a);
            sc[cb] = a; }
        if (role == 0) {
            const int drow = (kr0 + s) - r + 7;
#pragma unroll
            for (int cb = 0; cb < 2; ++cb)
#pragma unroll
                for (int q = 0; q < 4; ++q) { const int kc = kc0 + 16 * cb + 4 * kq + q; const bool in = (kc >= cs) && (kc < cs + 16);
                    const int dcol = min(max(kc - qcol + 15, 0), 30);
                    const float bias = ((const LAS float*)(L + O_RPB))[drow * 31 + dcol];
                    sc[cb][q] = in ? sc[cb][q] + bias : -1e30f; }
        }
        float mx = fmaxf(fmaxf(fmaxf(sc[0][0], sc[0][1]), fmaxf(sc[0][2], sc[0][3])), fmaxf(fmaxf(sc[1][0], sc[1][1]), fmaxf(sc[1][2], sc[1][3])));
        mx = fmaxf(mx, __shfl_xor(mx, 16)); mx = fmaxf(mx, __shfl_xor(mx, 32));
        const float mnew = fmaxf(mrun, mx), alpha = __expf(mrun - mnew);
        float p[8], ps = 0.f;
#pragma unroll
        for (int i = 0; i < 8; ++i) { p[i] = __expf(sc[i >> 2][i & 3] - mnew); ps += p[i]; }
        lrun = lrun * alpha + ps; mrun = mnew;
        const bf16x8 pf = mk8(pk2(p[0], p[1]), pk2(p[2], p[3]), pk2(p[4], p[5]), pk2(p[6], p[7]));
        const int q4 = fr >> 2, pp = fr & 3;
#pragma unroll
        for (int dvb = 0; dvb < 8; ++dvb) { const LAS unsigned char* vb = Vt + (kbase + 4 * kq + q4) * PIT + (16 * dvb + 4 * pp) * 2;
            O[dvb] = MFMA16(cat8(tr_read(vb), tr_read(vb + 16 * PIT)), pf, O[dvb] * alpha); }
    }
#undef ATT_LOAD
    lrun += __shfl_xor(lrun, 16); lrun += __shfl_xor(lrun, 32);
    __syncthreads();
    if (role == 1) {
        LAS float* mg = (LAS float*)(L + O_MG + j * 8704);
#pragma unroll
        for (int dvb = 0; dvb < 8; ++dvb)
#pragma unroll
            for (int q = 0; q < 4; ++q) mg[(dvb * 4 + q) * 64 + lane] = O[dvb][q];
        mg[2048 + lane] = mrun; mg[2048 + 64 + lane] = lrun;
    }
    __syncthreads();
    if (role == 0) {
        const LAS float* mg = (const LAS float*)(L + O_MG + j * 8704);
        const float m2 = mg[2048 + lane], l2 = mg[2048 + 64 + lane];
        const float m = fmaxf(mrun, m2), a1 = __expf(mrun - m), a2 = __expf(m2 - m), inv = 1.f / (lrun * a1 + l2 * a2);
        bf16* op = F.A2 + (size_t)(b * SEQ + r * 64 + qcol) * D + h * HD + 4 * kq;
#pragma unroll
        for (int dvb = 0; dvb < 8; ++dvb) { float o[4];
#pragma unroll
            for (int q = 0; q < 4; ++q) o[q] = (O[dvb][q] * a1 + mg[(dvb * 4 + q) * 64 + lane] * a2) * inv;
            v2u w; w.x = pk2(o[0], o[1]); w.y = pk2(o[2], o[3]); *(v2u*)(op + 16 * dvb) = w; }
    }
}
__device__ __forceinline__ void p3_mixer(Frame& F) {
    for (int ch = (int)blockIdx.x; ch < 128; ch += F.G) { gla_chain(F, ch); }
    for (;;) {
        if (F.tid == 0) F.MISC[0] = __hip_atomic_fetch_add((unsigned*)(F.ctl + CW_ATTQ), 1u, RLX_AGENT);
        __syncthreads();
        const int u = (int)F.MISC[0];
        if (u >= NB * HEADS * 32) break;
        attn_unit(F, u);
        __syncthreads();
    }
}

__device__ __forceinline__ void p4_hg_out(Frame& F) {
    const int gw = F.vcu * NWAVES + F.wave, NGW = F.G * NWAVES, lane = F.lane;
    for (int t = gw; t < T; t += NGW) {
        const f32x4* pf = (const f32x4*)(F.OF + (size_t)t * MIXG + 16 * lane); const f32x4* pb = (const f32x4*)(F.OB + (size_t)t * MIXG + 16 * lane);
        f32x4 o[4]; float ss = 0.f;
#pragma unroll
        for (int i = 0; i < 4; ++i) { o[i] = pf[i] + pb[i]; ss += (o[i].x * o[i].x + o[i].y * o[i].y) + (o[i].z * o[i].z + o[i].w * o[i].w); }
        ss += __shfl_xor(ss, 1); ss += __shfl_xor(ss, 2); ss += __shfl_xor(ss, 4);
        const float rstd = rsqrtf(ss * (1.f / HD) + EPS);
        const v4u* gp = (const v4u*)(F.PX + (size_t)t * PXW + PGH + 16 * lane);
        const v4u g0 = gp[0], g1 = gp[1];
        const unsigned gu[8] = {g0.x, g0.y, g0.z, g0.w, g1.x, g1.y, g1.z, g1.w};
        const f32x4* hp = (const f32x4*)(F.hg_norm + ((16 * lane) & 127));
        unsigned ow[8];
#pragma unroll
        for (int i = 0; i < 4; ++i) { const f32x4 gn = hp[i]; const f32x4 y = o[i] * rstd * gn;
            const float ga = bflo(gu[2 * i]), gb = bfhi(gu[2 * i]), gc = bflo(gu[2 * i + 1]), gd = bfhi(gu[2 * i + 1]);
            ow[2 * i] = pk2(y.x * silu_f(ga), y.y * silu_f(gb)); ow[2 * i + 1] = pk2(y.z * silu_f(gc), y.w * silu_f(gd)); }
        v4u* op = (v4u*)(F.A2 + (size_t)t * D + MIXG + 16 * lane);
        op[0] = (v4u){ow[0], ow[1], ow[2], ow[3]}; op[1] = (v4u){ow[4], ow[5], ow[6], ow[7]};
    }
}

struct EpiOutProj {
    static constexpr bool PERM = false, AFTER_DRAIN = false;
    const float* x; float* X1; const float* modf;
    __device__ __forceinline__ void operator()(const f32x4 (&acc)[2][2][4][2], const pg8::Unit& u, int wr, int wc, int fr, int fq) const {
        const int row0 = u.pm * 256 + wr * 64 + fr, col0 = u.pn * 256 + wc * 32 + 4 * fq;
        const float* g1 = modf + (size_t)(u.pm >> 3) * (6 * D) + 2 * D;
        f32x4 gv[2][2];
#pragma unroll
        for (int bj = 0; bj < 2; ++bj)
#pragma unroll
            for (int n = 0; n < 2; ++n) gv[bj][n] = *(const f32x4*)(g1 + col0 + bj * 128 + n * 16);
#pragma unroll
        for (int ai = 0; ai < 2; ++ai)
#pragma unroll
            for (int m = 0; m < 4; ++m) { const size_t ro = (size_t)(row0 + ai * 128 + m * 16) * D + col0;
#pragma unroll
                for (int bj = 0; bj < 2; ++bj)
#pragma unroll
                    for (int n = 0; n < 2; ++n) { const f32x4 xv = *(const f32x4*)(x + ro + bj * 128 + n * 16); *(f32x4*)(X1 + ro + bj * 128 + n * 16) = xv + gv[bj][n] * acc[ai][bj][m][n]; } }
    }
};

__device__ __forceinline__ void p6_router(Frame& F) {
    const int lane = F.lane, wave = F.wave, tid = F.tid, kq = lane >> 4, fr = lane & 15, g = wave & 3, kh = wave >> 2;
    LAS unsigned char* L = F.lds;
    constexpr int O_SSQ = 16384, O_LG = 16384 + 512, O_HIST = O_LG + 2 * 64 * 33 * 4, O_BASE = O_HIST + 128, O_PL = O_BASE + 128;
    for (int blk = F.vcu; blk < 256; blk += F.G) {
        const int bb = blk >> 5;
        p1_build_vec(F, bb, 3 * D, 4 * D, F.norm_ffn, false);
        if (tid < 32) ((LAS unsigned*)(L + O_HIST))[tid] = 0u;
        const int row = blk * 64 + g * 16 + fr;
        const float* xr = F.X1 + (size_t)row * D + kh * 1024 + 8 * kq;
        float ss = 0.f;
#pragma unroll 4
        for (int s = 0; s < 32; ++s) { const f32x4 a = *(const f32x4*)(xr + 32 * s), c = *(const f32x4*)(xr + 32 * s + 4);
            ss += (a.x * a.x + a.y * a.y) + (a.z * a.z + a.w * a.w) + (c.x * c.x + c.y * c.y) + (c.z * c.z + c.w * c.w); }
        ss += __shfl_xor(ss, 16); ss += __shfl_xor(ss, 32);
        if (kq == 0) ((LAS float*)(L + O_SSQ))[kh * 64 + g * 16 + fr] = ss;
        __syncthreads();
        const float rstd = rsqrtf((((LAS float*)(L + O_SSQ))[g * 16 + fr] + ((LAS float*)(L + O_SSQ))[64 + g * 16 + fr]) * (1.f / D) + EPS);
        f32x4 lg0 = (f32x4){0.f, 0.f, 0.f, 0.f}, lg1 = lg0;
        const LAS float* Av = (const LAS float*)L; const LAS float* Bv = Av + D;
        const bf16* wh = F.WRT + (size_t)fr * D + kh * 1024 + 8 * kq;
        bf16* hrow = F.HX2 + (size_t)row * D + kh * 1024 + 8 * kq;
#pragma unroll 2
        for (int s = 0; s < 32; ++s) {
            const int k = kh * 1024 + 32 * s + 8 * kq;
            const f32x4 a = *(const f32x4*)(xr + 32 * s), c = *(const f32x4*)(xr + 32 * s + 4);
            const f32x4 A0 = *(const LAS f32x4*)(Av + k), A1 = *(const LAS f32x4*)(Av + k + 4), B0 = *(const LAS f32x4*)(Bv + k), B1 = *(const LAS f32x4*)(Bv + k + 4);
            const f32x4 h0 = a * rstd * A0 + B0, h1 = c * rstd * A1 + B1;
            const unsigned u0 = pk2(h0.x, h0.y), u1 = pk2(h0.z, h0.w), u2 = pk2(h1.x, h1.y), u3 = pk2(h1.z, h1.w);
            *(v4u*)(hrow + 32 * s) = (v4u){u0, u1, u2, u3};
            const unsigned l0 = pk2(h0.x - bflo(u0), h0.y - bfhi(u0)), l1 = pk2(h0.z - bflo(u1), h0.w - bfhi(u1)), l2 = pk2(h1.x - bflo(u2), h1.y - bfhi(u2)), l3 = pk2(h1.z - bflo(u3), h1.w - bfhi(u3));
            const bf16x8 hh = mk8(u0, u1, u2, u3), hl = mk8(l0, l1, l2, l3);
            const bf16x8 w0h = *(const bf16x8*)(wh + 32 * s), w1h = *(const bf16x8*)(wh + 16 * D + 32 * s);
            const bf16x8 w0l = *(const bf16x8*)(wh + NE * D + 32 * s), w1l = *(const bf16x8*)(wh + NE * D + 16 * D + 32 * s);
            lg0 = MFMA16(hh, w0h, lg0); lg0 = MFMA16(hh, w0l, lg0); lg0 = MFMA16(hl, w0h, lg0);
            lg1 = MFMA16(hh, w1h, lg1); lg1 = MFMA16(hh, w1l, lg1); lg1 = MFMA16(hl, w1h, lg1);
        }
        { LAS float* lg = (LAS float*)(L + O_LG) + kh * 64 * 33;
#pragma unroll
          for (int r = 0; r < 4; ++r) { lg[(g * 16 + 4 * kq + r) * 33 + fr] = lg0[r]; lg[(g * 16 + 4 * kq + r) * 33 + 16 + fr] = lg1[r]; } }
        __syncthreads();
        int e4[4] = {0, 0, 0, 0}; int pl4[4] = {0, 0, 0, 0};
        if (tid < 64) {
            LAS float* lg = (LAS float*)(L + O_LG) + tid * 33;
            for (int e = 0; e < 32; ++e) lg[e] = lg[e] + lg[64 * 33 + e] + F.b_router[e];
            float v4[4];
#pragma unroll
            for (int p = 0; p < 4; ++p) { float best = -3.0e38f; int bi = 0;
                for (int e = 0; e < 32; ++e) { const float v = lg[e]; const bool used = (p > 0 && e == e4[0]) || (p > 1 && e == e4[1]) || (p > 2 && e == e4[2]); if (!used && v > best) { best = v; bi = e; } }
                e4[p] = bi; v4[p] = best; }
            const float e1 = __expf(v4[1] - v4[0]), e2 = __expf(v4[2] - v4[0]), e3 = __expf(v4[3] - v4[0]), inv = 1.f / (1.f + e1 + e2 + e3);
            const int t = blk * 64 + tid;
            *(f32x4*)(F.RT_G + (size_t)t * 4) = (f32x4){inv, e1 * inv, e2 * inv, e3 * inv};
            *(int4*)(F.RT_E + (size_t)t * 4) = make_int4(e4[0], e4[1], e4[2], e4[3]);
#pragma unroll
            for (int p = 0; p < 4; ++p) pl4[p] = (int)__hip_atomic_fetch_add((LAS unsigned*)(L + O_HIST) + e4[p], 1u, __ATOMIC_RELAXED, __HIP_MEMORY_SCOPE_WORKGROUP);
        }
        __syncthreads();
        if (tid < 32) { const unsigned c = ((LAS unsigned*)(L + O_HIST))[tid]; ((LAS unsigned*)(L + O_BASE))[tid] = c ? __hip_atomic_fetch_add((unsigned*)(F.ctl + CW_CNT + 64 * tid), c, RLX_AGENT) : 0u; }
        __syncthreads();
        if (tid < 64) { const int t = blk * 64 + tid; const LAS unsigned* base = (const LAS unsigned*)(L + O_BASE);
            *(int4*)(F.RT_POS + (size_t)t * 4) = make_int4((int)base[e4[0]] + pl4[0], (int)base[e4[1]] + pl4[1], (int)base[e4[2]] + pl4[2], (int)base[e4[3]] + pl4[3]); }
        __syncthreads();
    }
}

__device__ __forceinline__ int moe_tables(Frame& F) {
    LAS unsigned char* tile_e = F.lds + TILE_OFF; LAS int* offt = (LAS int*)(F.lds + OFFT_OFF);
    if (F.tid < 32) { int off = 0, mine = 0;
        for (int e = 0; e < 32; ++e) { const int c = (int)__hip_atomic_load((unsigned*)(F.ctl + CW_CNT + 64 * e), RLX_AGENT); const int nt = (c + 255) >> 8; if (e < F.tid) off += nt; if (e == F.tid) mine = nt; }
        offt[F.tid] = off; for (int t = 0; t < mine; ++t) tile_e[off + t] = (unsigned char)F.tid;
        if (F.tid == 31) offt[32] = off + mine; }
    __syncthreads();
    return offt[32];
}
struct MoeOrder {
    int nM, nN, nwg, G, c; const LAS unsigned char* tile_e;
    __device__ void init(int nM_, int nN_, int G_, int c_, const LAS unsigned char* te) { nM = nM_; nN = nN_; nwg = nM * nN; G = G_; c = c_; tile_e = te; }
    __device__ bool next(int i, pg8::Unit& u) const {
        const long Lq = (long)i * G + c; if (Lq >= nwg) return false;
        int wgid = (int)Lq; { const int q = nwg / 8, r = nwg % 8, xcd = wgid % 8, off = wgid / 8; wgid = (xcd < r ? xcd * (q + 1) : r * (q + 1) + (xcd - r) * q) + off; }
        const int nig = 8 * nN, gid = wgid / nig, fm = gid * 8, gsz = (nM - fm) < 8 ? (nM - fm) : 8;
        u.pm = fm + ((wgid % nig) % gsz); u.pn = (int)tile_e[u.pm] * nN + (wgid % nig) / gsz; return true;
    }
    __device__ __forceinline__ void a_ready(const pg8::Unit&) const {}
    __device__ __forceinline__ void done(const pg8::Unit&) const {}
};
__device__ __forceinline__ void p7_gather(Frame& F) {
    (void)moe_tables(F);
    const LAS int* offt = (const LAS int*)(F.lds + OFFT_OFF);
    for (int blk = F.vcu; blk < 256; blk += F.G) {
        for (int a = F.wave; a < 256; a += NWAVES) {
            const int t = blk * 64 + (a >> 2), idx = t * 4 + (a & 3);
            const int e = F.RT_E[idx], pos = F.RT_POS[idx], slot = offt[e] * 256 + pos;
            if (F.lane == 0) F.RT_SLOT[idx] = slot;
            const v4u* src = (const v4u*)(F.HX2 + (size_t)t * D) + F.lane; v4u* dst = (v4u*)(F.XG + (size_t)slot * D) + F.lane;
#pragma unroll
            for (int j = 0; j < 4; ++j) dst[64 * j] = src[64 * j];
        }
    }
}
struct EpiSwiglu {
    static constexpr bool PERM = true, AFTER_DRAIN = false;
    bf16* H; const float* b_gu;
    __device__ __forceinline__ void operator()(const f32x4 (&acc)[2][2][4][2], const pg8::Unit& u, int wr, int wc, int fr, int fq) const {
        const int e = u.pn >> 4, pl = u.pn & 15, row0 = u.pm * 256 + wr * 64 + fr, ccol = pl * 128 + wc * 32 + 8 * fq;
        const float* bg = b_gu + (size_t)e * 4096 + ccol;
        const f32x4 bg0 = *(const f32x4*)bg, bg1 = *(const f32x4*)(bg + 4), bl0 = *(const f32x4*)(bg + 2048), bl1 = *(const f32x4*)(bg + 2052);
#pragma unroll
        for (int ai = 0; ai < 2; ++ai)
#pragma unroll
            for (int m = 0; m < 4; ++m) { float y[8];
#pragma unroll
                for (int i = 0; i < 8; ++i) { const float gl = acc[ai][0][m][i >> 2][i & 3] + ((i < 4) ? bg0[i & 3] : bg1[i & 3]); const float ln = acc[ai][1][m][i >> 2][i & 3] + ((i < 4) ? bl0[i & 3] : bl1[i & 3]);
                    const float xg = fminf(gl, 7.f), xl = fminf(fmaxf(ln, -7.f), 7.f); y[i] = xg / (1.f + __expf(-1.702f * xg)) * (xl + 1.f); }
                v4u w; w.x = pk2(y[0], y[1]); w.y = pk2(y[2], y[3]); w.z = pk2(y[4], y[5]); w.w = pk2(y[6], y[7]);
                *(v4u*)(H + (size_t)(row0 + ai * 128 + m * 16) * FF + ccol) = w; }
    }
};
struct EpiDown {
    static constexpr bool PERM = true, AFTER_DRAIN = false;
    bf16* Y; const float* b_down;
    __device__ __forceinline__ void operator()(const f32x4 (&acc)[2][2][4][2], const pg8::Unit& u, int wr, int wc, int fr, int fq) const {
        const int e = u.pn >> 3, pl = u.pn & 7, row0 = u.pm * 256 + wr * 64 + fr, col0 = pl * 256 + wc * 32 + 8 * fq;
        f32x4 bv[2][2];
#pragma unroll
        for (int bj = 0; bj < 2; ++bj)
#pragma unroll
            for (int n = 0; n < 2; ++n) bv[bj][n] = *(const f32x4*)(b_down + (size_t)e * D + col0 + bj * 128 + 4 * n);
#pragma unroll
        for (int ai = 0; ai < 2; ++ai)
#pragma unroll
            for (int m = 0; m < 4; ++m) { bf16* rowp = Y + (size_t)(row0 + ai * 128 + m * 16) * D + col0;
#pragma unroll
                for (int bj = 0; bj < 2; ++bj) { const f32x4 v0 = acc[ai][bj][m][0] + bv[bj][0], v1 = acc[ai][bj][m][1] + bv[bj][1];
                    v4u w; w.x = pk2(v0[0], v0[1]); w.y = pk2(v0[2], v0[3]); w.z = pk2(v1[0], v1[1]); w.w = pk2(v1[2], v1[3]);
                    *(v4u*)(rowp + bj * 128) = w; } }
    }
};
__device__ __forceinline__ void p10_final(Frame& F) {
    const int gw = F.vcu * NWAVES + F.wave, NGW = F.G * NWAVES, lane = F.lane;
    for (int t = gw; t < T; t += NGW) {
        const int4 sl = *(const int4*)(F.RT_SLOT + (size_t)t * 4); const f32x4 gt = *(const f32x4*)(F.RT_G + (size_t)t * 4);
        const float* g2 = F.MODF + (size_t)(t >> 11) * (6 * D) + 5 * D;
        const f32x4* xr = (const f32x4*)(F.X1 + (size_t)t * D) + lane;
        const v2u* y0 = (const v2u*)(F.Y + (size_t)sl.x * D) + lane; const v2u* y1 = (const v2u*)(F.Y + (size_t)sl.y * D) + lane;
        const v2u* y2 = (const v2u*)(F.Y + (size_t)sl.z * D) + lane; const v2u* y3 = (const v2u*)(F.Y + (size_t)sl.w * D) + lane;
        f32x4 v[8]; float ss = 0.f;
#pragma unroll
        for (int j = 0; j < 8; ++j) { const v2u a = y0[64 * j], b = y1[64 * j], c = y2[64 * j], d = y3[64 * j];
            f32x4 m;
            m.x = gt.x * bflo(a.x) + gt.y * bflo(b.x) + gt.z * bflo(c.x) + gt.w * bflo(d.x);
            m.y = gt.x * bfhi(a.x) + gt.y * bfhi(b.x) + gt.z * bfhi(c.x) + gt.w * bfhi(d.x);
            m.z = gt.x * bflo(a.y) + gt.y * bflo(b.y) + gt.z * bflo(c.y) + gt.w * bflo(d.y);
            m.w = gt.x * bfhi(a.y) + gt.y * bfhi(b.y) + gt.z * bfhi(c.y) + gt.w * bfhi(d.y);
            const f32x4 gg = *((const f32x4*)g2 + lane + 64 * j);
            v[j] = xr[64 * j] + gg * m; ss += (v[j].x * v[j].x + v[j].y * v[j].y) + (v[j].z * v[j].z + v[j].w * v[j].w); }
        const float rstd = rsqrtf(wave_sum(ss) * (1.f / D) + EPS);
        f32x4* op = (f32x4*)(F.out + (size_t)t * D) + lane;
#pragma unroll
        for (int j = 0; j < 8; ++j) op[64 * j] = v[j] * rstd * *((const f32x4*)F.norm_final + lane + 64 * j);
    }
}

struct Args { const float* in[20]; float* out; unsigned char* ws; int ph_lo, ph_hi, li, pad; };
__global__ void __launch_bounds__(NWAVES * 64, 2) mk_fwd(Args args) {
    extern __shared__ __attribute__((aligned(16))) unsigned char lds[];
    Frame F;
    F.lds = (LAS unsigned char*)lds;
    F.MISC = (volatile LAS unsigned*)(F.lds + MISC_OFF);
    F.tid = threadIdx.x; F.lane = F.tid & 63; F.wave = __builtin_amdgcn_readfirstlane(F.tid >> 6);
    F.G = gridDim.x; { const int bx = blockIdx.x; F.vcu = (F.G % 8 == 0) ? (bx % 8) * (F.G / 8) + bx / 8 : bx; }
    unsigned char* ws = args.ws;
    F.ctl = (gu32*)(ws + WS_CTL);
    F.x = args.in[0]; F.c = args.in[1]; F.ctx = args.in[2]; F.c_ctx = args.in[3]; F.w_ada = args.in[4]; F.b_ada = args.in[5]; F.norm_mix = args.in[6]; F.norm_ffn = args.in[7];
    F.w_in = args.in[8]; F.lb_table = args.in[9]; F.hg_norm = args.in[10]; F.rpb = args.in[11]; F.w_out = args.in[12]; F.w_router = args.in[13]; F.b_router = args.in[14];
    F.w_gu = args.in[15]; F.b_gu = args.in[16]; F.w_down = args.in[17]; F.b_down = args.in[18]; F.norm_final = args.in[19]; F.out = args.out;
    F.MODP = (float*)(ws + WS_MODP); F.MODF = (float*)(ws + WS_MODF); F.OF = (float*)(ws + WS_OF); F.OB = (float*)(ws + WS_OB); F.X1 = (float*)(ws + WS_X1);
    F.WRT = (bf16*)(ws + WS_WRT); F.WIN = (bf16*)(ws + WS_WIN); F.WOUT = (bf16*)(ws + WS_WOUT); F.HXN = (bf16*)(ws + WS_HXN); F.PX = (bf16*)(ws + WS_PX); F.A2 = (bf16*)(ws + WS_A2);
    F.HX2 = (bf16*)(ws + WS_HX2); F.XG = (bf16*)(ws + WS_XG); F.H = (bf16*)(ws + WS_H); F.Y = (bf16*)(ws + WS_Y); F.WGU = (bf16*)(ws + WS_WGU); F.WD = (bf16*)(ws + WS_WD);
    F.RT_E = (int*)(ws + WS_RT); F.RT_POS = F.RT_E + T * 4; F.RT_G = (float*)(F.RT_POS + T * 4); F.RT_SLOT = (int*)(F.RT_G + T * 4);
    for (int u = F.tid; u < (LDS_BYTES - LDSCTL_OFF) / 4; u += NWAVES * 64) ((LAS unsigned*)(F.lds + LDSCTL_OFF))[u] = 0u;
    __syncthreads();
    XcdBarrier bar; bar.bar = (unsigned*)(F.ctl + CW_BAR); bar.x = 0; bar.st = nullptr;
    if (N_LAUNCHES == 1) bar = xcd_barrier_post((unsigned*)(F.ctl + CW_BAR), F.MISC + 8);
#define GRID_BAR() do { if (N_LAUNCHES == 1) xcd_barrier(bar); } while (0)
    const int lo = args.ph_lo, hi = args.ph_hi;
#define IN(k) (lo <= (k) && (k) < hi)
#define BOTH(k) (IN(k) && IN((k) + 1))
    if (IN(0)) { p0_prologue(F); if (BOTH(0)) GRID_BAR(); }
    if (IN(1)) { p1_norm(F); if (BOTH(1)) GRID_BAR(); }
    if (IN(2)) {
        pg8::Gemm g{F.HXN, F.WIN, MTOT, 8192, D}; InProjOrder S; S.init(F.G, (int)blockIdx.x);
        EpiInProj E{F.PX, F.lb_table};
        pg8::gemm_phase<EpiInProj, InProjOrder, PG8_ALIGN, PG8_SP2>(F.lds + RING_OFF, g, S, E);
        if (BOTH(2)) GRID_BAR();
    }
    if (IN(3)) { p3_mixer(F); if (BOTH(3)) GRID_BAR(); }
    if (IN(4)) { p4_hg_out(F); if (BOTH(4)) GRID_BAR(); }
    if (IN(5)) {
        pg8::Gemm g{F.A2, F.WOUT, T, D, D}; pg8::StaticOrder S; S.init(T, D, F.G, (int)blockIdx.x);
        EpiOutProj E{F.x, F.X1, F.MODF};
        pg8::gemm_phase<EpiOutProj, pg8::StaticOrder, PG8_ALIGN, PG8_SP2>(F.lds + RING_OFF, g, S, E);
        if (BOTH(5)) GRID_BAR();
    }
    if (IN(6)) { p6_router(F); if (BOTH(6)) GRID_BAR(); }
    if (IN(7)) { p7_gather(F); if (BOTH(7)) GRID_BAR(); }
    if (IN(8)) {
        const int NT = moe_tables(F);
        pg8::Gemm g{F.XG, F.WGU, CAP, NE * 4096, D}; MoeOrder S; S.init(NT, 16, F.G, (int)blockIdx.x, F.lds + TILE_OFF);
        EpiSwiglu E{F.H, F.b_gu};
        pg8::gemm_phase<EpiSwiglu, MoeOrder, PG8_ALIGN, PG8_SP2>(F.lds + RING_OFF, g, S, E);
        if (BOTH(8)) GRID_BAR();
    }
    if (IN(9)) {
        const int NT = moe_tables(F);
        pg8::Gemm g{F.H, F.WD, CAP, NE * 2048, FF}; MoeOrder S; S.init(NT, 8, F.G, (int)blockIdx.x, F.lds + TILE_OFF);
        EpiDown E{F.Y, F.b_down};
        pg8::gemm_phase<EpiDown, MoeOrder, PG8_ALIGN, PG8_SP2>(F.lds + RING_OFF, g, S, E);
        if (BOTH(9)) GRID_BAR();
    }
    if (IN(10)) { p10_final(F); }
#undef IN
#undef BOTH
}

extern "C" void kernel_launch(void* const* d_in, const int* in_sizes, int n_in, void* d_out, int out_size, void* d_ws, size_t ws_size, hipStream_t stream) {
    static int grid = 0;
    if (grid == 0) {
        if (n_in != 20 || out_size != T * D || ws_size < WS_END) { fprintf(stderr, "kernel_launch: unexpected shapes (n_in %d out %d ws %zu)\n", n_in, out_size, ws_size); grid = -1; return; }
        int dev = 0, cus = 0, per_cu = 0;
        if (hipGetDevice(&dev) != hipSuccess || hipDeviceGetAttribute(&cus, hipDeviceAttributeMultiprocessorCount, dev) != hipSuccess) { grid = -1; return; }
        if (hipFuncSetAttribute((const void*)mk_fwd, hipFuncAttributeMaxDynamicSharedMemorySize, LDS_BYTES) != hipSuccess) { fprintf(stderr, "kernel_launch: hipFuncSetAttribute failed\n"); grid = -1; return; }
        if (hipOccupancyMaxActiveBlocksPerMultiprocessor(&per_cu, (const void*)mk_fwd, NWAVES * 64, LDS_BYTES) != hipSuccess || per_cu < 1)
            fprintf(stderr, "kernel_launch: occupancy query reports %d workgroups per CU\n", per_cu);
        (void)hipGetLastError();
        grid = cus;
    }
    if (grid < 0) return;
    if (hipMemsetAsync((char*)d_ws + WS_CTL, 0, CTL_ZERO_BYTES, stream) != hipSuccess) return;
    Args a{};
    for (int i = 0; i < 20; ++i) a.in[i] = (const float*)d_in[i];
    a.out = (float*)d_out; a.ws = (unsigned char*)d_ws;
    for (int li = 0; li < N_LAUNCHES; ++li) {
        a.ph_lo = (N_LAUNCHES == 1) ? 0 : li; a.ph_hi = (N_LAUNCHES == 1) ? NPHASE : li + 1; a.li = li; a.pad = 0;
        hipLaunchKernelGGL(mk_fwd, dim3(grid), dim3(NWAVES * 64), LDS_BYTES, stream, a);
        const hipError_t le = hipPeekAtLastError();
        if (le != hipSuccess) { fprintf(stderr, "kernel_launch: launch %d failed: %s\n", li, hipGetErrorName(le)); break; }
    }
}
```

```cpp
#include <hip/hip_runtime.h>
#include <cstdio>
#include <cstdint>
namespace pg8 {
#define PG8_LAS __attribute__((address_space(3)))
typedef unsigned short bf16_t;
typedef short bf16x8 __attribute__((ext_vector_type(8)));
typedef float f32x4 __attribute__((ext_vector_type(4)));
typedef unsigned u32x4 __attribute__((ext_vector_type(4)));
constexpr int BM = 256, BK = 64, HALF = 128, HTB = HALF * BK * 2  , STAGE_BYTES = 8 * HTB, NXCD = 8, WGM = 8;

__host__ __device__ __forceinline__ int lds_byte(int r, int c) { const int st = (r >> 4) * 2 + (c >> 5), rr = r & 15, cc = c & 31, ob = rr * 64 + cc * 2; return st * 1024 + (ob ^ (((ob >> 9) & 1) << 5)); }
__host__ __device__ __forceinline__ void stage_rc(int b, int& R, int& C) { const int st = b / 1024, sb = b % 1024, swz = sb ^ (((sb >> 9) & 1) << 5); R = (st >> 1) * 16 + swz / 64; C = (st & 1) * 32 + (swz % 64) / 2; }
__host__ __device__ __forceinline__ int perm32(int rho) { const int n = rho >> 4, i = rho & 15; return 8 * (i >> 2) + 4 * n + (i & 3); }

struct Unit { int pm, pn; };
struct Gemm { const bf16_t* A; const bf16_t* Bt; int M, N, K; };

struct StaticOrder {
    int nM, nN, nwg, G, c;
    __host__ __device__ void init(int M, int N, int G_, int c_) { nM = M / BM; nN = N / BM; nwg = nM * nN; G = G_; c = c_; }
    __host__ __device__ bool next(int i, Unit& u) const {
        const long L = (long)i * G + c; if (L >= nwg) return false;
        int wgid = (int)L; { const int q = nwg / NXCD, r = nwg % NXCD, xcd = wgid % NXCD, off = wgid / NXCD; wgid = (xcd < r ? xcd * (q + 1) : r * (q + 1) + (xcd - r) * q) + off; }
        const int nig = WGM * nN, gid = wgid / nig, fm = gid * WGM, gsz = (nM - fm) < WGM ? (nM - fm) : WGM;
        u.pm = fm + ((wgid % nig) % gsz); u.pn = (wgid % nig) / gsz; return true;
    }
    __device__ __forceinline__ void a_ready(const Unit&) const {}
    __device__ __forceinline__ void done(const Unit&) const {}
};

__device__ __forceinline__ unsigned cvt_pk_bf16(float lo, float hi) { unsigned r; asm volatile("v_cvt_pk_bf16_f32 %0, %1, %2" : "=v"(r) : "v"(lo), "v"(hi)); return r; }
typedef int v8i32 __attribute__((ext_vector_type(8))); typedef int v4i32 __attribute__((ext_vector_type(4)));
__device__ __forceinline__ v8i32 cat_i8(bf16x8 a, bf16x8 b) { const v4i32 x = __builtin_bit_cast(v4i32, a), y = __builtin_bit_cast(v4i32, b); return __builtin_shufflevector(x, y, 0, 1, 2, 3, 4, 5, 6, 7); }
template <class Epi, class Sched, bool ALIGN_EPI = false, bool SP2 = false, bool F8 = false>
__device__ __forceinline__ void gemm_phase(PG8_LAS unsigned char* lds, const Gemm g, const Sched& S, const Epi& E) {
    const int tid = threadIdx.x, wid = __builtin_amdgcn_readfirstlane(tid >> 6), lane = tid & 63, wr = wid >> 2, wc = wid & 3, fr = lane & 15, fq = lane >> 4;
    const int K = g.K, PB = F8 ? K : 2 * K  , nt = PB / 128;
    unsigned voffA[2], voffB[2];
#pragma unroll
    for (int i = 0; i < 2; ++i) { int R, C; stage_rc(tid * 16 + i * 8192, R, C); const int Rb = Epi::PERM ? ((R & ~31) + perm32(R & 31)) : R;
        voffA[i] = (unsigned)(R * PB + C * 2); voffB[i] = (unsigned)(Rb * PB + C * 2); }
    const size_t kstep = (size_t)(BK * 2);
    const size_t hstep = (size_t)HALF * PB;
    const size_t tstep = 2 * hstep;
    const unsigned ldsw = (unsigned)wid * 1024u;
    const int aoff = lds_byte(wr * 64 + fr, fq * 8), boff = lds_byte(wc * 32 + fr, fq * 8);
#define PG8_SA(b, h) (((b) * 2 + (h)) * HTB)
#define PG8_SB(b, h) ((4 + (b) * 2 + (h)) * HTB)
#define PG8_STAGE(bufoff, gbase, voff) do { _Pragma("unroll") for (int _i = 0; _i < 2; ++_i) \
        __builtin_amdgcn_global_load_lds((const unsigned*)((const char*)(gbase) + (voff)[_i]), (PG8_LAS unsigned*)(lds + (bufoff) + ldsw + _i * 8192), 16, 0, 0); } while (0)
#define PG8_LDA(dst, b, h) do { _Pragma("unroll") for (int m = 0; m < 4; ++m) { if constexpr (F8) { dst##8[m] = cat_i8(*(const PG8_LAS bf16x8*)(lds + PG8_SA(b, h) + aoff + m * 2048), *(const PG8_LAS bf16x8*)(lds + PG8_SA(b, h) + aoff + m * 2048 + 1024)); } \
        else { _Pragma("unroll") for (int k = 0; k < 2; ++k) dst[m][k] = *(const PG8_LAS bf16x8*)(lds + PG8_SA(b, h) + aoff + m * 2048 + k * 1024); } } } while (0)
#define PG8_LDB(dst, b, h) do { _Pragma("unroll") for (int n = 0; n < 2; ++n) { if constexpr (F8) { dst##8[n] = cat_i8(*(const PG8_LAS bf16x8*)(lds + PG8_SB(b, h) + boff + n * 2048), *(const PG8_LAS bf16x8*)(lds + PG8_SB(b, h) + boff + n * 2048 + 1024)); } \
        else { _Pragma("unroll") for (int k = 0; k < 2; ++k) dst[n][k] = *(const PG8_LAS bf16x8*)(lds + PG8_SB(b, h) + boff + n * 2048 + k * 1024); } } } while (0)
#define PG8_MMA(ai, bj, At, Bt) do { __builtin_amdgcn_s_setprio(1); _Pragma("unroll") for (int m = 0; m < 4; ++m) _Pragma("unroll") for (int n = 0; n < 2; ++n) { \
        if constexpr (F8) { asm volatile("v_mfma_scale_f32_16x16x128_f8f6f4 %0, %1, %2, %0, %3, %3 op_sel_hi:[0,0,0]" : "+v"(acc[ai][bj][m][n]) : "v"(Bt##8[n]), "v"(At##8[m]), "v"(f8scale)); } \
        else { _Pragma("unroll") for (int k = 0; k < 2; ++k) acc[ai][bj][m][n] = __builtin_amdgcn_mfma_f32_16x16x32_bf16(Bt[n][k], At[m][k], acc[ai][bj][m][n], 0, 0, 0); } } \
        __builtin_amdgcn_s_setprio(0); } while (0)
#define PG8_WAIT_V(n) asm volatile("s_waitcnt vmcnt(" #n ")" ::: "memory")
#define PG8_WAIT_L(n) asm volatile("s_waitcnt lgkmcnt(" #n ")" ::: "memory")
#define PG8_BAR __builtin_amdgcn_s_barrier()
#define PG8_SCHED __builtin_amdgcn_sched_barrier(0)
    Unit cur, nxt; int ui = 0;
    if (!S.next(0, cur)) return;
    f32x4 acc[2][2][4][2];
#pragma unroll
    for (int a = 0; a < 2; ++a)
#pragma unroll
        for (int b = 0; b < 2; ++b)
#pragma unroll
            for (int m = 0; m < 4; ++m)
#pragma unroll
                for (int n = 0; n < 2; ++n) acc[a][b][m][n] = (f32x4){0.f, 0.f, 0.f, 0.f};
    bf16x8 At[4][2], B0[2][2], B1[2][2]; v8i32 At8[4], B08[2], B18[2]; const int f8scale = 0x7F7F7F7F;
    const char* cA = (const char*)g.A + (size_t)cur.pm * tstep; const char* cB = (const char*)g.Bt + (size_t)cur.pn * tstep;
    S.a_ready(cur);
    if constexpr (SP2) {
        PG8_STAGE(PG8_SB(0, 0), cB, voffB); PG8_STAGE(PG8_SB(0, 1), cB + hstep, voffB); PG8_STAGE(PG8_SA(0, 0), cA, voffA); PG8_STAGE(PG8_SA(0, 1), cA + hstep, voffA);
        if (wr == 1) PG8_BAR;
        PG8_WAIT_V(2); PG8_BAR;
        PG8_STAGE(PG8_SB(1, 0), cB + kstep, voffB); PG8_STAGE(PG8_SA(1, 0), cA + kstep, voffA); PG8_STAGE(PG8_SB(1, 1), cB + hstep + kstep, voffB);
        PG8_WAIT_V(6); PG8_BAR;
    } else {
        PG8_STAGE(PG8_SB(0, 0), cB, voffB); PG8_STAGE(PG8_SA(0, 0), cA, voffA); PG8_STAGE(PG8_SB(0, 1), cB + hstep, voffB); PG8_STAGE(PG8_SA(0, 1), cA + hstep, voffA);
        if (wr == 1) PG8_BAR;
        PG8_WAIT_V(4); PG8_BAR;
        PG8_STAGE(PG8_SB(1, 0), cB + kstep, voffB); PG8_STAGE(PG8_SA(1, 0), cA + kstep, voffA); PG8_STAGE(PG8_SB(1, 1), cB + hstep + kstep, voffB);
        PG8_WAIT_V(6); PG8_BAR;
    }
    for (;;) {
        const bool has_next = S.next(ui + 1, nxt);
        const char* nA = has_next ? (const char*)g.A + (size_t)nxt.pm * tstep : cA; const char* nB = has_next ? (const char*)g.Bt + (size_t)nxt.pn * tstep : cB;
        for (int t = 0; t < nt; t += 2) {
            const bool last = (t == nt - 2);
            const char* a1 = cA + (size_t)(t + 1) * kstep;
            const char* a2 = last ? nA : cA + (size_t)(t + 2) * kstep; const char* b2 = last ? nB : cB + (size_t)(t + 2) * kstep;
            const char* a3 = a2 + kstep; const char* b3 = b2 + kstep;
            if (last && has_next) S.a_ready(nxt);
            if constexpr (SP2) {
            PG8_LDB(B0, 0, 0); PG8_LDB(B1, 0, 1); PG8_SCHED; PG8_LDA(At, 0, 0); PG8_STAGE(PG8_SA(1, 1), a1 + hstep, voffA);
            PG8_WAIT_V(8); PG8_WAIT_L(0); PG8_BAR; PG8_MMA(0, 0, At, B0); PG8_MMA(0, 1, At, B1); PG8_BAR; PG8_SCHED;
            PG8_LDA(At, 0, 1); PG8_STAGE(PG8_SB(0, 0), b2, voffB); PG8_STAGE(PG8_SB(0, 1), b2 + hstep, voffB); PG8_STAGE(PG8_SA(0, 0), a2, voffA);
            PG8_WAIT_V(8); PG8_WAIT_L(0); PG8_BAR; PG8_MMA(1, 0, At, B0); PG8_MMA(1, 1, At, B1); PG8_BAR; PG8_SCHED;
            PG8_LDB(B0, 1, 0); PG8_LDB(B1, 1, 1); PG8_SCHED; PG8_LDA(At, 1, 0); PG8_STAGE(PG8_SA(0, 1), a2 + hstep, voffA);
            PG8_WAIT_V(8); PG8_WAIT_L(0); PG8_BAR; PG8_MMA(0, 0, At, B0); PG8_MMA(0, 1, At, B1); PG8_BAR; PG8_SCHED;
            PG8_LDA(At, 1, 1); PG8_STAGE(PG8_SB(1, 0), b3, voffB); PG8_STAGE(PG8_SB(1, 1), b3 + hstep, voffB); PG8_STAGE(PG8_SA(1, 0), a3, voffA);
            PG8_WAIT_V(8); PG8_WAIT_L(0); PG8_BAR; PG8_MMA(1, 0, At, B0); PG8_MMA(1, 1, At, B1); PG8_BAR; PG8_SCHED;
            } else {
            PG8_LDB(B0, 0, 0); PG8_SCHED; PG8_LDA(At, 0, 0); PG8_STAGE(PG8_SA(1, 1), a1 + hstep, voffA);
            PG8_WAIT_L(8); PG8_BAR; PG8_WAIT_L(0); PG8_MMA(0, 0, At, B0); PG8_BAR; PG8_SCHED;
            PG8_LDB(B1, 0, 1); PG8_STAGE(PG8_SB(0, 0), b2, voffB);
            PG8_BAR; PG8_WAIT_L(0); PG8_MMA(0, 1, At, B1); PG8_BAR;
            PG8_LDA(At, 0, 1); PG8_STAGE(PG8_SA(0, 0), a2, voffA);
            PG8_BAR; PG8_WAIT_L(0); PG8_MMA(1, 0, At, B0); PG8_BAR; PG8_SCHED;
            PG8_STAGE(PG8_SB(0, 1), b2 + hstep, voffB);
            PG8_WAIT_V(6); PG8_BAR; PG8_MMA(1, 1, At, B1); PG8_BAR;
            PG8_LDB(B0, 1, 0); PG8_SCHED; PG8_LDA(At, 1, 0); PG8_STAGE(PG8_SA(0, 1), a2 + hstep, voffA);
            PG8_WAIT_L(8); PG8_BAR; PG8_WAIT_L(0); PG8_MMA(0, 0, At, B0); PG8_BAR; PG8_SCHED;
            PG8_LDB(B1, 1, 1); PG8_STAGE(PG8_SB(1, 0), b3, voffB);
            PG8_BAR; PG8_WAIT_L(0); PG8_MMA(0, 1, At, B1); PG8_BAR;
            PG8_LDA(At, 1, 1); PG8_STAGE(PG8_SA(1, 0), a3, voffA);
            PG8_BAR; PG8_WAIT_L(0); PG8_MMA(1, 0, At, B0); PG8_BAR; PG8_SCHED;
            PG8_STAGE(PG8_SB(1, 1), b3 + hstep, voffB);
            PG8_WAIT_V(6); PG8_BAR; PG8_MMA(1, 1, At, B1); PG8_BAR;
            }
        }
        if constexpr (ALIGN_EPI) { if (wr == 0) PG8_BAR; }
        if constexpr (F8) { asm volatile("s_nop 15\n\ts_nop 15" ::: "memory"); }
        if constexpr (!Epi::AFTER_DRAIN) { E(acc, cur, wr, wc, fr, fq); S.done(cur); }
        if (!has_next) break;
#pragma unroll
        for (int a = 0; a < 2; ++a)
#pragma unroll
            for (int b = 0; b < 2; ++b)
#pragma unroll
                for (int m = 0; m < 4; ++m)
#pragma unroll
                    for (int n = 0; n < 2; ++n) acc[a][b][m][n] = (f32x4){0.f, 0.f, 0.f, 0.f};
        cur = nxt; cA = nA; cB = nB; ++ui;
        if constexpr (ALIGN_EPI) { if (wr == 1) PG8_BAR; }
    }
    PG8_WAIT_V(0);
    if constexpr (!ALIGN_EPI) { if (wr == 0) PG8_BAR; }
    PG8_BAR;
    if constexpr (Epi::AFTER_DRAIN) { E.fused(acc, cur, wr, wc, fr, fq, lds, wid, lane); S.done(cur); }
#undef PG8_SA
#undef PG8_SB
#undef PG8_STAGE
#undef PG8_LDA
#undef PG8_LDB
#undef PG8_MMA
#undef PG8_WAIT_V
#undef PG8_WAIT_L
#undef PG8_BAR
#undef PG8_SCHED
}
}

#ifndef PG8_SP2
#define PG8_SP2 true
#endif
#ifndef PG8_ALIGN
#define PG8_ALIGN true
#endif
constexpr int NWAVES = 8;
#ifndef MK_N_LAUNCHES
#define MK_N_LAUNCHES 1
#endif
constexpr int NPHASE = 11;
constexpr int N_LAUNCHES = MK_N_LAUNCHES;
static_assert(N_LAUNCHES == 1 || N_LAUNCHES == NPHASE, "MK_N_LAUNCHES is 1 or 11");

constexpr int D = 2048, NB = 8, SEQ = 2048, T = NB * SEQ, LC = 256, TC = NB * LC, MTOT = T + TC;
constexpr int HEADS = 8, HD = 128, MIXG = 1024;
constexpr int PXW = 10240;
constexpr int PQN = 0, PKN = 1024, PVN = 2048, PQH = 3072, PKF = 4096, PKB = 5120, PIH = 6144, PGH = 7168, PGF = 8192, PGB = 9216;
constexpr int NE = 32, TOPK = 4, FF = 2048;
constexpr int CAP_TILES = 288, CAP = CAP_TILES * 256;
constexpr float EPS = 1e-6f;

constexpr size_t MiB = 1u << 20;
constexpr size_t WS_CTL = 0, CTL_ZERO_BYTES = 1 * MiB;
constexpr size_t WS_MODP = 4 * MiB;
constexpr size_t WS_MODF = 6 * MiB;
constexpr size_t WS_WRT = 7 * MiB;
constexpr size_t WS_WIN = 8 * MiB;
constexpr size_t WS_WOUT = 40 * MiB;
constexpr size_t WS_HXN = 48 * MiB;
constexpr size_t WS_PX = 120 * MiB;
constexpr size_t WS_A2 = 480 * MiB;
constexpr size_t WS_OF = 544 * MiB;
constexpr size_t WS_OB = 608 * MiB;
constexpr size_t WS_X1 = 672 * MiB;
constexpr size_t WS_HX2 = 800 * MiB;
constexpr size_t WS_RT = 864 * MiB;
constexpr size_t WS_XG = 866 * MiB;
constexpr size_t WS_H = 1154 * MiB;
constexpr size_t WS_Y = 1442 * MiB;
constexpr size_t WS_WGU = 1730 * MiB;
constexpr size_t WS_WD = 2242 * MiB;
constexpr size_t WS_END = 2498 * MiB;
constexpr int CW_TMO = 0;
constexpr int CW_BAR = 4096;
constexpr int CW_ATTQ = 16384;
constexpr int CW_CNT = 16448;

constexpr int RING_OFF = 0, SCR_BYTES = 139264;
constexpr int LDSCTL_OFF = SCR_BYTES, MISC_OFF = LDSCTL_OFF + 320, TILE_OFF = MISC_OFF + 128, OFFT_OFF = TILE_OFF + 320;
constexpr int LDS_BYTES = 147456;
static_assert(OFFT_OFF + 256 <= LDS_BYTES, "LDS map");

#define GAS __attribute__((address_space(1)))
#define LAS __attribute__((address_space(3)))
typedef unsigned short bf16;
typedef unsigned char u8;
typedef unsigned v4u __attribute__((ext_vector_type(4)));
typedef unsigned v2u __attribute__((ext_vector_type(2)));
typedef float f32x4 __attribute__((ext_vector_type(4)));
typedef float f32x2 __attribute__((ext_vector_type(2)));
typedef short bf16x8 __attribute__((ext_vector_type(8)));
typedef short s16x4 __attribute__((ext_vector_type(4)));
typedef __bf16 bfv2 __attribute__((ext_vector_type(2)));
typedef GAS unsigned gu32;
#define RLX_AGENT __ATOMIC_RELAXED, __HIP_MEMORY_SCOPE_AGENT
#define LDS_WAIT() asm volatile("s_waitcnt lgkmcnt(0)" ::: "memory")
#define VM_WAIT() asm volatile("s_waitcnt vmcnt(0)" ::: "memory")
__device__ __forceinline__ unsigned pk2(float lo, float hi) { f32x2 v = {lo, hi}; bfv2 b = __builtin_convertvector(v, bfv2); return __builtin_bit_cast(unsigned, b); }
constexpr float SW8 = 256.f, SA8 = 8.f, SH8 = 4.f;
__device__ __forceinline__ unsigned pk4_fp8(float a, float b, float c, float d) {
    a = fminf(fmaxf(a, -448.f), 448.f); b = fminf(fmaxf(b, -448.f), 448.f); c = fminf(fmaxf(c, -448.f), 448.f); d = fminf(fmaxf(d, -448.f), 448.f);
    int w = __builtin_amdgcn_cvt_pk_fp8_f32(a, b, 0, false); w = __builtin_amdgcn_cvt_pk_fp8_f32(c, d, w, true); return (unsigned)w; }
__device__ __forceinline__ float bflo(unsigned u) { return __uint_as_float(u << 16); }
__device__ __forceinline__ float bfhi(unsigned u) { return __uint_as_float(u & 0xffff0000u); }
__device__ __forceinline__ float wave_sum(float v) {
#pragma unroll
    for (int o = 1; o < 64; o <<= 1) v += __shfl_xor(v, o);
    return v;
}
__device__ __forceinline__ float silu_f(float x) { return x / (1.f + __expf(-x)); }
__device__ __forceinline__ bf16x8 cat8(s16x4 a, s16x4 b) { return __builtin_shufflevector(a, b, 0, 1, 2, 3, 4, 5, 6, 7); }
__device__ __forceinline__ s16x4 tr_read(const LAS unsigned char* p) { return __builtin_amdgcn_ds_read_tr16_b64_v4i16((LAS s16x4*)p); }
__device__ __forceinline__ bf16x8 mk8(unsigned a, unsigned b, unsigned c, unsigned d) { v4u v = {a, b, c, d}; return __builtin_bit_cast(bf16x8, v); }
#define XB_TMO      128
#define XB_XCNT(j)  (256  + 64 * (j))
#define XB_XSUB(j)  (1280 + 64 * (j))
#define XB_XGEN(j)  (2304 + 64 * (j))
#define XB_TOP      3328
#define XB_TOPGEN   3392
#define XCD_BAR_WORDS 3456
#define XB_SPIN_CAP (1u << 18)

__device__ __forceinline__ unsigned xb_ld(unsigned* p)              { return __hip_atomic_load(p, __ATOMIC_RELAXED, __HIP_MEMORY_SCOPE_AGENT); }
__device__ __forceinline__ unsigned xb_add(unsigned* p, unsigned v) { return __hip_atomic_fetch_add(p, v, __ATOMIC_RELAXED, __HIP_MEMORY_SCOPE_AGENT); }
__device__ __forceinline__ unsigned xb_xcc_id() { return (unsigned)__builtin_amdgcn_s_getreg((3 << 11) | 20) & 0xFu; }
#define XB_SPIN(cond, bar) do { unsigned _sp = 0; while (cond) { __builtin_amdgcn_s_sleep(1); \
    if ((++_sp & 255u) == 0u) { if (xb_ld(&(bar)[XB_TMO])) break; if (_sp > XB_SPIN_CAP) { atomicAdd(&(bar)[XB_TMO], 1u); break; } } } } while (0)

struct XcdBarrier {
    unsigned* bar; unsigned x;
    volatile LAS unsigned* st;
};

__device__ __forceinline__ XcdBarrier xcd_barrier_post(unsigned* bar, volatile LAS unsigned* st) {
    XcdBarrier b; b.bar = bar; b.x = xb_xcc_id(); b.st = st;
    if (threadIdx.x == 0) (void)xb_add(&bar[XB_XCNT(b.x)], 1u);
    return b;
}
__device__ __forceinline__ void xcd_barrier_complete(unsigned* bar, unsigned x, unsigned& nloc, unsigned& nx) {
    const unsigned G = gridDim.x * gridDim.y * gridDim.z;
    unsigned sum, cnt, mine, sp = 0u;
    for (;;) {
        sum = 0u; cnt = 0u; mine = 0u;
#pragma unroll
        for (unsigned j = 0; j < 16; ++j) { const unsigned c = xb_ld(&bar[XB_XCNT(j)]); sum += c; cnt += (c > 0u) ? 1u : 0u; mine = (j == x) ? c : mine; }
        if (sum == G) break;
        __builtin_amdgcn_s_sleep(1);
        if ((++sp & 255u) == 0u) { if (xb_ld(&bar[XB_TMO])) break; if (sp > XB_SPIN_CAP) { atomicAdd(&bar[XB_TMO], 1u); break; } }
    }
    nloc = mine > 0u ? mine : 1u; nx = cnt > 0u ? cnt : 1u;
}

__device__ __forceinline__ void xcd_barrier(const XcdBarrier& b) {
    asm volatile("s_waitcnt vmcnt(0)" ::: "memory");
    __syncthreads();
    if (threadIdx.x == 0) {
        unsigned* bar = b.bar;
        __builtin_amdgcn_s_waitcnt(0);
        unsigned nloc = b.st[0], nx = b.st[1];
        if (nloc == 0u) { xcd_barrier_complete(bar, b.x, nloc, nx); b.st[0] = nloc; b.st[1] = nx; }
        const unsigned old = xb_add(&bar[XB_XSUB(b.x)], 1u);
        const unsigned gen = old / nloc;
        if (old + 1u == (gen + 1u) * nloc) {
            __builtin_amdgcn_fence(__ATOMIC_RELEASE, "agent");
            asm volatile("s_waitcnt vmcnt(0)" ::: "memory");
            const unsigned og = xb_add(&bar[XB_TOP], 1u);
            const unsigned tg = og / nx;
            if (og + 1u == (tg + 1u) * nx) xb_add(&bar[XB_TOPGEN], 1u);
            else XB_SPIN(xb_ld(&bar[XB_TOPGEN]) == tg, bar);
            __builtin_amdgcn_fence(__ATOMIC_ACQUIRE, "agent");
            xb_add(&bar[XB_XGEN(b.x)], 1u);
            asm volatile("s_waitcnt vmcnt(0)" ::: "memory");
        } else {
            XB_SPIN(xb_ld(&bar[XB_XGEN(b.x)]) == gen, bar);
            __builtin_amdgcn_fence(__ATOMIC_ACQUIRE, "agent");
            asm volatile("s_waitcnt vmcnt(0)" ::: "memory");
        }
    }
    __syncthreads();
}

struct Frame {
    LAS unsigned char* lds;
    volatile LAS unsigned* MISC;
    gu32* ctl;
    int tid, lane, wave;
    int vcu, G;
    const float *x, *c, *ctx, *c_ctx, *w_ada, *b_ada, *norm_mix, *norm_ffn, *w_in, *lb_table, *hg_norm, *rpb, *w_out, *w_router, *b_router, *w_gu, *b_gu, *w_down, *b_down, *norm_final;
    float* out;
    float *MODP, *MODF, *OF, *OB, *X1;
    bf16 *WRT, *WIN, *WOUT, *HXN, *PX, *A2, *Y; u8 *HX2, *XG, *H, *WGU, *WD;
    int *RT_E, *RT_POS, *RT_SLOT; float* RT_G;
};

__device__ __forceinline__ void p0_mod_unit(Frame& F, int unit) {
    const int slab = unit >> 2, ks = unit & 3, col0 = slab * 64, k0 = ks * 512;
    LAS float* cond = (LAS float*)(F.lds);
    LAS float* red = (LAS float*)(F.lds + 9 * 512 * 4);
    for (int i = F.tid; i < 9 * 512; i += 512) { const int r = i >> 9, k = i & 511; const float v = (r < 8) ? F.c[r * D + k0 + k] : F.c_ctx[k0 + k]; cond[i] = silu_f(v); }
    __syncthreads();
    const int c4 = F.tid & 15, kl = F.tid >> 4;
    float acc[9][4];
#pragma unroll
    for (int r = 0; r < 9; ++r) { acc[r][0] = 0.f; acc[r][1] = 0.f; acc[r][2] = 0.f; acc[r][3] = 0.f; }
    const float* wp = F.w_ada + (size_t)(k0 + kl) * (6 * D) + col0 + 4 * c4;
#pragma unroll 4
    for (int it = 0; it < 16; ++it) {
        const f32x4 w = *(const f32x4*)(wp + (size_t)(32 * it) * (6 * D));
#pragma unroll
        for (int r = 0; r < 9; ++r) { const float cv = cond[r * 512 + kl + 32 * it]; acc[r][0] += cv * w.x; acc[r][1] += cv * w.y; acc[r][2] += cv * w.z; acc[r][3] += cv * w.w; }
    }
#pragma unroll
    for (int r = 0; r < 9; ++r)
#pragma unroll
        for (int j = 0; j < 4; ++j) { float v = acc[r][j]; v += __shfl_xor(v, 16); v += __shfl_xor(v, 32); if (F.lane < 16) red[F.wave * 576 + r * 64 + 4 * c4 + j] = v; }
    __syncthreads();
    for (int o = F.tid; o < 576; o += 512) { float s = 0.f;
#pragma unroll
        for (int w = 0; w < 8; ++w) s += red[w * 576 + o];
        const int r = o >> 6, cc = o & 63; F.MODP[(size_t)(ks * 9 + r) * (6 * D) + col0 + cc] = s; }
    __syncthreads();
}
__device__ __forceinline__ void p0_tr_item(const float* W, int ldw, bf16* WT, size_t dst_row0, int k0, int n0, LAS float* scr, int lane) {
#pragma unroll 4
    for (int i = 0; i < 16; ++i) { const int kk = 4 * i + (lane >> 4); const f32x4 v = *(const f32x4*)(W + (size_t)(k0 + kk) * ldw + n0 + 4 * (lane & 15));
        LAS float* s = scr + kk * 65 + 4 * (lane & 15); s[0] = v.x; s[1] = v.y; s[2] = v.z; s[3] = v.w; }
    LDS_WAIT(); asm volatile("" ::: "memory");
    const int c = lane & 7, nn = lane >> 3;
#pragma unroll
    for (int j = 0; j < 8; ++j) { const int n = 8 * j + nn; const LAS float* s = scr + (8 * c) * 65 + n;
        v4u o; o.x = pk2(s[0 * 65], s[1 * 65]); o.y = pk2(s[2 * 65], s[3 * 65]); o.z = pk2(s[4 * 65], s[5 * 65]); o.w = pk2(s[6 * 65], s[7 * 65]);
        *(v4u*)(WT + (dst_row0 + n) * 2048 + k0 + 8 * c) = o; }
    LDS_WAIT(); asm volatile("" ::: "memory");
}
__device__ __forceinline__ void p0_tr_item8(const float* W, int ldw, u8* WT, size_t dst_row0, int k0, int n0, LAS float* scr, int lane, float scale) {
#pragma unroll 4
    for (int i = 0; i < 16; ++i) { const int kk = 8 * i + (lane >> 3); const f32x4 v = *(const f32x4*)(W + (size_t)(k0 + kk) * ldw + n0 + 4 * (lane & 7)) * scale;
        LAS float* s = scr + kk * 33 + 4 * (lane & 7); s[0] = v.x; s[1] = v.y; s[2] = v.z; s[3] = v.w; }
    LDS_WAIT(); asm volatile("" ::: "memory");
    const int n = lane & 31, h = lane >> 5;
#pragma unroll
    for (int j = 0; j < 4; ++j) { const int cj = 2 * j + h; const LAS float* s = scr + (16 * cj) * 33 + n;
        v4u o; o.x = pk4_fp8(s[0 * 33], s[1 * 33], s[2 * 33], s[3 * 33]); o.y = pk4_fp8(s[4 * 33], s[5 * 33], s[6 * 33], s[7 * 33]);
        o.z = pk4_fp8(s[8 * 33], s[9 * 33], s[10 * 33], s[11 * 33]); o.w = pk4_fp8(s[12 * 33], s[13 * 33], s[14 * 33], s[15 * 33]);
        *(v4u*)(WT + (dst_row0 + n) * 2048 + k0 + 16 * cj) = o; }
    LDS_WAIT(); asm volatile("" ::: "memory");
}
__device__ __forceinline__ void p0_prologue(Frame& F) {
    for (int u = F.vcu; u < 768; u += F.G) p0_mod_unit(F, u);
    LAS float* scr = (LAS float*)(F.lds + F.wave * 16896);
    const int gw = F.vcu * NWAVES + F.wave, NGW = F.G * NWAVES;
    constexpr int I_IN = 32 * 128, I_OUT = 32 * 32, I_GU = 32 * 64, I_DN = 32 * 32;
    constexpr int NITEMS = I_IN + I_OUT + NE * I_GU + NE * I_DN;
    for (int it = gw; it < NITEMS; it += NGW) {
        int r = it;
        if (r < I_IN) { const int kb = r >> 7, nb = r & 127; p0_tr_item(F.w_in, 8192, F.WIN, (size_t)nb * 64, kb * 64, nb * 64, scr, F.lane); continue; } r -= I_IN;
        if (r < I_OUT) { const int kb = r >> 5, nb = r & 31; p0_tr_item(F.w_out, 2048, F.WOUT, (size_t)nb * 64, kb * 64, nb * 64, scr, F.lane); continue; } r -= I_OUT;
        if (r < NE * I_GU) { const int e = r >> 11, q = r & 2047, kb = q >> 7, nb = q & 127, n0 = nb * 32;
            const size_t drow = (size_t)e * 4096 + (size_t)(((n0 & 2047) >> 7) * 256 + (n0 >> 11) * 128 + (n0 & 127));
            p0_tr_item8(F.w_gu + (size_t)e * 2048 * 4096, 4096, F.WGU, drow, kb * 128, n0, scr, F.lane, SW8); continue; } r -= NE * I_GU;
        { const int e = r >> 10, q = r & 1023, kb = q >> 6, nb = q & 63; p0_tr_item8(F.w_down + (size_t)e * 2048 * 2048, 2048, F.WD, (size_t)e * 2048 + nb * 32, kb * 128, nb * 32, scr, F.lane, SW8); }
    }
    for (int i = F.vcu * 512 + F.tid; i < NE * D; i += F.G * 512) { const int e = i >> 11, k = i & 2047; const float w = F.w_router[k * NE + e];
        const unsigned hi = pk2(w, 0.f) & 0xffffu; const float wl = w - bflo(hi); F.WRT[i] = (bf16)hi; F.WRT[NE * D + i] = (bf16)(pk2(wl, 0.f) & 0xffffu); }
}

__device__ __forceinline__ void p1_build_vec(Frame& F, int bb, int sh_off, int sc_off, const float* gain, bool from_partials) {
    LAS float* Av = (LAS float*)(F.lds); LAS float* Bv = Av + D;
    for (int c = F.tid; c < D; c += 512) {
        float sh, sc;
        if (from_partials) { sh = F.b_ada[sh_off + c]; sc = F.b_ada[sc_off + c];
#pragma unroll
            for (int ks = 0; ks < 4; ++ks) { sh += F.MODP[(size_t)(ks * 9 + bb) * (6 * D) + sh_off + c]; sc += F.MODP[(size_t)(ks * 9 + bb) * (6 * D) + sc_off + c]; } }
        else { sh = F.MODF[(size_t)bb * (6 * D) + sh_off + c]; sc = F.MODF[(size_t)bb * (6 * D) + sc_off + c]; }
        Av[c] = gain[c] * (1.f + sc); Bv[c] = sh; }
    __syncthreads();
}
__device__ __forceinline__ void norm_row_bf16(Frame& F, const float* xrow, bf16* orow) {
    const LAS f32x4* Av = (const LAS f32x4*)(F.lds); const LAS f32x4* Bv = Av + D / 4;
    const f32x4* xr = (const f32x4*)xrow + F.lane;
    f32x4 v[8]; float s = 0.f;
#pragma unroll
    for (int j = 0; j < 8; ++j) { v[j] = xr[64 * j]; s += (v[j].x * v[j].x + v[j].y * v[j].y) + (v[j].z * v[j].z + v[j].w * v[j].w); }
    const float rstd = rsqrtf(wave_sum(s) * (1.f / D) + EPS);
    v2u* o8 = (v2u*)orow + F.lane;
#pragma unroll
    for (int j = 0; j < 8; ++j) { const f32x4 a = Av[F.lane + 64 * j], b = Bv[F.lane + 64 * j]; const f32x4 y = v[j] * rstd * a + b;
        v2u o; o.x = pk2(y.x, y.y); o.y = pk2(y.z, y.w); o8[64 * j] = o; }
}
__device__ __forceinline__ void p1_norm(Frame& F) {
    for (int i = F.vcu * 512 + F.tid; i < 9 * 6 * D; i += F.G * 512) { float s = F.b_ada[i % (6 * D)];
#pragma unroll
        for (int ks = 0; ks < 4; ++ks) s += F.MODP[(size_t)ks * 9 * 6 * D + i];
        F.MODF[i] = s; }
    for (int blk = F.vcu; blk < 256; blk += F.G) {
        const int bb = blk >> 5;
        p1_build_vec(F, bb, 0, D, F.norm_mix, true);
        for (int r = F.wave; r < 64; r += NWAVES) { const int row = blk * 64 + r; norm_row_bf16(F, F.x + (size_t)row * D, F.HXN + (size_t)row * D); }
        __syncthreads();
        p1_build_vec(F, 8, 0, D, F.norm_mix, true);
        { const int row = blk * 8 + F.wave; norm_row_bf16(F, F.ctx + (size_t)row * D, F.HXN + (size_t)(T + row) * D); }
        __syncthreads();
    }
}

struct InProjOrder {
    pg8::StaticOrder so; int G, c;
    __device__ void init(int G_, int c_) { so.init(T, 8192, G_, c_); G = G_; c = c_; }
    __device__ bool next(int i, pg8::Unit& u) const {
        const int L = i * G + c;
        if (L < 2048) return so.next(i, u);
        const int idx = L - 2048; if (idx >= 160) return false;
        const int q = idx % 20; u.pm = 64 + idx / 20; u.pn = q < 8 ? 4 + q : 8 + q; return true;
    }
    __device__ __forceinline__ void a_ready(const pg8::Unit&) const {}
    __device__ __forceinline__ void done(const pg8::Unit&) const {}
};
struct EpiInProj {
    static constexpr bool PERM = true, AFTER_DRAIN = false;
    bf16* PX; const float* lbt;
    __device__ __forceinline__ void operator()(const f32x4 (&acc)[2][2][4][2], const pg8::Unit& u, int wr, int wc, int fr, int fq) const {
        const int row0 = u.pm * 256 + wr * 64 + fr, part = u.pn >> 2, col0 = u.pn * 256 + wc * 32 + 8 * fq;
        if (part == 4 || part == 5) {
            float lb[2][8];
#pragma unroll
            for (int bj = 0; bj < 2; ++bj)
#pragma unroll
                for (int i = 0; i < 8; ++i) { const int c = col0 + bj * 128 + i - 4096; lb[bj][i] = 1.f / (1.f + __expf(lbt[2048 + c] - lbt[c])); }
#pragma unroll
            for (int ai = 0; ai < 2; ++ai)
#pragma unroll
                for (int m = 0; m < 4; ++m) { bf16* rowp = PX + (size_t)(row0 + ai * 128 + m * 16) * PXW + col0;
#pragma unroll
                    for (int bj = 0; bj < 2; ++bj) { float ky[8], gg[8];
#pragma unroll
                        for (int i = 0; i < 8; ++i) { float xv = acc[ai][bj][m][i >> 2][i & 3]; xv = fminf(fmaxf(xv, -30.f), 30.f);
                            const float sig = 1.f / (1.f + __expf(-xv)), l = lb[bj][i]; gg[i] = __logf(l + (1.f - l) * sig); ky[i] = (1.f - l) * (1.f - sig); }
                        v4u w; w.x = pk2(ky[0], ky[1]); w.y = pk2(ky[2], ky[3]); w.z = pk2(ky[4], ky[5]); w.w = pk2(ky[6], ky[7]);
                        *(v4u*)(rowp + bj * 128) = w;
                        w.x = pk2(gg[0], gg[1]); w.y = pk2(gg[2], gg[3]); w.z = pk2(gg[4], gg[5]); w.w = pk2(gg[6], gg[7]);
                        *(v4u*)(rowp + bj * 128 + 4096) = w; __builtin_amdgcn_sched_barrier(0); } }
        } else {
            const float sc = (part == 0) ? 0.08838834764831845f : 1.f;
#pragma unroll
            for (int ai = 0; ai < 2; ++ai)
#pragma unroll
                for (int m = 0; m < 4; ++m) { bf16* rowp = PX + (size_t)(row0 + ai * 128 + m * 16) * PXW + col0;
#pragma unroll
                    for (int bj = 0; bj < 2; ++bj) { const f32x4 v0 = acc[ai][bj][m][0] * sc, v1 = acc[ai][bj][m][1] * sc;
                        v4u w; w.x = pk2(v0[0], v0[1]); w.y = pk2(v0[2], v0[3]); w.z = pk2(v1[0], v1[1]); w.w = pk2(v1[2], v1[3]);
                        *(v4u*)(rowp + bj * 128) = w; } __builtin_amdgcn_sched_barrier(0); }
        }
    }
};

#define MFMA16(a, b, c) __builtin_amdgcn_mfma_f32_16x16x32_bf16((a), (b), (c), 0, 0, 0)
__device__ __forceinline__ void gla_chain(Frame& F, int chain) {
    const int b = chain >> 4, h = (chain >> 1) & 7, dir = chain & 1;
    const int lane = F.lane, wave = F.wave, tid = F.tid, kq = lane >> 4, fr = lane & 15;
    LAS unsigned char* L = F.lds;
    constexpr int PIT = 272;
    constexpr int O_QE = 0, O_QD = 17408, O_KD = 34816, O_V = 52224, O_KEX = 69632, O_ATT = 113152, O_SUB = 122368, O_DECL = 126464;
    for (int i = tid; i < 9216 / 4; i += 512) ((LAS unsigned*)(L + O_ATT))[i] = 0u;
    f32x4 S[8];
#pragma unroll
    for (int i = 0; i < 8; ++i) S[i] = (f32x4){0.f, 0.f, 0.f, 0.f};
    const int pko = dir ? PKB : PKF, pgo = dir ? PGB : PGF;
    float invf[2];
#pragma unroll
    for (int j = 0; j < 2; ++j) invf[j] = __expf(-(float)(2 * (lane & 15) + j) * (9.210340371976184f / 32.f));
    const float sgn = (lane & 16) ? 1.f : -1.f;
    float* OUT = dir ? F.OB : F.OF;
    unsigned pq[8], pk[8], pg[8]; v4u pv[2];
#define GLA_LOAD(n) do { const int _lat = (n) >= 4, _s0 = _lat ? 64 * ((n) - 4) : 64 * (n); \
        _Pragma("unroll") for (int i = 0; i < 8; ++i) { const int s = _s0 + 8 * wave + i; const int tok = _lat ? (dir ? 2047 - s : s) : (dir ? 255 - s : s); \
            const size_t grow = _lat ? (size_t)(b * SEQ + tok) : (size_t)(T + b * LC + tok); const bf16* rp = F.PX + grow * PXW + h * HD + 2 * lane; \
            pq[i] = _lat ? *(const unsigned*)(rp + PQH) : 0u; pk[i] = *(const unsigned*)(rp + pko); pg[i] = *(const unsigned*)(rp + pgo); } \
        _Pragma("unroll") for (int j = 0; j < 2; ++j) { const int p = tid + 512 * j, R = p >> 4, ch = p & 15, s = _s0 + R; const int tok = _lat ? (dir ? 2047 - s : s) : (dir ? 255 - s : s); \
            const size_t grow = _lat ? (size_t)(b * SEQ + tok) : (size_t)(T + b * LC + tok); pv[j] = *(const v4u*)(F.PX + grow * PXW + PIH + h * HD + ch * 8); } } while (0)
    GLA_LOAD(0);
    for (int n = 0; n < 36; ++n) {
        const bool lat = n >= 4;
        const int s0 = lat ? 64 * (n - 4) : 64 * n;
#pragma unroll
        for (int j = 0; j < 2; ++j) { const int p = tid + 512 * j, R = p >> 4, ch = p & 15; *(LAS v4u*)(L + O_V + R * PIT + ch * 16) = pv[j]; }
        float qa[8], qb[8], ka[8], kb[8], ca[8], cb[8];
        float ra = 0.f, rb = 0.f;
#pragma unroll
        for (int i = 0; i < 8; ++i) {
            float q0 = bflo(pq[i]), q1 = bfhi(pq[i]), k0 = bflo(pk[i]), k1 = bfhi(pk[i]);
            if (lat) {
                const int s = s0 + 8 * wave + i, tok = dir ? 2047 - s : s;
                const float pos = (float)((lane >= 32) ? (tok & 63) : (tok >> 6));
                const unsigned qp = (unsigned)__shfl_xor((int)pq[i], 16), kp = (unsigned)__shfl_xor((int)pk[i], 16);
                const float a0 = pos * invf[0], a1 = pos * invf[1];
                const float c0 = __cosf(a0), s0_ = __sinf(a0), c1 = __cosf(a1), s1_ = __sinf(a1);
                q0 = q0 * c0 + sgn * bflo(qp) * s0_; q1 = q1 * c1 + sgn * bfhi(qp) * s1_;
                k0 = k0 * c0 + sgn * bflo(kp) * s0_; k1 = k1 * c1 + sgn * bfhi(kp) * s1_;
            }
            qa[i] = q0; qb[i] = q1; ka[i] = k0; kb[i] = k1;
            ra += bflo(pg[i]); rb += bfhi(pg[i]); ca[i] = ra; cb[i] = rb;
        }
        *(LAS f32x2*)(L + O_SUB + (wave * 128 + 2 * lane) * 4) = (f32x2){ra, rb};
        __syncthreads();
        {
            float refa[4], refb[4], pa = 0.f, pb = 0.f, ta = 0.f, tb = 0.f;
#pragma unroll
            for (int w = 0; w < 8; ++w) { const f32x2 sv = *(const LAS f32x2*)(L + O_SUB + (w * 128 + 2 * lane) * 4);
                if ((w & 1) == 0) { refa[w >> 1] = ta; refb[w >> 1] = tb; }
                if (w < wave) { pa += sv.x; pb += sv.y; }
                ta += sv.x; tb += sv.y; }
            const int I = wave >> 1;
            float rIa = refa[0], rIb = refb[0];
#pragma unroll
            for (int q = 1; q < 4; ++q) if (I == q) { rIa = refa[q]; rIb = refb[q]; }
#pragma unroll
            for (int i = 0; i < 8; ++i) {
                const int R = 8 * wave + i; const float cua = pa + ca[i], cub = pb + cb[i];
                *(LAS unsigned*)(L + O_KD + R * PIT + 4 * lane) = pk2(ka[i] * __expf(ta - cua), kb[i] * __expf(tb - cub));
                if (lat) {
                    *(LAS unsigned*)(L + O_QE + R * PIT + 4 * lane) = pk2(qa[i] * __expf(cua - rIa), qb[i] * __expf(cub - rIb));
                    *(LAS unsigned*)(L + O_QD + R * PIT + 4 * lane) = pk2(qa[i] * __expf(cua), qb[i] * __expf(cub));
#pragma unroll
                    for (int Ip = 0; Ip < 4; ++Ip) if (Ip >= I) {
                        const int row = 16 * (Ip * (Ip + 1) / 2 + I) + (R & 15);
                        *(LAS unsigned*)(L + O_KEX + row * PIT + 4 * lane) = pk2(ka[i] * __expf(refa[Ip] - cua), kb[i] * __expf(refb[Ip] - cub)); }
                }
            }
            if (wave == 0) *(LAS f32x2*)(L + O_DECL + 8 * lane) = (f32x2){__expf(ta), __expf(tb)};
        }
        if (n + 1 < 36) GLA_LOAD(n + 1);
        __syncthreads();
        if (lat) {
            for (int tt = wave; tt < 10; tt += 8) {
                const int I = (tt >= 6) ? 3 : (tt >= 3) ? 2 : (tt >= 1) ? 1 : 0, J = tt - I * (I + 1) / 2;
                f32x4 X = (f32x4){0.f, 0.f, 0.f, 0.f};
#pragma unroll
                for (int ks = 0; ks < 4; ++ks) {
                    const bf16x8 a = *(const LAS bf16x8*)(L + O_KEX + (16 * tt + fr) * PIT + ks * 64 + kq * 16);
                    const bf16x8 bq = *(const LAS bf16x8*)(L + O_QE + (16 * I + fr) * PIT + ks * 64 + kq * 16);
                    X = MFMA16(a, bq, X); }
                if (J == I) {
#pragma unroll
                    for (int r = 0; r < 4; ++r) if (4 * kq + r > fr) X[r] = 0.f; }
                v2u o; o.x = pk2(X[0], X[1]); o.y = pk2(X[2], X[3]);
                *(LAS v2u*)(L + O_ATT + (16 * I + fr) * 144 + (16 * J + 4 * kq) * 2) = o;
            }
        }
        __syncthreads();
        {
            const int q4 = fr >> 2, pp = fr & 3;
            bf16x8 Vf[2];
#pragma unroll
            for (int p = 0; p < 2; ++p) { const LAS unsigned char* vb = L + O_V + (32 * p + 8 * kq + q4) * PIT + (16 * wave + 4 * pp) * 2;
                Vf[p] = cat8(tr_read(vb), tr_read(vb + 4 * PIT)); }
            if (lat) {
                bf16x8 Sb[4];
#pragma unroll
                for (int ks = 0; ks < 4; ++ks) Sb[ks] = mk8(pk2(S[2 * ks][0], S[2 * ks][1]), pk2(S[2 * ks][2], S[2 * ks][3]), pk2(S[2 * ks + 1][0], S[2 * ks + 1][1]), pk2(S[2 * ks + 1][2], S[2 * ks + 1][3]));
#pragma unroll
                for (int I = 0; I < 4; ++I) {
                    f32x4 o = (f32x4){0.f, 0.f, 0.f, 0.f};
#pragma unroll
                    for (int p = 0; p < 2; ++p) if (p <= (I >> 1)) { const bf16x8 a = *(const LAS bf16x8*)(L + O_ATT + (16 * I + fr) * 144 + p * 64 + kq * 16); o = MFMA16(a, Vf[p], o); }
#pragma unroll
                    for (int ks = 0; ks < 4; ++ks) { const LAS unsigned char* qp = L + O_QD + (16 * I + fr) * PIT + (32 * ks + 4 * kq) * 2;
                        const v2u lo = *(const LAS v2u*)qp, hi = *(const LAS v2u*)(qp + 32);
                        o = MFMA16(mk8(lo.x, lo.y, hi.x, hi.y), Sb[ks], o); }
#pragma unroll
                    for (int r = 0; r < 4; ++r) { const int s = s0 + 16 * I + 4 * kq + r, tok = dir ? 2047 - s : s;
                        OUT[(size_t)(b * SEQ + tok) * MIXG + h * HD + 16 * wave + fr] = o[r]; }
                }
            }
#pragma unroll
            for (int dkb = 0; dkb < 8; ++dkb) {
                const f32x4 dec = *(const LAS f32x4*)(L + O_DECL + (16 * dkb + 4 * kq) * 4);
                f32x4 s = S[dkb] * dec;
#pragma unroll
                for (int p = 0; p < 2; ++p) { const LAS unsigned char* kb_ = L + O_KD + (32 * p + 8 * kq + q4) * PIT + (16 * dkb + 4 * pp) * 2;
                    s = MFMA16(cat8(tr_read(kb_), tr_read(kb_ + 4 * PIT)), Vf[p], s); }
                S[dkb] = s;
            }
        }
        __syncthreads();
    }
#undef GLA_LOAD
}

__device__ __forceinline__ void attn_unit(Frame& F, int u) {
    const int b = u >> 8, h = (u >> 5) & 7, r = u & 31;
    const int lane = F.lane, wave = F.wave, tid = F.tid, kq = lane >> 4, fr = lane & 15, j = wave & 3, role = wave >> 2;
    LAS unsigned char* L = F.lds;
    constexpr int PIT = 272;
    constexpr int O_KW = 0, O_VW = 17408, O_KC = 34816, O_VC = 43520, O_RPB = 52224, O_MG = 0;
    const int kr0 = min(max(r - 4, 0), 24), kc0 = min(max(16 * j - 8, 0), 32);
    const int qcol = 16 * j + fr, cs = min(max(qcol - 8, 0), 48);
    for (int i = tid; i < 465; i += 512) ((LAS float*)(L + O_RPB))[i] = F.rpb[h * 465 + i];
    bf16x8 qf[4];
    { const bf16* qp = F.PX + (size_t)(b * SEQ + r * 64 + qcol) * PXW + PQN + h * HD + 8 * kq;
#pragma unroll
      for (int ks = 0; ks < 4; ++ks) qf[ks] = *(const bf16x8*)(qp + 32 * ks); }
    v4u st[6];
#define ATT_LOAD(s_) do { \
        _Pragma("unroll") for (int m = 0; m < 4; ++m) { const int p = tid + 512 * (m & 1), R = p >> 4, ch = p & 15; \
            st[m] = *(const v4u*)(F.PX + (size_t)(b * SEQ + (kr0 + (s_)) * 64 + R) * PXW + ((m < 2) ? PKN : PVN) + h * HD + ch * 8); } \
        _Pragma("unroll") for (int m = 4; m < 6; ++m) { const int R = tid >> 4, ch = tid & 15; \
            st[m] = *(const v4u*)(F.PX + (size_t)(T + b * LC + 32 * (s_) + R) * PXW + ((m == 4) ? PKN : PVN) + h * HD + ch * 8); } } while (0)
    ATT_LOAD(0);
    f32x4 O[8];
#pragma unroll
    for (int i = 0; i < 8; ++i) O[i] = (f32x4){0.f, 0.f, 0.f, 0.f};
    float mrun = -1e30f, lrun = 0.f;
    for (int s = 0; s < 8; ++s) {
        __syncthreads();
#pragma unroll
        for (int m = 0; m < 4; ++m) { const int p = tid + 512 * (m & 1), R = p >> 4, ch = p & 15; *(LAS v4u*)(L + ((m < 2) ? O_KW : O_VW) + R * PIT + ch * 16) = st[m]; }
#pragma unroll
        for (int m = 4; m < 6; ++m) { const int R = tid >> 4, ch = tid & 15; *(LAS v4u*)(L + ((m == 4) ? O_KC : O_VC) + R * PIT + ch * 16) = st[m]; }
        if (s < 7) ATT_LOAD(s + 1);
        __syncthreads();
        const int kbase = role ? 0 : kc0;
        const LAS unsigned char* Kt = L + (role ? O_KC : O_KW);
        const LAS unsigned char* Vt = L + (role ? O_VC : O_VW);
        f32x4 sc[2];
#pragma unroll
        for (int cb = 0; cb < 2; ++cb) { f32x4 a = (f32x4){0.f, 0.f, 0.f, 0.f};
#pragma unroll
            for (int ks = 0; ks < 4; ++ks) a = MFMA16(*(const LAS bf16x8*)(Kt + (kbase + 16 * cb + fr) * PIT + ks * 64 + kq * 16), qf[ks], a);
            sc[cb] = a; }
        if (role == 0) {
            const int drow = (kr0 + s) - r + 7;
#pragma unroll
            for (int cb = 0; cb < 2; ++cb)
#pragma unroll
                for (int q = 0; q < 4; ++q) { const int kc = kc0 + 16 * cb + 4 * kq + q; const bool in = (kc >= cs) && (kc < cs + 16);
                    const int dcol = min(max(kc - qcol + 15, 0), 30);
                    const float bias = ((const LAS float*)(L + O_RPB))[drow * 31 + dcol];
                    sc[cb][q] = in ? sc[cb][q] + bias : -1e30f; }
        }
        float mx = fmaxf(fmaxf(fmaxf(sc[0][0], sc[0][1]), fmaxf(sc[0][2], sc[0][3])), fmaxf(fmaxf(sc[1][0], sc[1][1]), fmaxf(sc[1][2], sc[1][3])));
        mx = fmaxf(mx, __shfl_xor(mx, 16)); mx = fmaxf(mx, __shfl_xor(mx, 32));
        const float mnew = fmaxf(mrun, mx), alpha = __expf(mrun - mnew);
        float p[8], ps = 0.f;
#pragma unroll
        for (int i = 0; i < 8; ++i) { p[i] = __expf(sc[i >> 2][i & 3] - mnew); ps += p[i]; }
        lrun = lrun * alpha + ps; mrun = mnew;
        const bf16x8 pf = mk8(pk2(p[0], p[1]), pk2(p[2], p[3]), pk2(p[4], p[5]), pk2(p[6], p[7]));
        const int q4 = fr >> 2, pp = fr & 3;
#pragma unroll
        for (int dvb = 0; dvb < 8; ++dvb) { const LAS unsigned char* vb = Vt + (kbase + 4 * kq + q4) * PIT + (16 * dvb + 4 * pp) * 2;
            O[dvb] = MFMA16(cat8(tr_read(vb), tr_read(vb + 16 * PIT)), pf, O[dvb] * alpha); }
    }
#undef ATT_LOAD
    lrun += __shfl_xor(lrun, 16); lrun += __shfl_xor(lrun, 32);
    __syncthreads();
    if (role == 1) {
        LAS float* mg = (LAS float*)(L + O_MG + j * 8704);
#pragma unroll
        for (int dvb = 0; dvb < 8; ++dvb)
#pragma unroll
            for (int q = 0; q < 4; ++q) mg[(dvb * 4 + q) * 64 + lane] = O[dvb][q];
        mg[2048 + lane] = mrun; mg[2048 + 64 + lane] = lrun;
    }
    __syncthreads();
    if (role == 0) {
        const LAS float* mg = (const LAS float*)(L + O_MG + j * 8704);
        const float m2 = mg[2048 + lane], l2 = mg[2048 + 64 + lane];
        const float m = fmaxf(mrun, m2), a1 = __expf(mrun - m), a2 = __expf(m2 - m), inv = 1.f / (lrun * a1 + l2 * a2);
        bf16* op = F.A2 + (size_t)(b * SEQ + r * 64 + qcol) * D + h * HD + 4 * kq;
#pragma unroll
        for (int dvb = 0; dvb < 8; ++dvb) { float o[4];
#pragma unroll
            for (int q = 0; q < 4; ++q) o[q] = (O[dvb][q] * a1 + mg[(dvb * 4 + q) * 64 + lane] * a2) * inv;
            v2u w; w.x = pk2(o[0], o[1]); w.y = pk2(o[2], o[3]); *(v2u*)(op + 16 * dvb) = w; }
    }
}
__device__ __forceinline__ void p3_mixer(Frame& F) {
    for (int ch = (int)blockIdx.x; ch < 128; ch += F.G) { gla_chain(F, ch); }
    for (;;) {
        if (F.tid == 0) F.MISC[0] = __hip_atomic_fetch_add((unsigned*)(F.ctl + CW_ATTQ), 1u, RLX_AGENT);
        __syncthreads();
        const int u = (int)F.MISC[0];
        if (u >= NB * HEADS * 32) break;
        attn_unit(F, u);
        __syncthreads();
    }
}

__device__ __forceinline__ void p4_hg_out(Frame& F) {
    const int gw = F.vcu * NWAVES + F.wave, NGW = F.G * NWAVES, lane = F.lane;
    for (int t = gw; t < T; t += NGW) {
        const f32x4* pf = (const f32x4*)(F.OF + (size_t)t * MIXG + 16 * lane); const f32x4* pb = (const f32x4*)(F.OB + (size_t)t * MIXG + 16 * lane);
        f32x4 o[4]; float ss = 0.f;
#pragma unroll
        for (int i = 0; i < 4; ++i) { o[i] = pf[i] + pb[i]; ss += (o[i].x * o[i].x + o[i].y * o[i].y) + (o[i].z * o[i].z + o[i].w * o[i].w); }
        ss += __shfl_xor(ss, 1); ss += __shfl_xor(ss, 2); ss += __shfl_xor(ss, 4);
        const float rstd = rsqrtf(ss * (1.f / HD) + EPS);
        const v4u* gp = (const v4u*)(F.PX + (size_t)t * PXW + PGH + 16 * lane);
        const v4u g0 = gp[0], g1 = gp[1];
        const unsigned gu[8] = {g0.x, g0.y, g0.z, g0.w, g1.x, g1.y, g1.z, g1.w};
        const f32x4* hp = (const f32x4*)(F.hg_norm + ((16 * lane) & 127));
        unsigned ow[8];
#pragma unroll
        for (int i = 0; i < 4; ++i) { const f32x4 gn = hp[i]; const f32x4 y = o[i] * rstd * gn;
            const float ga = bflo(gu[2 * i]), gb = bfhi(gu[2 * i]), gc = bflo(gu[2 * i + 1]), gd = bfhi(gu[2 * i + 1]);
            ow[2 * i] = pk2(y.x * silu_f(ga), y.y * silu_f(gb)); ow[2 * i + 1] = pk2(y.z * silu_f(gc), y.w * silu_f(gd)); }
        v4u* op = (v4u*)(F.A2 + (size_t)t * D + MIXG + 16 * lane);
        op[0] = (v4u){ow[0], ow[1], ow[2], ow[3]}; op[1] = (v4u){ow[4], ow[5], ow[6], ow[7]};
    }
}

struct EpiOutProj {
    static constexpr bool PERM = false, AFTER_DRAIN = false;
    const float* x; float* X1; const float* modf;
    __device__ __forceinline__ void operator()(const f32x4 (&acc)[2][2][4][2], const pg8::Unit& u, int wr, int wc, int fr, int fq) const {
        const int row0 = u.pm * 256 + wr * 64 + fr, col0 = u.pn * 256 + wc * 32 + 4 * fq;
        const float* g1 = modf + (size_t)(u.pm >> 3) * (6 * D) + 2 * D;
        f32x4 gv[2][2];
#pragma unroll
        for (int bj = 0; bj < 2; ++bj)
#pragma unroll
            for (int n = 0; n < 2; ++n) gv[bj][n] = *(const f32x4*)(g1 + col0 + bj * 128 + n * 16);
#pragma unroll
        for (int ai = 0; ai < 2; ++ai)
#pragma unroll
            for (int m = 0; m < 4; ++m) { const size_t ro = (size_t)(row0 + ai * 128 + m * 16) * D + col0;
#pragma unroll
                for (int bj = 0; bj < 2; ++bj)
#pragma unroll
                    for (int n = 0; n < 2; ++n) { const f32x4 xv = *(const f32x4*)(x + ro + bj * 128 + n * 16); *(f32x4*)(X1 + ro + bj * 128 + n * 16) = xv + gv[bj][n] * acc[ai][bj][m][n]; } __builtin_amdgcn_sched_barrier(0); }
    }
};

__device__ __forceinline__ void p6_router(Frame& F) {
    const int lane = F.lane, wave = F.wave, tid = F.tid, kq = lane >> 4, fr = lane & 15, g = wave & 3, kh = wave >> 2;
    LAS unsigned char* L = F.lds;
    constexpr int O_SSQ = 16384, O_LG = 16384 + 512, O_HIST = O_LG + 2 * 64 * 33 * 4, O_BASE = O_HIST + 128, O_PL = O_BASE + 128;
    for (int blk = F.vcu; blk < 256; blk += F.G) {
        const int bb = blk >> 5;
        p1_build_vec(F, bb, 3 * D, 4 * D, F.norm_ffn, false);
        if (tid < 32) ((LAS unsigned*)(L + O_HIST))[tid] = 0u;
        const int row = blk * 64 + g * 16 + fr;
        const float* xr = F.X1 + (size_t)row * D + kh * 1024 + 8 * kq;
        float ss = 0.f;
#pragma unroll 4
        for (int s = 0; s < 32; ++s) { const f32x4 a = *(const f32x4*)(xr + 32 * s), c = *(const f32x4*)(xr + 32 * s + 4);
            ss += (a.x * a.x + a.y * a.y) + (a.z * a.z + a.w * a.w) + (c.x * c.x + c.y * c.y) + (c.z * c.z + c.w * c.w); }
        ss += __shfl_xor(ss, 16); ss += __shfl_xor(ss, 32);
        if (kq == 0) ((LAS float*)(L + O_SSQ))[kh * 64 + g * 16 + fr] = ss;
        __syncthreads();
        const float rstd = rsqrtf((((LAS float*)(L + O_SSQ))[g * 16 + fr] + ((LAS float*)(L + O_SSQ))[64 + g * 16 + fr]) * (1.f / D) + EPS);
        f32x4 lg0 = (f32x4){0.f, 0.f, 0.f, 0.f}, lg1 = lg0;
        const LAS float* Av = (const LAS float*)L; const LAS float* Bv = Av + D;
        const bf16* wh = F.WRT + (size_t)fr * D + kh * 1024 + 8 * kq;
        u8* hrow = F.HX2 + (size_t)row * D + kh * 1024 + 8 * kq;
#pragma unroll 2
        for (int s = 0; s < 32; ++s) {
            const int k = kh * 1024 + 32 * s + 8 * kq;
            const f32x4 a = *(const f32x4*)(xr + 32 * s), c = *(const f32x4*)(xr + 32 * s + 4);
            const f32x4 A0 = *(const LAS f32x4*)(Av + k), A1 = *(const LAS f32x4*)(Av + k + 4), B0 = *(const LAS f32x4*)(Bv + k), B1 = *(const LAS f32x4*)(Bv + k + 4);
            const f32x4 h0 = a * rstd * A0 + B0, h1 = c * rstd * A1 + B1;
            const unsigned u0 = pk2(h0.x, h0.y), u1 = pk2(h0.z, h0.w), u2 = pk2(h1.x, h1.y), u3 = pk2(h1.z, h1.w);
            *(v2u*)(hrow + 32 * s) = (v2u){pk4_fp8(h0.x * SA8, h0.y * SA8, h0.z * SA8, h0.w * SA8), pk4_fp8(h1.x * SA8, h1.y * SA8, h1.z * SA8, h1.w * SA8)};
            const unsigned l0 = pk2(h0.x - bflo(u0), h0.y - bfhi(u0)), l1 = pk2(h0.z - bflo(u1), h0.w - bfhi(u1)), l2 = pk2(h1.x - bflo(u2), h1.y - bfhi(u2)), l3 = pk2(h1.z - bflo(u3), h1.w - bfhi(u3));
            const bf16x8 hh = mk8(u0, u1, u2, u3), hl = mk8(l0, l1, l2, l3);
            const bf16x8 w0h = *(const bf16x8*)(wh + 32 * s), w1h = *(const bf16x8*)(wh + 16 * D + 32 * s);
            const bf16x8 w0l = *(const bf16x8*)(wh + NE * D + 32 * s), w1l = *(const bf16x8*)(wh + NE * D + 16 * D + 32 * s);
            lg0 = MFMA16(hh, w0h, lg0); lg0 = MFMA16(hh, w0l, lg0); lg0 = MFMA16(hl, w0h, lg0);
            lg1 = MFMA16(hh, w1h, lg1); lg1 = MFMA16(hh, w1l, lg1); lg1 = MFMA16(hl, w1h, lg1);
        }
        { LAS float* lg = (LAS float*)(L + O_LG) + kh * 64 * 33;
#pragma unroll
          for (int r = 0; r < 4; ++r) { lg[(g * 16 + 4 * kq + r) * 33 + fr] = lg0[r]; lg[(g * 16 + 4 * kq + r) * 33 + 16 + fr] = lg1[r]; } }
        __syncthreads();
        int e4[4] = {0, 0, 0, 0}; int pl4[4] = {0, 0, 0, 0};
        if (tid < 64) {
            LAS float* lg = (LAS float*)(L + O_LG) + tid * 33;
            for (int e = 0; e < 32; ++e) lg[e] = lg[e] + lg[64 * 33 + e] + F.b_router[e];
            float v4[4];
#pragma unroll
            for (int p = 0; p < 4; ++p) { float best = -3.0e38f; int bi = 0;
                for (int e = 0; e < 32; ++e) { const float v = lg[e]; const bool used = (p > 0 && e == e4[0]) || (p > 1 && e == e4[1]) || (p > 2 && e == e4[2]); if (!used && v > best) { best = v; bi = e; } }
                e4[p] = bi; v4[p] = best; }
            const float e1 = __expf(v4[1] - v4[0]), e2 = __expf(v4[2] - v4[0]), e3 = __expf(v4[3] - v4[0]), inv = 1.f / (1.f + e1 + e2 + e3);
            const int t = blk * 64 + tid;
            *(f32x4*)(F.RT_G + (size_t)t * 4) = (f32x4){inv, e1 * inv, e2 * inv, e3 * inv};
            *(int4*)(F.RT_E + (size_t)t * 4) = make_int4(e4[0], e4[1], e4[2], e4[3]);
#pragma unroll
            for (int p = 0; p < 4; ++p) pl4[p] = (int)__hip_atomic_fetch_add((LAS unsigned*)(L + O_HIST) + e4[p], 1u, __ATOMIC_RELAXED, __HIP_MEMORY_SCOPE_WORKGROUP);
        }
        __syncthreads();
        if (tid < 32) { const unsigned c = ((LAS unsigned*)(L + O_HIST))[tid]; ((LAS unsigned*)(L + O_BASE))[tid] = c ? __hip_atomic_fetch_add((unsigned*)(F.ctl + CW_CNT + 64 * tid), c, RLX_AGENT) : 0u; }
        __syncthreads();
        if (tid < 64) { const int t = blk * 64 + tid; const LAS unsigned* base = (const LAS unsigned*)(L + O_BASE);
            *(int4*)(F.RT_POS + (size_t)t * 4) = make_int4((int)base[e4[0]] + pl4[0], (int)base[e4[1]] + pl4[1], (int)base[e4[2]] + pl4[2], (int)base[e4[3]] + pl4[3]); }
        __syncthreads();
    }
}

__device__ __forceinline__ int moe_tables(Frame& F) {
    LAS unsigned char* tile_e = F.lds + TILE_OFF; LAS int* offt = (LAS int*)(F.lds + OFFT_OFF);
    if (F.tid < 32) { int off = 0, mine = 0;
        for (int e = 0; e < 32; ++e) { const int c = (int)__hip_atomic_load((unsigned*)(F.ctl + CW_CNT + 64 * e), RLX_AGENT); const int nt = (c + 255) >> 8; if (e < F.tid) off += nt; if (e == F.tid) mine = nt; }
        offt[F.tid] = off; for (int t = 0; t < mine; ++t) tile_e[off + t] = (unsigned char)F.tid;
        if (F.tid == 31) offt[32] = off + mine; }
    __syncthreads();
    return offt[32];
}
struct MoeOrder {
    int nM, nN, nwg, G, c; const LAS unsigned char* tile_e;
    __device__ void init(int nM_, int nN_, int G_, int c_, const LAS unsigned char* te) { nM = nM_; nN = nN_; nwg = nM * nN; G = G_; c = c_; tile_e = te; }
    __device__ bool next(int i, pg8::Unit& u) const {
        const long Lq = (long)i * G + c; if (Lq >= nwg) return false;
        int wgid = (int)Lq; { const int q = nwg / 8, r = nwg % 8, xcd = wgid % 8, off = wgid / 8; wgid = (xcd < r ? xcd * (q + 1) : r * (q + 1) + (xcd - r) * q) + off; }
        const int nig = 8 * nN, gid = wgid / nig, fm = gid * 8, gsz = (nM - fm) < 8 ? (nM - fm) : 8;
        u.pm = fm + ((wgid % nig) % gsz); u.pn = __builtin_amdgcn_readfirstlane((int)tile_e[u.pm]) * nN + (wgid % nig) / gsz; return true;
    }
    __device__ __forceinline__ void a_ready(const pg8::Unit&) const {}
    __device__ __forceinline__ void done(const pg8::Unit&) const {}
};
__device__ __forceinline__ void p7_gather(Frame& F) {
    (void)moe_tables(F);
    const LAS int* offt = (const LAS int*)(F.lds + OFFT_OFF);
    for (int blk = F.vcu; blk < 256; blk += F.G) {
        for (int a = F.wave; a < 256; a += NWAVES) {
            const int t = blk * 64 + (a >> 2), idx = t * 4 + (a & 3);
            const int e = F.RT_E[idx], pos = F.RT_POS[idx], slot = offt[e] * 256 + pos;
            if (F.lane == 0) F.RT_SLOT[idx] = slot;
            const v4u* src = (const v4u*)(F.HX2 + (size_t)t * D) + F.lane; v4u* dst = (v4u*)(F.XG + (size_t)slot * D) + F.lane;
#pragma unroll
            for (int j = 0; j < 2; ++j) dst[64 * j] = src[64 * j];
        }
    }
}
struct EpiSwiglu {
    static constexpr bool PERM = true, AFTER_DRAIN = false;
    u8* H; const float* b_gu;
    __device__ __forceinline__ void operator()(const f32x4 (&acc)[2][2][4][2], const pg8::Unit& u, int wr, int wc, int fr, int fq) const {
        const int e = u.pn >> 4, pl = u.pn & 15, row0 = u.pm * 256 + wr * 64 + fr, ccol = pl * 128 + wc * 32 + 8 * fq;
        const float* bg = b_gu + (size_t)e * 4096 + ccol;
        const f32x4 bg0 = *(const f32x4*)bg, bg1 = *(const f32x4*)(bg + 4), bl0 = *(const f32x4*)(bg + 2048), bl1 = *(const f32x4*)(bg + 2052);
#pragma unroll
        for (int ai = 0; ai < 2; ++ai)
#pragma unroll
            for (int m = 0; m < 4; ++m) { float y[8];
#pragma unroll
                for (int i = 0; i < 8; ++i) { const float gl = acc[ai][0][m][i >> 2][i & 3] * (1.f / (SA8 * SW8)) + ((i < 4) ? bg0[i & 3] : bg1[i & 3]); const float ln = acc[ai][1][m][i >> 2][i & 3] * (1.f / (SA8 * SW8)) + ((i < 4) ? bl0[i & 3] : bl1[i & 3]);
                    const float xg = fminf(gl, 7.f), xl = fminf(fmaxf(ln, -7.f), 7.f); y[i] = xg / (1.f + __expf(-1.702f * xg)) * (xl + 1.f) * SH8; }
                v2u w; w.x = pk4_fp8(y[0], y[1], y[2], y[3]); w.y = pk4_fp8(y[4], y[5], y[6], y[7]);
                *(v2u*)(H + (size_t)(row0 + ai * 128 + m * 16) * FF + ccol) = w; __builtin_amdgcn_sched_barrier(0); }
    }
};
struct EpiDown {
    static constexpr bool PERM = true, AFTER_DRAIN = false;
    bf16* Y; const float* b_down;
    __device__ __forceinline__ void operator()(const f32x4 (&acc)[2][2][4][2], const pg8::Unit& u, int wr, int wc, int fr, int fq) const {
        const int e = u.pn >> 3, pl = u.pn & 7, row0 = u.pm * 256 + wr * 64 + fr, col0 = pl * 256 + wc * 32 + 8 * fq;
        f32x4 bv[2][2];
#pragma unroll
        for (int bj = 0; bj < 2; ++bj)
#pragma unroll
            for (int n = 0; n < 2; ++n) bv[bj][n] = *(const f32x4*)(b_down + (size_t)e * D + col0 + bj * 128 + 4 * n);
#pragma unroll
        for (int ai = 0; ai < 2; ++ai)
#pragma unroll
            for (int m = 0; m < 4; ++m) { bf16* rowp = Y + (size_t)(row0 + ai * 128 + m * 16) * D + col0;
#pragma unroll
                for (int bj = 0; bj < 2; ++bj) { const f32x4 v0 = acc[ai][bj][m][0] * (1.f / (SH8 * SW8)) + bv[bj][0], v1 = acc[ai][bj][m][1] * (1.f / (SH8 * SW8)) + bv[bj][1];
                    v4u w; w.x = pk2(v0[0], v0[1]); w.y = pk2(v0[2], v0[3]); w.z = pk2(v1[0], v1[1]); w.w = pk2(v1[2], v1[3]);
                    *(v4u*)(rowp + bj * 128) = w; } __builtin_amdgcn_sched_barrier(0); }
    }
};
__device__ __forceinline__ void p10_final(Frame& F) {
    const int gw = F.vcu * NWAVES + F.wave, NGW = F.G * NWAVES, lane = F.lane;
    for (int t = gw; t < T; t += NGW) {
        const int4 sl = *(const int4*)(F.RT_SLOT + (size_t)t * 4); const f32x4 gt = *(const f32x4*)(F.RT_G + (size_t)t * 4);
        const float* g2 = F.MODF + (size_t)(t >> 11) * (6 * D) + 5 * D;
        const f32x4* xr = (const f32x4*)(F.X1 + (size_t)t * D) + lane;
        const v2u* y0 = (const v2u*)(F.Y + (size_t)sl.x * D) + lane; const v2u* y1 = (const v2u*)(F.Y + (size_t)sl.y * D) + lane;
        const v2u* y2 = (const v2u*)(F.Y + (size_t)sl.z * D) + lane; const v2u* y3 = (const v2u*)(F.Y + (size_t)sl.w * D) + lane;
        f32x4 v[8]; float ss = 0.f;
#pragma unroll
        for (int j = 0; j < 8; ++j) { const v2u a = y0[64 * j], b = y1[64 * j], c = y2[64 * j], d = y3[64 * j];
            f32x4 m;
            m.x = gt.x * bflo(a.x) + gt.y * bflo(b.x) + gt.z * bflo(c.x) + gt.w * bflo(d.x);
            m.y = gt.x * bfhi(a.x) + gt.y * bfhi(b.x) + gt.z * bfhi(c.x) + gt.w * bfhi(d.x);
            m.z = gt.x * bflo(a.y) + gt.y * bflo(b.y) + gt.z * bflo(c.y) + gt.w * bflo(d.y);
            m.w = gt.x * bfhi(a.y) + gt.y * bfhi(b.y) + gt.z * bfhi(c.y) + gt.w * bfhi(d.y);
            const f32x4 gg = *((const f32x4*)g2 + lane + 64 * j);
            v[j] = xr[64 * j] + gg * m; ss += (v[j].x * v[j].x + v[j].y * v[j].y) + (v[j].z * v[j].z + v[j].w * v[j].w); }
        const float rstd = rsqrtf(wave_sum(ss) * (1.f / D) + EPS);
        f32x4* op = (f32x4*)(F.out + (size_t)t * D) + lane;
#pragma unroll
        for (int j = 0; j < 8; ++j) op[64 * j] = v[j] * rstd * *((const f32x4*)F.norm_final + lane + 64 * j);
    }
}

struct Args { const float* in[20]; float* out; unsigned char* ws; int ph_lo, ph_hi, li, pad; };
__global__ void __launch_bounds__(NWAVES * 64, 2) mk_fwd(Args args) {
    extern __shared__ __attribute__((aligned(16))) unsigned char lds[];
    Frame F;
    F.lds = (LAS unsigned char*)lds;
    F.MISC = (volatile LAS unsigned*)(F.lds + MISC_OFF);
    F.tid = threadIdx.x; F.lane = F.tid & 63; F.wave = __builtin_amdgcn_readfirstlane(F.tid >> 6);
    F.G = gridDim.x; { const int bx = blockIdx.x; F.vcu = (F.G % 8 == 0) ? (bx % 8) * (F.G / 8) + bx / 8 : bx; }
    unsigned char* ws = args.ws;
    F.ctl = (gu32*)(ws + WS_CTL);
    F.x = args.in[0]; F.c = args.in[1]; F.ctx = args.in[2]; F.c_ctx = args.in[3]; F.w_ada = args.in[4]; F.b_ada = args.in[5]; F.norm_mix = args.in[6]; F.norm_ffn = args.in[7];
    F.w_in = args.in[8]; F.lb_table = args.in[9]; F.hg_norm = args.in[10]; F.rpb = args.in[11]; F.w_out = args.in[12]; F.w_router = args.in[13]; F.b_router = args.in[14];
    F.w_gu = args.in[15]; F.b_gu = args.in[16]; F.w_down = args.in[17]; F.b_down = args.in[18]; F.norm_final = args.in[19]; F.out = args.out;
    F.MODP = (float*)(ws + WS_MODP); F.MODF = (float*)(ws + WS_MODF); F.OF = (float*)(ws + WS_OF); F.OB = (float*)(ws + WS_OB); F.X1 = (float*)(ws + WS_X1);
    F.WRT = (bf16*)(ws + WS_WRT); F.WIN = (bf16*)(ws + WS_WIN); F.WOUT = (bf16*)(ws + WS_WOUT); F.HXN = (bf16*)(ws + WS_HXN); F.PX = (bf16*)(ws + WS_PX); F.A2 = (bf16*)(ws + WS_A2);
    F.HX2 = (u8*)(ws + WS_HX2); F.XG = (u8*)(ws + WS_XG); F.H = (u8*)(ws + WS_H); F.Y = (bf16*)(ws + WS_Y); F.WGU = (u8*)(ws + WS_WGU); F.WD = (u8*)(ws + WS_WD);
    F.RT_E = (int*)(ws + WS_RT); F.RT_POS = F.RT_E + T * 4; F.RT_G = (float*)(F.RT_POS + T * 4); F.RT_SLOT = (int*)(F.RT_G + T * 4);
    for (int u = F.tid; u < (LDS_BYTES - LDSCTL_OFF) / 4; u += NWAVES * 64) ((LAS unsigned*)(F.lds + LDSCTL_OFF))[u] = 0u;
    __syncthreads();
    XcdBarrier bar; bar.bar = (unsigned*)(F.ctl + CW_BAR); bar.x = 0; bar.st = nullptr;
    if (N_LAUNCHES == 1) bar = xcd_barrier_post((unsigned*)(F.ctl + CW_BAR), F.MISC + 8);
#define GRID_BAR() do { if (N_LAUNCHES == 1) xcd_barrier(bar); } while (0)
    const int lo = args.ph_lo, hi = args.ph_hi;
#define IN(k) (lo <= (k) && (k) < hi)
#define BOTH(k) (IN(k) && IN((k) + 1))
    if (IN(0)) { p0_prologue(F); if (BOTH(0)) GRID_BAR(); }
    if (IN(1)) { p1_norm(F); if (BOTH(1)) GRID_BAR(); }
    if (IN(2)) {
        pg8::Gemm g{F.HXN, F.WIN, MTOT, 8192, D}; InProjOrder S; S.init(F.G, (int)blockIdx.x);
        EpiInProj E{F.PX, F.lb_table};
        pg8::gemm_phase<EpiInProj, InProjOrder, PG8_ALIGN, PG8_SP2>(F.lds + RING_OFF, g, S, E);
        if (BOTH(2)) GRID_BAR();
    }
    if (IN(3)) { p3_mixer(F); if (BOTH(3)) GRID_BAR(); }
    if (IN(4)) { p4_hg_out(F); if (BOTH(4)) GRID_BAR(); }
    if (IN(5)) {
        pg8::Gemm g{F.A2, F.WOUT, T, D, D}; pg8::StaticOrder S; S.init(T, D, F.G, (int)blockIdx.x);
        EpiOutProj E{F.x, F.X1, F.MODF};
        pg8::gemm_phase<EpiOutProj, pg8::StaticOrder, PG8_ALIGN, PG8_SP2>(F.lds + RING_OFF, g, S, E);
        if (BOTH(5)) GRID_BAR();
    }
    if (IN(6)) { p6_router(F); if (BOTH(6)) GRID_BAR(); }
    if (IN(7)) { p7_gather(F); if (BOTH(7)) GRID_BAR(); }
    if (IN(8)) {
        const int NT = moe_tables(F);
        pg8::Gemm g{(const bf16*)F.XG, (const bf16*)F.WGU, CAP, NE * 4096, D}; MoeOrder S; S.init(NT, 16, F.G, (int)blockIdx.x, F.lds + TILE_OFF);
        EpiSwiglu E{F.H, F.b_gu};
        pg8::gemm_phase<EpiSwiglu, MoeOrder, PG8_ALIGN, PG8_SP2, true>(F.lds + RING_OFF, g, S, E);
        if (BOTH(8)) GRID_BAR();
    }
    if (IN(9)) {
        const int NT = moe_tables(F);
        pg8::Gemm g{(const bf16*)F.H, (const bf16*)F.WD, CAP, NE * 2048, FF}; MoeOrder S; S.init(NT, 8, F.G, (int)blockIdx.x, F.lds + TILE_OFF);
        EpiDown E{F.Y, F.b_down};
        pg8::gemm_phase<EpiDown, MoeOrder, PG8_ALIGN, PG8_SP2, true>(F.lds + RING_OFF, g, S, E);
        if (BOTH(9)) GRID_BAR();
    }
    if (IN(10)) { p10_final(F); }
#undef IN
#undef BOTH
}

extern "C" void kernel_launch(void* const* d_in, const int* in_sizes, int n_in, void* d_out, int out_size, void* d_ws, size_t ws_size, hipStream_t stream) {
    static int grid = 0;
    if (grid == 0) {
        if (n_in != 20 || out_size != T * D || ws_size < WS_END) { fprintf(stderr, "kernel_launch: unexpected shapes (n_in %d out %d ws %zu)\n", n_in, out_size, ws_size); grid = -1; return; }
        int dev = 0, cus = 0, per_cu = 0;
        if (hipGetDevice(&dev) != hipSuccess || hipDeviceGetAttribute(&cus, hipDeviceAttributeMultiprocessorCount, dev) != hipSuccess) { grid = -1; return; }
        if (hipFuncSetAttribute((const void*)mk_fwd, hipFuncAttributeMaxDynamicSharedMemorySize, LDS_BYTES) != hipSuccess) { fprintf(stderr, "kernel_launch: hipFuncSetAttribute failed\n"); grid = -1; return; }
        if (hipOccupancyMaxActiveBlocksPerMultiprocessor(&per_cu, (const void*)mk_fwd, NWAVES * 64, LDS_BYTES) != hipSuccess || per_cu < 1)
            fprintf(stderr, "kernel_launch: occupancy query reports %d workgroups per CU\n", per_cu);
        (void)hipGetLastError();
        grid = cus;
    }
    if (grid < 0) return;
    if (hipMemsetAsync((char*)d_ws + WS_CTL, 0, CTL_ZERO_BYTES, stream) != hipSuccess) return;
    Args a{};
    for (int i = 0; i < 20; ++i) a.in[i] = (const float*)d_in[i];
    a.out = (float*)d_out; a.ws = (unsigned char*)d_ws;
    for (int li = 0; li < N_LAUNCHES; ++li) {
        a.ph_lo = (N_LAUNCHES == 1) ? 0 : li; a.ph_hi = (N_LAUNCHES == 1) ? NPHASE : li + 1; a.li = li; a.pad = 0;
        hipLaunchKernelGGL(mk_fwd, dim3(grid), dim3(NWAVES * 64), LDS_BYTES, stream, a);
        const hipError_t le = hipPeekAtLastError();
        if (le != hipSuccess) { fprintf(stderr, "kernel_launch: launch %d failed: %s\n", li, hipGetErrorName(le)); break; }
    }
}
```

```cpp
#define MOE_NB 2
#include <hip/hip_runtime.h>
#include <cstdio>
#include <cstdint>
namespace pg8 {
#define PG8_LAS __attribute__((address_space(3)))
typedef unsigned short bf16_t;
typedef short bf16x8 __attribute__((ext_vector_type(8)));
typedef float f32x4 __attribute__((ext_vector_type(4)));
typedef unsigned u32x4 __attribute__((ext_vector_type(4)));
constexpr int BM = 256, BK = 64, HALF = 128, HTB = HALF * BK * 2  , STAGE_BYTES = 8 * HTB, NXCD = 8, WGM = 8;

__host__ __device__ __forceinline__ int lds_byte2(int r, int chunk) { return r * 128 + 16 * (chunk ^ ((r >> 1) & 7)); }
__host__ __device__ __forceinline__ void stage_rc2(int b, int& R, int& C) { const int row = (b >> 10) * 8 + ((b & 1023) >> 7), pos = (b >> 4) & 7; R = row; C = 8 * (pos ^ ((row >> 1) & 7)); }
__host__ __device__ __forceinline__ int lds_byte(int r, int c) { const int st = (r >> 4) * 2 + (c >> 5), rr = r & 15, cc = c & 31, ob = rr * 64 + cc * 2; return st * 1024 + (ob ^ (((ob >> 9) & 1) << 5)); }
__host__ __device__ __forceinline__ void stage_rc(int b, int& R, int& C) { const int st = b / 1024, sb = b % 1024, swz = sb ^ (((sb >> 9) & 1) << 5); R = (st >> 1) * 16 + swz / 64; C = (st & 1) * 32 + (swz % 64) / 2; }
__host__ __device__ __forceinline__ int perm32(int rho) { const int n = rho >> 4, i = rho & 15; return 8 * (i >> 2) + 4 * n + (i & 3); }

struct Unit { int pm, pn, pa; };
struct Gemm { const bf16_t* A; const bf16_t* Bt; int M, N, K; };

struct StaticOrder {
    static constexpr bool SPARSE_A = false;
    int nM, nN, nwg, G, c;
    __host__ __device__ void init(int M, int N, int G_, int c_) { nM = M / BM; nN = N / BM; nwg = nM * nN; G = G_; c = c_; }
    __host__ __device__ bool next(int i, Unit& u) const {
        const long L = (long)i * G + c; if (L >= nwg) return false;
        int wgid = (int)L; { const int q = nwg / NXCD, r = nwg % NXCD, xcd = wgid % NXCD, off = wgid / NXCD; wgid = (xcd < r ? xcd * (q + 1) : r * (q + 1) + (xcd - r) * q) + off; }
        const int nig = WGM * nN, gid = wgid / nig, fm = gid * WGM, gsz = (nM - fm) < WGM ? (nM - fm) : WGM;
        u.pm = fm + ((wgid % nig) % gsz); u.pn = (wgid % nig) / gsz; return true;
    }
    __device__ __forceinline__ void a_ready(const Unit&) const {}
    __device__ __forceinline__ void done(const Unit&) const {}
};

__device__ __forceinline__ unsigned cvt_pk_bf16(float lo, float hi) { unsigned r; asm volatile("v_cvt_pk_bf16_f32 %0, %1, %2" : "=v"(r) : "v"(lo), "v"(hi)); return r; }
typedef int v8i32 __attribute__((ext_vector_type(8))); typedef int v4i32 __attribute__((ext_vector_type(4))); typedef int v6i32 __attribute__((ext_vector_type(6)));
__device__ __forceinline__ v6i32 sub6(v8i32 x) { return __builtin_shufflevector(x, x, 0, 1, 2, 3, 4, 5); }
__device__ __forceinline__ v8i32 cat_i8(bf16x8 a, bf16x8 b) { const v4i32 x = __builtin_bit_cast(v4i32, a), y = __builtin_bit_cast(v4i32, b); return __builtin_shufflevector(x, y, 0, 1, 2, 3, 4, 5, 6, 7); }
template <class Epi, class Sched, bool ALIGN_EPI = false, bool SP2 = false, int F8 = 0>
__device__ __forceinline__ void gemm_phase(PG8_LAS unsigned char* lds, const Gemm g, const Sched& S, const Epi& E) {
    const int tid = threadIdx.x, wid = __builtin_amdgcn_readfirstlane(tid >> 6), lane = tid & 63, wr = wid >> 2, wc = wid & 3, fr = lane & 15, fq = lane >> 4;
    const int K = g.K, PB = F8 ? K : 2 * K  , nt = PB / 128;
    unsigned voffA[2], voffB[2];
#pragma unroll
    for (int i = 0; i < 2; ++i) { int R, C; stage_rc2(tid * 16 + i * 8192, R, C); const int Rb = Epi::PERM ? ((R & ~31) + perm32(R & 31)) : R;
        voffA[i] = (unsigned)(R * PB + C * 2); voffB[i] = (unsigned)(Rb * PB + C * 2); }
    const size_t kstep = (size_t)(BK * 2);
    const size_t hstep = (size_t)HALF * PB;
    const size_t tstep = 2 * hstep;
    const unsigned ldsw = (unsigned)wid * 1024u;
    const int aoff = lds_byte2(wr * 64 + fr, fq), boff = lds_byte2(wc * 32 + fr, fq), aoff1 = lds_byte2(wr * 64 + fr, fq + 4) - aoff, boff1 = lds_byte2(wc * 32 + fr, fq + 4) - boff;
#define PG8_SA(b, h) (((b) * 2 + (h)) * HTB)
#define PG8_SB(b, h) ((4 + (b) * 2 + (h)) * HTB)
#define PG8_STAGE(bufoff, gbase, voff) do { _Pragma("unroll") for (int _i = 0; _i < 2; ++_i) \
        __builtin_amdgcn_global_load_lds((const unsigned*)((const char*)(gbase) + (voff)[_i]), (PG8_LAS unsigned*)(lds + (bufoff) + ldsw + _i * 8192), 16, 0, 0); } while (0)
#define PG8_LDA(dst, b, h) do { _Pragma("unroll") for (int m = 0; m < 4; ++m) { if constexpr (F8) { dst##8[m] = cat_i8(*(const PG8_LAS bf16x8*)(lds + PG8_SA(b, h) + aoff + m * 2048), *(const PG8_LAS bf16x8*)(lds + PG8_SA(b, h) + aoff + aoff1 + m * 2048)); } \
        else { _Pragma("unroll") for (int k = 0; k < 2; ++k) dst[m][k] = *(const PG8_LAS bf16x8*)(lds + PG8_SA(b, h) + aoff + k * aoff1 + m * 2048); } } } while (0)
#define PG8_LDB(dst, b, h) do { _Pragma("unroll") for (int n = 0; n < 2; ++n) { if constexpr (F8) { dst##8[n] = cat_i8(*(const PG8_LAS bf16x8*)(lds + PG8_SB(b, h) + boff + n * 2048), *(const PG8_LAS bf16x8*)(lds + PG8_SB(b, h) + boff + boff1 + n * 2048)); } \
        else { _Pragma("unroll") for (int k = 0; k < 2; ++k) dst[n][k] = *(const PG8_LAS bf16x8*)(lds + PG8_SB(b, h) + boff + k * boff1 + n * 2048); } } } while (0)
#define PG8_MMA(ai, bj, At, Bt) do { __builtin_amdgcn_s_setprio(1); _Pragma("unroll") for (int m = 0; m < 4; ++m) _Pragma("unroll") for (int n = 0; n < 2; ++n) { \
        if constexpr (F8 == 2) { asm volatile("s_nop 1\n\tv_mfma_scale_f32_16x16x128_f8f6f4 %0, %1, %2, %0, %3, %4 op_sel_hi:[0,0,0] cbsz:2 blgp:2" : "+v"(acc[ai][bj][m][n]) : "v"(sub6(Bt##8[n])), "v"(sub6(At##8[m])), "v"(Bt##8[n][6]), "v"(At##8[m][6])); } \
        else if constexpr (F8 == 1) { asm volatile("v_mfma_scale_f32_16x16x128_f8f6f4 %0, %1, %2, %0, %3, %3 op_sel_hi:[0,0,0]" : "+v"(acc[ai][bj][m][n]) : "v"(Bt##8[n]), "v"(At##8[m]), "v"(f8scale)); } \
        else { _Pragma("unroll") for (int k = 0; k < 2; ++k) acc[ai][bj][m][n] = __builtin_amdgcn_mfma_f32_16x16x32_bf16(Bt[n][k], At[m][k], acc[ai][bj][m][n], 0, 0, 0); } } \
        __builtin_amdgcn_s_setprio(0); } while (0)
#define PG8_WAIT_V(n) asm volatile("s_waitcnt vmcnt(" #n ")" ::: "memory")
#define PG8_WAIT_L(n) asm volatile("s_waitcnt lgkmcnt(" #n ")" ::: "memory")
#define PG8_BAR __builtin_amdgcn_s_barrier()
#define PG8_SCHED __builtin_amdgcn_sched_barrier(0)
    Unit cur, nxt; int ui = 0;
    if (!S.next(0, cur)) return;
    f32x4 acc[2][2][4][2];
#pragma unroll
    for (int a = 0; a < 2; ++a)
#pragma unroll
        for (int b = 0; b < 2; ++b)
#pragma unroll
            for (int m = 0; m < 4; ++m)
#pragma unroll
                for (int n = 0; n < 2; ++n) acc[a][b][m][n] = (f32x4){0.f, 0.f, 0.f, 0.f};
    bf16x8 At[4][2], B0[2][2], B1[2][2]; v8i32 At8[4], B08[2], B18[2]; const int f8scale = 0x7F7F7F7F;
    const char* cA = (const char*)g.A + (size_t)(Sched::SPARSE_A ? cur.pa : cur.pm) * tstep; const char* cB = (const char*)g.Bt + (size_t)cur.pn * tstep;
    S.a_ready(cur);
    if constexpr (SP2) {
        PG8_STAGE(PG8_SB(0, 0), cB, voffB); PG8_STAGE(PG8_SB(0, 1), cB + hstep, voffB); PG8_STAGE(PG8_SA(0, 0), cA, voffA); PG8_STAGE(PG8_SA(0, 1), cA + hstep, voffA);
        if (wr == 1) PG8_BAR;
        PG8_WAIT_V(2); PG8_BAR;
        PG8_STAGE(PG8_SB(1, 0), cB + kstep, voffB); PG8_STAGE(PG8_SA(1, 0), cA + kstep, voffA); PG8_STAGE(PG8_SB(1, 1), cB + hstep + kstep, voffB);
        PG8_WAIT_V(6); PG8_BAR;
    } else {
        PG8_STAGE(PG8_SB(0, 0), cB, voffB); PG8_STAGE(PG8_SA(0, 0), cA, voffA); PG8_STAGE(PG8_SB(0, 1), cB + hstep, voffB); PG8_STAGE(PG8_SA(0, 1), cA + hstep, voffA);
        if (wr == 1) PG8_BAR;
        PG8_WAIT_V(4); PG8_BAR;
        PG8_STAGE(PG8_SB(1, 0), cB + kstep, voffB); PG8_STAGE(PG8_SA(1, 0), cA + kstep, voffA); PG8_STAGE(PG8_SB(1, 1), cB + hstep + kstep, voffB);
        PG8_WAIT_V(6); PG8_BAR;
    }
    for (;;) {
        const bool has_next = S.next(ui + 1, nxt);
        const char* nA = has_next ? (const char*)g.A + (size_t)(Sched::SPARSE_A ? nxt.pa : nxt.pm) * tstep : cA; const char* nB = has_next ? (const char*)g.Bt + (size_t)nxt.pn * tstep : cB;
        for (int t = 0; t < nt; t += 2) {
            const bool last = (t == nt - 2);
            const char* a1 = cA + (size_t)(t + 1) * kstep;
            const char* a2 = last ? nA : cA + (size_t)(t + 2) * kstep; const char* b2 = last ? nB : cB + (size_t)(t + 2) * kstep;
            const char* a3 = a2 + kstep; const char* b3 = b2 + kstep;
            if (last && has_next) S.a_ready(nxt);
            if constexpr (SP2) {
            PG8_LDB(B0, 0, 0); PG8_LDB(B1, 0, 1); PG8_SCHED; PG8_LDA(At, 0, 0); PG8_STAGE(PG8_SA(1, 1), a1 + hstep, voffA);
            PG8_WAIT_V(8); PG8_WAIT_L(0); PG8_BAR; PG8_MMA(0, 0, At, B0); PG8_MMA(0, 1, At, B1); PG8_BAR; PG8_SCHED;
            PG8_LDA(At, 0, 1); PG8_STAGE(PG8_SB(0, 0), b2, voffB); PG8_STAGE(PG8_SB(0, 1), b2 + hstep, voffB); PG8_STAGE(PG8_SA(0, 0), a2, voffA);
            PG8_WAIT_V(8); PG8_WAIT_L(0); PG8_BAR; PG8_MMA(1, 0, At, B0); PG8_MMA(1, 1, At, B1); PG8_BAR; PG8_SCHED;
            PG8_LDB(B0, 1, 0); PG8_LDB(B1, 1, 1); PG8_SCHED; PG8_LDA(At, 1, 0); PG8_STAGE(PG8_SA(0, 1), a2 + hstep, voffA);
            PG8_WAIT_V(8); PG8_WAIT_L(0); PG8_BAR; PG8_MMA(0, 0, At, B0); PG8_MMA(0, 1, At, B1); PG8_BAR; PG8_SCHED;
            PG8_LDA(At, 1, 1); PG8_STAGE(PG8_SB(1, 0), b3, voffB); PG8_STAGE(PG8_SB(1, 1), b3 + hstep, voffB); PG8_STAGE(PG8_SA(1, 0), a3, voffA);
            PG8_WAIT_V(8); PG8_WAIT_L(0); PG8_BAR; PG8_MMA(1, 0, At, B0); PG8_MMA(1, 1, At, B1); PG8_BAR; PG8_SCHED;
            } else {
            PG8_LDB(B0, 0, 0); PG8_SCHED; PG8_LDA(At, 0, 0); PG8_STAGE(PG8_SA(1, 1), a1 + hstep, voffA);
            PG8_WAIT_L(8); PG8_BAR; PG8_WAIT_L(0); PG8_MMA(0, 0, At, B0); PG8_BAR; PG8_SCHED;
            PG8_LDB(B1, 0, 1); PG8_STAGE(PG8_SB(0, 0), b2, voffB);
            PG8_BAR; PG8_WAIT_L(0); PG8_MMA(0, 1, At, B1); PG8_BAR;
            PG8_LDA(At, 0, 1); PG8_STAGE(PG8_SA(0, 0), a2, voffA);
            PG8_BAR; PG8_WAIT_L(0); PG8_MMA(1, 0, At, B0); PG8_BAR; PG8_SCHED;
            PG8_STAGE(PG8_SB(0, 1), b2 + hstep, voffB);
            PG8_WAIT_V(6); PG8_BAR; PG8_MMA(1, 1, At, B1); PG8_BAR;
            PG8_LDB(B0, 1, 0); PG8_SCHED; PG8_LDA(At, 1, 0); PG8_STAGE(PG8_SA(0, 1), a2 + hstep, voffA);
            PG8_WAIT_L(8); PG8_BAR; PG8_WAIT_L(0); PG8_MMA(0, 0, At, B0); PG8_BAR; PG8_SCHED;
            PG8_LDB(B1, 1, 1); PG8_STAGE(PG8_SB(1, 0), b3, voffB);
            PG8_BAR; PG8_WAIT_L(0); PG8_MMA(0, 1, At, B1); PG8_BAR;
            PG8_LDA(At, 1, 1); PG8_STAGE(PG8_SA(1, 0), a3, voffA);
            PG8_BAR; PG8_WAIT_L(0); PG8_MMA(1, 0, At, B0); PG8_BAR; PG8_SCHED;
            PG8_STAGE(PG8_SB(1, 1), b3 + hstep, voffB);
            PG8_WAIT_V(6); PG8_BAR; PG8_MMA(1, 1, At, B1); PG8_BAR;
            }
        }
        if constexpr (ALIGN_EPI) { if (wr == 0) PG8_BAR; }
        if constexpr (F8) { asm volatile("s_nop 15\n\ts_nop 15" ::: "memory"); }
        if constexpr (!Epi::AFTER_DRAIN) { E(acc, cur, wr, wc, fr, fq); S.done(cur); }
        if (!has_next) break;
#pragma unroll
        for (int a = 0; a < 2; ++a)
#pragma unroll
            for (int b = 0; b < 2; ++b)
#pragma unroll
                for (int m = 0; m < 4; ++m)
#pragma unroll
                    for (int n = 0; n < 2; ++n) acc[a][b][m][n] = (f32x4){0.f, 0.f, 0.f, 0.f};
        cur = nxt; cA = nA; cB = nB; ++ui;
        if constexpr (ALIGN_EPI) { if (wr == 1) PG8_BAR; }
    }
    PG8_WAIT_V(0);
    if constexpr (!ALIGN_EPI) { if (wr == 0) PG8_BAR; }
    PG8_BAR;
    if constexpr (Epi::AFTER_DRAIN) { E.fused(acc, cur, wr, wc, fr, fq, lds, wid, lane); S.done(cur); }
#undef PG8_SA
#undef PG8_SB
#undef PG8_STAGE
#undef PG8_LDA
#undef PG8_LDB
#undef PG8_MMA
#undef PG8_WAIT_V
#undef PG8_WAIT_L
#undef PG8_BAR
#undef PG8_SCHED
}
}

#ifndef PG8_SP2
#define PG8_SP2 true
#endif
#ifndef PG8_ALIGN
#define PG8_ALIGN true
#endif
constexpr int NWAVES = 8;
#ifndef MK_N_LAUNCHES
#define MK_N_LAUNCHES 1
#endif
constexpr int NPHASE = 11;
constexpr int N_LAUNCHES = MK_N_LAUNCHES;
static_assert(N_LAUNCHES == 1 || N_LAUNCHES == NPHASE, "MK_N_LAUNCHES is 1 or 11");

constexpr int D = 2048, NB = 8, SEQ = 2048, T = NB * SEQ, LC = 256, TC = NB * LC, MTOT = T + TC;
constexpr int HEADS = 8, HD = 128, MIXG = 1024;
constexpr int SQN = 0, SKN = 1, SVN = 2, SQH = 3, SKF = 4, SKB = 5, SIH = 6, SGF = 7, SGB = 8, NSTREAM = 9;
constexpr size_t HM_CTX0 = (size_t)NSTREAM * NB * HEADS * SEQ * HD, HM_GATE0 = HM_CTX0 + (size_t)NSTREAM * NB * HEADS * LC * HD;
constexpr int NE = 32, TOPK = 4, FF = 2048;
constexpr int CAP_TILES = 288, CAP = CAP_TILES * 256;
constexpr float EPS = 1e-6f;

constexpr size_t MiB = 1u << 20;
constexpr size_t WS_CTL = 0, CTL_ZERO_BYTES = 1 * MiB;
constexpr size_t WS_MODP = 4 * MiB;
constexpr size_t WS_MODF = 6 * MiB;
constexpr size_t WS_WRT = 7 * MiB;
constexpr size_t WS_WIN = 8 * MiB;
constexpr size_t WS_WOUT = 40 * MiB;
constexpr size_t WS_HXN = 48 * MiB;
constexpr size_t WS_PX = 120 * MiB;
constexpr size_t WS_A2 = 480 * MiB;
constexpr size_t WS_OF = 544 * MiB;
constexpr size_t WS_OB = 608 * MiB;
constexpr size_t WS_X1 = 672 * MiB;
constexpr size_t WS_HX2 = 800 * MiB;
constexpr size_t WS_RT = 864 * MiB;
constexpr size_t WS_XG = 2498 * MiB;
constexpr size_t WS_XG_OLD = 866 * MiB;
constexpr size_t WS_H = 1154 * MiB;
constexpr size_t WS_Y = 1442 * MiB;
constexpr size_t WS_WGU = 1730 * MiB;
constexpr size_t WS_WD = 2242 * MiB;
constexpr size_t WS_END = 3522 * MiB;
constexpr int CW_TMO = 0;
constexpr int CW_BAR = 4096, CW_BAR2 = 8192;
constexpr int NCONV = 57, CVA_PER_WAVE = 0;
constexpr int CW_ATTQ = 16384;
constexpr int CW_CNT = 16448;

constexpr int RING_OFF = 0, SCR_BYTES = 139264;
constexpr int LDSCTL_OFF = SCR_BYTES, MISC_OFF = LDSCTL_OFF + 320, TILE_OFF = MISC_OFF + 128, OFFT_OFF = TILE_OFF + 320;
constexpr int LDS_BYTES = 147456;
static_assert(OFFT_OFF + 256 <= LDS_BYTES, "LDS map");

#define GAS __attribute__((address_space(1)))
#define LAS __attribute__((address_space(3)))
typedef unsigned short bf16;
typedef unsigned char u8;
typedef unsigned v4u __attribute__((ext_vector_type(4)));
typedef unsigned v2u __attribute__((ext_vector_type(2)));
typedef float f32x4 __attribute__((ext_vector_type(4)));
typedef float f32x2 __attribute__((ext_vector_type(2)));
typedef short bf16x8 __attribute__((ext_vector_type(8)));
typedef short s16x4 __attribute__((ext_vector_type(4)));
typedef __bf16 bfv2 __attribute__((ext_vector_type(2)));
typedef GAS unsigned gu32;
#define RLX_AGENT __ATOMIC_RELAXED, __HIP_MEMORY_SCOPE_AGENT
#define LDS_WAIT() asm volatile("s_waitcnt lgkmcnt(0)" ::: "memory")
#define VM_WAIT() asm volatile("s_waitcnt vmcnt(0)" ::: "memory")
__device__ __forceinline__ unsigned pk2(float lo, float hi) { f32x2 v = {lo, hi}; bfv2 b = __builtin_convertvector(v, bfv2); return __builtin_bit_cast(unsigned, b); }
constexpr float SW8 = 256.f, SA8 = 8.f, SH8 = 4.f, SY8 = 16.f;
__device__ __forceinline__ unsigned pk4_fp8(float a, float b, float c, float d) {
    a = fminf(fmaxf(a, -448.f), 448.f); b = fminf(fmaxf(b, -448.f), 448.f); c = fminf(fmaxf(c, -448.f), 448.f); d = fminf(fmaxf(d, -448.f), 448.f);
    int w = __builtin_amdgcn_cvt_pk_fp8_f32(a, b, 0, false); w = __builtin_amdgcn_cvt_pk_fp8_f32(c, d, w, true); return (unsigned)w; }
__device__ __forceinline__ size_t hm_lat(int s, int b, int h) { return ((size_t)((s * NB + b) * HEADS + h) * SEQ) * HD; }
__device__ __forceinline__ size_t hm_ctx(int s, int b, int h) { return HM_CTX0 + ((size_t)((s * NB + b) * HEADS + h) * LC) * HD; }
__device__ __forceinline__ size_t hm_row(int s, int row, int h) { return row < T ? hm_lat(s, row >> 11, h) + (size_t)(row & 2047) * HD : hm_ctx(s, (row - T) >> 8, h) + (size_t)((row - T) & 255) * HD; }
__device__ __forceinline__ unsigned pk4_fp8_nc(float a, float b, float c, float d) {
    int w = __builtin_amdgcn_cvt_pk_fp8_f32(a, b, 0, false); w = __builtin_amdgcn_cvt_pk_fp8_f32(c, d, w, true); return (unsigned)w; }
typedef float v16f __attribute__((ext_vector_type(16))); typedef unsigned v6u __attribute__((ext_vector_type(6)));
__device__ __forceinline__ void mx6_pack(const float (&v)[32], v6u& p, unsigned& eb) {
    float m = fabsf(v[0]);
#pragma unroll
    for (int i = 1; i < 32; ++i) m = fmaxf(m, fabsf(v[i]));
    const unsigned mb = __float_as_uint(m);
    int e = (int)(mb >> 23) - 129 + (((mb & 0x7FFFFFu) > 0x700000u) ? 1 : 0);
    e = max(e, -126);
    const float inv = __uint_as_float((unsigned)(127 - e) << 23);
    v16f lo, hi;
#pragma unroll
    for (int i = 0; i < 16; ++i) { lo[i] = v[i] * inv; hi[i] = v[16 + i] * inv; }
    p = __builtin_amdgcn_cvt_scalef32_2xpk16_fp6_f32(lo, hi, 1.0f);
    eb = (unsigned)(e + 127);
}
__device__ __forceinline__ float bflo(unsigned u) { return __uint_as_float(u << 16); }
__device__ __forceinline__ float bfhi(unsigned u) { return __uint_as_float(u & 0xffff0000u); }
__device__ __forceinline__ float wave_sum(float v) {
#pragma unroll
    for (int o = 1; o < 64; o <<= 1) v += __shfl_xor(v, o);
    return v;
}
__device__ __forceinline__ float rcp_f(float x) { return __builtin_amdgcn_rcpf(x); }
__device__ __forceinline__ float silu_f(float x) { return x * rcp_f(1.f + __expf(-x)); }
__device__ __forceinline__ bf16x8 cat8(s16x4 a, s16x4 b) { return __builtin_shufflevector(a, b, 0, 1, 2, 3, 4, 5, 6, 7); }
__device__ __forceinline__ s16x4 tr_read(const LAS unsigned char* p) { return __builtin_amdgcn_ds_read_tr16_b64_v4i16((LAS s16x4*)p); }
__device__ __forceinline__ bf16x8 mk8(unsigned a, unsigned b, unsigned c, unsigned d) { v4u v = {a, b, c, d}; return __builtin_bit_cast(bf16x8, v); }
#define XB_TMO      128
#define XB_XCNT(j)  (256  + 64 * (j))
#define XB_XSUB(j)  (1280 + 64 * (j))
#define XB_XGEN(j)  (2304 + 64 * (j))
#define XB_TOP      3328
#define XB_TOPGEN   3392
#define XCD_BAR_WORDS 3456
#define XB_SPIN_CAP (1u << 18)

__device__ __forceinline__ unsigned xb_ld(unsigned* p)              { return __hip_atomic_load(p, __ATOMIC_RELAXED, __HIP_MEMORY_SCOPE_AGENT); }
__device__ __forceinline__ unsigned xb_add(unsigned* p, unsigned v) { return __hip_atomic_fetch_add(p, v, __ATOMIC_RELAXED, __HIP_MEMORY_SCOPE_AGENT); }
__device__ __forceinline__ unsigned xb_xcc_id() { return (unsigned)__builtin_amdgcn_s_getreg((3 << 11) | 20) & 0xFu; }
#define XB_SPIN(cond, bar) do { unsigned _sp = 0; while (cond) { __builtin_amdgcn_s_sleep(1); \
    if ((++_sp & 255u) == 0u) { if (xb_ld(&(bar)[XB_TMO])) break; if (_sp > XB_SPIN_CAP) { atomicAdd(&(bar)[XB_TMO], 1u); break; } } } } while (0)

struct XcdBarrier {
    unsigned* bar; unsigned x; unsigned total;
    volatile LAS unsigned* st;
};

__device__ __forceinline__ XcdBarrier xcd_barrier_post(unsigned* bar, volatile LAS unsigned* st, unsigned total) {
    XcdBarrier b; b.bar = bar; b.x = xb_xcc_id(); b.st = st; b.total = total;
    if (threadIdx.x == 0) (void)xb_add(&bar[XB_XCNT(b.x)], 1u);
    return b;
}
__device__ __forceinline__ void xcd_barrier_complete(unsigned* bar, unsigned x, unsigned G, unsigned& nloc, unsigned& nx) {
    unsigned sum, cnt, mine, sp = 0u;
    for (;;) {
        sum = 0u; cnt = 0u; mine = 0u;
#pragma unroll
        for (unsigned j = 0; j < 16; ++j) { const unsigned c = xb_ld(&bar[XB_XCNT(j)]); sum += c; cnt += (c > 0u) ? 1u : 0u; mine = (j == x) ? c : mine; }
        if (sum == G) break;
        __builtin_amdgcn_s_sleep(1);
        if ((++sp & 255u) == 0u) { if (xb_ld(&bar[XB_TMO])) break; if (sp > XB_SPIN_CAP) { atomicAdd(&bar[XB_TMO], 1u); break; } }
    }
    nloc = mine > 0u ? mine : 1u; nx = cnt > 0u ? cnt : 1u;
}

__device__ __forceinline__ void xcd_barrier(const XcdBarrier& b) {
    asm volatile("s_waitcnt vmcnt(0)" ::: "memory");
    __syncthreads();
    if (threadIdx.x == 0) {
        unsigned* bar = b.bar;
        __builtin_amdgcn_s_waitcnt(0);
        unsigned nloc = b.st[0], nx = b.st[1];
        if (nloc == 0u) { xcd_barrier_complete(bar, b.x, b.total, nloc, nx); b.st[0] = nloc; b.st[1] = nx; }
        const unsigned old = xb_add(&bar[XB_XSUB(b.x)], 1u);
        const unsigned gen = old / nloc;
        if (old + 1u == (gen + 1u) * nloc) {
            __builtin_amdgcn_fence(__ATOMIC_RELEASE, "agent");
            asm volatile("s_waitcnt vmcnt(0)" ::: "memory");
            const unsigned og = xb_add(&bar[XB_TOP], 1u);
            const unsigned tg = og / nx;
            if (og + 1u == (tg + 1u) * nx) xb_add(&bar[XB_TOPGEN], 1u);
            else XB_SPIN(xb_ld(&bar[XB_TOPGEN]) == tg, bar);
            __builtin_amdgcn_fence(__ATOMIC_ACQUIRE, "agent");
            xb_add(&bar[XB_XGEN(b.x)], 1u);
            asm volatile("s_waitcnt vmcnt(0)" ::: "memory");
        } else {
            XB_SPIN(xb_ld(&bar[XB_XGEN(b.x)]) == gen, bar);
            __builtin_amdgcn_fence(__ATOMIC_ACQUIRE, "agent");
            asm volatile("s_waitcnt vmcnt(0)" ::: "memory");
        }
    }
    __syncthreads();
}

struct Frame {
    LAS unsigned char* lds;
    volatile LAS unsigned* MISC;
    gu32* ctl;
    int tid, lane, wave;
    int vcu, G;
    const float *x, *c, *ctx, *c_ctx, *w_ada, *b_ada, *norm_mix, *norm_ffn, *w_in, *lb_table, *hg_norm, *rpb, *w_out, *w_router, *b_router, *w_gu, *b_gu, *w_down, *b_down, *norm_final;
    float* out;
    float *MODP, *MODF; bf16 *OF, *OB;
    bf16 *WRT, *WIN, *WOUT, *HXN, *PX, *A2, *X1; u8 *HX2, *XG, *H, *WGU, *WD, *Y;
    int *RT_E, *RT_POS, *RT_SLOT; float* RT_G;
};

__device__ __forceinline__ void p0_mod_unit(Frame& F, int unit) {
    const int slab = unit >> 2, ks = unit & 3, col0 = slab * 64, k0 = ks * 512;
    LAS float* cond = (LAS float*)(F.lds);
    LAS float* red = (LAS float*)(F.lds + 9 * 512 * 4);
    for (int i = F.tid; i < 9 * 512; i += 512) { const int r = i >> 9, k = i & 511; const float v = (r < 8) ? F.c[r * D + k0 + k] : F.c_ctx[k0 + k]; cond[i] = silu_f(v); }
    __syncthreads();
    const int c4 = F.tid & 15, kl = F.tid >> 4;
    float acc[9][4];
#pragma unroll
    for (int r = 0; r < 9; ++r) { acc[r][0] = 0.f; acc[r][1] = 0.f; acc[r][2] = 0.f; acc[r][3] = 0.f; }
    const float* wp = F.w_ada + (size_t)(k0 + kl) * (6 * D) + col0 + 4 * c4;
#pragma unroll 4
    for (int it = 0; it < 16; ++it) {
        const f32x4 w = *(const f32x4*)(wp + (size_t)(32 * it) * (6 * D));
#pragma unroll
        for (int r = 0; r < 9; ++r) { const float cv = cond[r * 512 + kl + 32 * it]; acc[r][0] += cv * w.x; acc[r][1] += cv * w.y; acc[r][2] += cv * w.z; acc[r][3] += cv * w.w; }
    }
#pragma unroll
    for (int r = 0; r < 9; ++r)
#pragma unroll
        for (int j = 0; j < 4; ++j) { float v = acc[r][j]; v += __shfl_xor(v, 16); v += __shfl_xor(v, 32); if (F.lane < 16) red[F.wave * 576 + r * 64 + 4 * c4 + j] = v; }
    __syncthreads();
    for (int o = F.tid; o < 576; o += 512) { float s = 0.f;
#pragma unroll
        for (int w = 0; w < 8; ++w) s += red[w * 576 + o];
        const int r = o >> 6, cc = o & 63; F.MODP[(size_t)(ks * 9 + r) * (6 * D) + col0 + cc] = s; }
    __syncthreads();
}
__device__ __forceinline__ void p0_tr_item(const float* W, int ldw, bf16* WT, size_t dst_row0, int k0, int n0, LAS float* scr, int lane, int hi_off = 0) {
#pragma unroll 4
    for (int i = 0; i < 16; ++i) { const int kk = 4 * i + (lane >> 4); const f32x4 v = *(const f32x4*)(W + (size_t)(k0 + kk) * ldw + n0 + 4 * (lane & 15));
        LAS float* s = scr + kk * 65 + 4 * (lane & 15); s[0] = v.x; s[1] = v.y; s[2] = v.z; s[3] = v.w; }
    LDS_WAIT(); asm volatile("" ::: "memory");
    const int c = lane & 7, nn = lane >> 3;
#pragma unroll
    for (int j = 0; j < 8; ++j) { const int n = 8 * j + nn; const LAS float* s = scr + (8 * c) * 65 + n;
        v4u o; o.x = pk2(s[0 * 65], s[1 * 65]); o.y = pk2(s[2 * 65], s[3 * 65]); o.z = pk2(s[4 * 65], s[5 * 65]); o.w = pk2(s[6 * 65], s[7 * 65]);
        *(v4u*)(WT + (dst_row0 + n + (n >= 32 ? hi_off : 0)) * 2048 + k0 + 8 * c) = o; }
    LDS_WAIT(); asm volatile("" ::: "memory");
}
__device__ __forceinline__ void p0_tr_item8(const float* W, int ldw, u8* WT, size_t dst_row0, int k0, int n0, LAS float* scr, int lane, float scale) {
#pragma unroll 4
    for (int i = 0; i < 16; ++i) { const int kk = 8 * i + (lane >> 3); const f32x4 v = *(const f32x4*)(W + (size_t)(k0 + kk) * ldw + n0 + 4 * (lane & 7)) * scale;
        LAS float* s = scr + kk * 33 + 4 * (lane & 7); s[0] = v.x; s[1] = v.y; s[2] = v.z; s[3] = v.w; }
    LDS_WAIT(); asm volatile("" ::: "memory");
    const int n = lane & 31, h = lane >> 5;
#pragma unroll
    for (int j = 0; j < 4; ++j) { const int cj = 2 * j + h; const LAS float* s = scr + (16 * cj) * 33 + n;
        v4u o; o.x = pk4_fp8(s[0 * 33], s[1 * 33], s[2 * 33], s[3 * 33]); o.y = pk4_fp8(s[4 * 33], s[5 * 33], s[6 * 33], s[7 * 33]);
        o.z = pk4_fp8(s[8 * 33], s[9 * 33], s[10 * 33], s[11 * 33]); o.w = pk4_fp8(s[12 * 33], s[13 * 33], s[14 * 33], s[15 * 33]);
        *(v4u*)(WT + (dst_row0 + n) * 2048 + k0 + 16 * cj) = o; }
    LDS_WAIT(); asm volatile("" ::: "memory");
}
__device__ __forceinline__ void p0_prologue(Frame& F, bool with_moe) {
    for (int u = F.vcu; u < 768; u += F.G) p0_mod_unit(F, u);
    LAS float* scr = (LAS float*)(F.lds + F.wave * 16896);
    const int gw = F.vcu * NWAVES + F.wave, NGW = F.G * NWAVES;
    constexpr int I_IN = 32 * 128, I_OUT = 32 * 32, I_GU = 32 * 64, I_DN = 32 * 32;
    const int NITEMS = I_IN + I_OUT + (with_moe ? NE * I_GU + NE * I_DN : 0);
    for (int it = gw; it < NITEMS; it += NGW) {
        int r = it;
        if (r < I_IN) { const int kb = r >> 7, nb = r & 127, n0 = nb * 64, part = n0 >> 10;
            const bool prm = (part >= 3 && part <= 5); const int cl = n0 & 255;
            const size_t drow = prm ? (size_t)((n0 & ~255) + 32 * ((cl >> 7) * 2 + ((cl >> 6) & 1))) : (size_t)n0;
            p0_tr_item(F.w_in, 8192, F.WIN, drow, kb * 64, n0, scr, F.lane, prm ? 96 : 0); continue; } r -= I_IN;
        if (r < I_OUT) { const int kb = r >> 6, nb = r & 63; p0_tr_item8(F.w_out, 2048, (u8*)F.WOUT, (size_t)nb * 32, kb * 128, nb * 32, scr, F.lane, SW8); continue; } r -= I_OUT;
        if (r < NE * I_GU) { const int e = r >> 11, q = r & 2047, kb = q >> 7, nb = q & 127, n0 = nb * 32;
            const size_t drow = (size_t)e * 4096 + (size_t)(((n0 & 2047) >> 7) * 256 + (n0 >> 11) * 128 + (n0 & 127));
            p0_tr_item8(F.w_gu + (size_t)e * 2048 * 4096, 4096, F.WGU, drow, kb * 128, n0, scr, F.lane, SW8); continue; } r -= NE * I_GU;
        { const int e = r >> 10, q = r & 1023, kb = q >> 6, nb = q & 63; p0_tr_item8(F.w_down + (size_t)e * 2048 * 2048, 2048, F.WD, (size_t)e * 2048 + nb * 32, kb * 128, nb * 32, scr, F.lane, SW8); }
    }
    for (int i = F.vcu * 512 + F.tid; i < NE * D; i += F.G * 512) { const int e = i >> 11, k = i & 2047; const float w = F.w_router[k * NE + e];
        const unsigned hi = pk2(w, 0.f) & 0xffffu; const float wl = w - bflo(hi); F.WRT[i] = (bf16)hi; F.WRT[NE * D + i] = (bf16)(pk2(wl, 0.f) & 0xffffu); }
}

struct CvItem { const float* src; u8* dst; int ldw; int t6; };
__device__ __forceinline__ CvItem cv_decode(Frame& F, int r) {
    CvItem c;
    if (r < NE * 2048) { const int e = r >> 11, q = r & 2047, kb = q >> 7, nb = q & 127, n0 = nb * 32;
        const size_t drow = (size_t)e * 4096 + (size_t)(((n0 & 2047) >> 7) * 256 + (n0 >> 11) * 128 + (n0 & 127));
        c.src = F.w_gu + (size_t)e * 2048 * 4096 + (size_t)(kb * 128) * 4096 + n0; c.ldw = 4096; c.dst = F.WGU + drow * 2048 + kb * 128; c.t6 = 1; }
    else { r -= NE * 2048; const int e = r >> 10, q = r & 1023, kb = q >> 6, nb = q & 63;
        c.src = F.w_down + (size_t)e * 2048 * 2048 + (size_t)(kb * 128) * 2048 + nb * 32; c.ldw = 2048; c.dst = F.WD + ((size_t)e * 2048 + nb * 32) * 2048 + kb * 128; c.t6 = 0; }
    return c;
}
__device__ __forceinline__ void cv_load(f32x4 (&v)[16], const CvItem& c, int lane) {
    const float* p = c.src + (size_t)(16 * (lane >> 3)) * c.ldw + 4 * (lane & 7);
#pragma unroll
    for (int i = 0; i < 16; ++i) v[i] = __builtin_nontemporal_load((const f32x4*)(p + (size_t)i * c.ldw));
}
__device__ __forceinline__ void cv_proc(const f32x4 (&v)[16], const CvItem& c, LAS float* scr, int lane) {
    (void)scr;
    if (c.t6) {
        const bool odd = (lane >> 3) & 1;
        float lo[2][16], hi[2][16];
#pragma unroll
        for (int i = 0; i < 16; ++i) {
            const float sx = odd ? v[i].x : v[i].z, sy = odd ? v[i].y : v[i].w, ox = odd ? v[i].z : v[i].x, oy = odd ? v[i].w : v[i].y;
            const float rx = __int_as_float(__builtin_amdgcn_mov_dpp(__float_as_int(sx), 0x128, 0xf, 0xf, true)), ry = __int_as_float(__builtin_amdgcn_mov_dpp(__float_as_int(sy), 0x128, 0xf, 0xf, true));
            lo[0][i] = odd ? rx : ox; hi[0][i] = odd ? ox : rx; lo[1][i] = odd ? ry : oy; hi[1][i] = odd ? oy : ry; }
        u8* d6 = c.dst + (size_t)(4 * (lane & 7) + (odd ? 2 : 0)) * 2048 + 16 * (lane >> 4);
#pragma unroll
        for (int cc = 0; cc < 2; ++cc) { float hv[32];
#pragma unroll
            for (int j = 0; j < 16; ++j) { hv[j] = lo[cc][j]; hv[16 + j] = hi[cc][j]; }
            v6u p; unsigned eb; mx6_pack(hv, p, eb);
            __builtin_nontemporal_store((v4u){p[0], p[1], p[2], p[3]}, (v4u*)(d6 + (size_t)cc * 2048)); __builtin_nontemporal_store((v4u){p[4], p[5], eb, 0u}, (v4u*)(d6 + (size_t)cc * 2048 + 64)); }
        return; }
    u8* d = c.dst + (size_t)(4 * (lane & 7)) * 2048 + 16 * (lane >> 3);
#pragma unroll
    for (int cc = 0; cc < 4; ++cc) { v4u o;
        o.x = pk4_fp8(v[0][cc] * SW8, v[1][cc] * SW8, v[2][cc] * SW8, v[3][cc] * SW8); o.y = pk4_fp8(v[4][cc] * SW8, v[5][cc] * SW8, v[6][cc] * SW8, v[7][cc] * SW8);
        o.z = pk4_fp8(v[8][cc] * SW8, v[9][cc] * SW8, v[10][cc] * SW8, v[11][cc] * SW8); o.w = pk4_fp8(v[12][cc] * SW8, v[13][cc] * SW8, v[14][cc] * SW8, v[15][cc] * SW8);
        __builtin_nontemporal_store(o, (v4u*)(d + (size_t)cc * 2048)); }
}
__device__ __forceinline__ void convert_moe(Frame& F, int gw, int ngw, int lo, int hi) {
    f32x4 va[16], vb[16];
    int it = lo + gw;
    if (it >= hi) return;
    CvItem ca = cv_decode(F, it), cb = ca;
    cv_load(va, ca, F.lane);
    for (;;) {
        const bool hb = it + ngw < hi;
        if (hb) { cb = cv_decode(F, it + ngw); cv_load(vb, cb, F.lane); }
        cv_proc(va, ca, nullptr, F.lane);
        if (!hb) break;
        it += ngw;
        const bool ha = it + ngw < hi;
        if (ha) { ca = cv_decode(F, it + ngw); cv_load(va, ca, F.lane); }
        cv_proc(vb, cb, nullptr, F.lane);
        if (!ha) break;
        it += ngw;
    }
}

__device__ __forceinline__ void p1_build_vec(Frame& F, int bb, int sh_off, int sc_off, const float* gain, bool from_partials) {
    LAS float* Av = (LAS float*)(F.lds); LAS float* Bv = Av + D;
    for (int c = F.tid; c < D; c += 512) {
        float sh, sc;
        if (from_partials) { sh = F.b_ada[sh_off + c]; sc = F.b_ada[sc_off + c];
#pragma unroll
            for (int ks = 0; ks < 4; ++ks) { sh += F.MODP[(size_t)(ks * 9 + bb) * (6 * D) + sh_off + c]; sc += F.MODP[(size_t)(ks * 9 + bb) * (6 * D) + sc_off + c]; } }
        else { sh = F.MODF[(size_t)bb * (6 * D) + sh_off + c]; sc = F.MODF[(size_t)bb * (6 * D) + sc_off + c]; }
        Av[c] = gain[c] * (1.f + sc); Bv[c] = sh; }
    __syncthreads();
}
__device__ __forceinline__ void norm_row_bf16(Frame& F, const float* xrow, bf16* orow) {
    const LAS f32x4* Av = (const LAS f32x4*)(F.lds); const LAS f32x4* Bv = Av + D / 4;
    const f32x4* xr = (const f32x4*)xrow + F.lane;
    f32x4 v[8]; float s = 0.f;
#pragma unroll
    for (int j = 0; j < 8; ++j) { v[j] = xr[64 * j]; s += (v[j].x * v[j].x + v[j].y * v[j].y) + (v[j].z * v[j].z + v[j].w * v[j].w); }
    const float rstd = rsqrtf(wave_sum(s) * (1.f / D) + EPS);
    v2u* o8 = (v2u*)orow + F.lane;
#pragma unroll
    for (int j = 0; j < 8; ++j) { const f32x4 a = Av[F.lane + 64 * j], b = Bv[F.lane + 64 * j]; const f32x4 y = v[j] * rstd * a + b;
        v2u o; o.x = pk2(y.x, y.y); o.y = pk2(y.z, y.w); o8[64 * j] = o; }
}
__device__ __forceinline__ void p1_norm(Frame& F) {
    for (int i = F.vcu * 512 + F.tid; i < 9 * 6 * D; i += F.G * 512) { float s = F.b_ada[i % (6 * D)];
#pragma unroll
        for (int ks = 0; ks < 4; ++ks) s += F.MODP[(size_t)ks * 9 * 6 * D + i];
        F.MODF[i] = s; }
    for (int blk = F.vcu; blk < 256; blk += F.G) {
        const int bb = blk >> 5;
        p1_build_vec(F, bb, 0, D, F.norm_mix, true);
        for (int r = F.wave; r < 64; r += NWAVES) { const int row = blk * 64 + r; norm_row_bf16(F, F.x + (size_t)row * D, F.HXN + (size_t)row * D); }
        __syncthreads();
        p1_build_vec(F, 8, 0, D, F.norm_mix, true);
        { const int row = blk * 8 + F.wave; norm_row_bf16(F, F.ctx + (size_t)row * D, F.HXN + (size_t)(T + row) * D); }
        __syncthreads();
    }
}

struct InProjOrder {
    static constexpr bool SPARSE_A = false;
    pg8::StaticOrder so; int G, c;
    __device__ void init(int G_, int c_) { so.init(T, 8192, G_, c_); G = G_; c = c_; }
    __device__ bool next(int i, pg8::Unit& u) const {
        const int L = i * G + c;
        if (L < 2048) return so.next(i, u);
        const int idx = L - 2048; if (idx >= 160) return false;
        const int q = idx % 20; u.pm = 64 + idx / 20; u.pn = q < 8 ? 4 + q : 8 + q; return true;
    }
    __device__ __forceinline__ void a_ready(const pg8::Unit&) const {}
    __device__ __forceinline__ void done(const pg8::Unit&) const {}
};
struct EpiInProj {
    static constexpr bool PERM = true, AFTER_DRAIN = false;
    bf16* PX; const float* lbt;
    __device__ __forceinline__ void operator()(const f32x4 (&acc)[2][2][4][2], const pg8::Unit& u, int wr, int wc, int fr, int fq) const {
        const int row0 = u.pm * 256 + wr * 64 + fr, part = u.pn >> 2;
        if (part >= 3 && part <= 5) {
            const int axis = wc & 1, cbase = u.pn * 256 + (wc >> 1) * 128 + axis * 64 + 8 * fq;
            const int hh = (u.pn & 3) * 2 + (wc >> 1), cc0 = axis * 64 + 8 * fq, sk = (part == 3) ? SQH : (part == 4 ? SKF : SKB), sg = (part == 4) ? SGF : SGB;
            const bool lat = u.pm < 64, gate = part != 3;
            float invf[8], lb1[8], lb2[8];
#pragma unroll
            for (int i = 0; i < 8; ++i) { invf[i] = __expf(-(float)(8 * fq + i) * 0.28782313662425574f); lb1[i] = 0.f; lb2[i] = 0.f; }
            if (gate) {
#pragma unroll
                for (int i = 0; i < 8; ++i) { const int c1 = cbase + i - 4096; lb1[i] = rcp_f(1.f + __expf(lbt[2048 + c1] - lbt[c1])); lb2[i] = rcp_f(1.f + __expf(lbt[2048 + c1 + 32] - lbt[c1 + 32])); } }
#pragma unroll
            for (int ai = 0; ai < 2; ++ai) {
                const float prow = (float)(((u.pm * 256 + ai * 128 + wr * 64) & 2047) >> 6);
#pragma unroll
                for (int m = 0; m < 4; ++m) {
                    const float pos = axis ? (float)(16 * m + fr) : prow;
                    const int row = row0 + ai * 128 + m * 16; bf16* rowp = PX + hm_row(sk, row, hh) + cc0; bf16* rowg = PX + hm_row(sg, row, hh) + cc0;
                    float x1[8], x2[8];
#pragma unroll
                    for (int i = 0; i < 8; ++i) { x1[i] = acc[ai][0][m][i >> 2][i & 3]; x2[i] = acc[ai][1][m][i >> 2][i & 3]; }
                    if (gate) {
                        float g1[8], g2[8];
#pragma unroll
                        for (int i = 0; i < 8; ++i) {
                            const float xa = fminf(fmaxf(x1[i], -30.f), 30.f), xb = fminf(fmaxf(x2[i], -30.f), 30.f);
                            const float sa = rcp_f(1.f + __expf(-xa)), sb = rcp_f(1.f + __expf(-xb));
                            g1[i] = __log2f(lb1[i] + (1.f - lb1[i]) * sa); g2[i] = __log2f(lb2[i] + (1.f - lb2[i]) * sb);
                            x1[i] = (1.f - lb1[i]) * (1.f - sa); x2[i] = (1.f - lb2[i]) * (1.f - sb); }
                        v4u w; w.x = pk2(g1[0], g1[1]); w.y = pk2(g1[2], g1[3]); w.z = pk2(g1[4], g1[5]); w.w = pk2(g1[6], g1[7]); *(v4u*)(rowg) = w;
                        w.x = pk2(g2[0], g2[1]); w.y = pk2(g2[2], g2[3]); w.z = pk2(g2[4], g2[5]); w.w = pk2(g2[6], g2[7]); *(v4u*)(rowg + 32) = w;
                    }
                    if (lat) {
#pragma unroll
                        for (int i = 0; i < 8; ++i) { const float a = pos * invf[i], cs = __cosf(a), sn = __sinf(a); const float o1 = x1[i] * cs - x2[i] * sn, o2 = x2[i] * cs + x1[i] * sn; x1[i] = o1; x2[i] = o2; } }
                    v4u w; w.x = pk2(x1[0], x1[1]); w.y = pk2(x1[2], x1[3]); w.z = pk2(x1[4], x1[5]); w.w = pk2(x1[6], x1[7]); *(v4u*)(rowp) = w;
                    w.x = pk2(x2[0], x2[1]); w.y = pk2(x2[2], x2[3]); w.z = pk2(x2[4], x2[5]); w.w = pk2(x2[6], x2[7]); *(v4u*)(rowp + 32) = w;
                    __builtin_amdgcn_sched_barrier(0);
                }
            }
        } else {
            const float sc = (part == 0) ? 0.08838834764831845f : 1.f;
            const int strm = (part == 6) ? SIH : part, cp = (u.pn & 3) * 256 + wc * 32 + 8 * fq;
#pragma unroll
            for (int ai = 0; ai < 2; ++ai)
#pragma unroll
                for (int m = 0; m < 4; ++m) { const int row = row0 + ai * 128 + m * 16;
#pragma unroll
                    for (int bj = 0; bj < 2; ++bj) { const f32x4 v0 = acc[ai][bj][m][0] * sc, v1 = acc[ai][bj][m][1] * sc;
                        v4u w; w.x = pk2(v0[0], v0[1]); w.y = pk2(v0[2], v0[3]); w.z = pk2(v1[0], v1[1]); w.w = pk2(v1[2], v1[3]);
                        const int cq = cp + bj * 128;
                        bf16* dst = (part == 7) ? PX + HM_GATE0 + (size_t)row * MIXG + cq : PX + hm_row(strm, row, cq >> 7) + (cq & 127);
                        *(v4u*)dst = w; } __builtin_amdgcn_sched_barrier(0); }
        }
    }
};

#define LDS_BAR() do { asm volatile("s_waitcnt lgkmcnt(0)" ::: "memory"); __builtin_amdgcn_s_barrier(); asm volatile("" ::: "memory"); } while (0)
#define MFMA16(a, b, c) __builtin_amdgcn_mfma_f32_16x16x32_bf16((a), (b), (c), 0, 0, 0)
struct GlaRegs { unsigned pq[8], pk[8], pg[8]; v4u pv[2]; };
__device__ __forceinline__ void gla_load(Frame& F, GlaRegs& R, int n, int b, int h, int dir) {
    const int lat = n >= 4, s0 = lat ? 64 * (n - 4) : 64 * n, sk = dir ? SKB : SKF, sg = dir ? SGB : SGF;
    const bf16* bq = F.PX + hm_lat(SQH, b, h) + 2 * F.lane;
    const bf16* bk = F.PX + (lat ? hm_lat(sk, b, h) : hm_ctx(sk, b, h)) + 2 * F.lane;
    const bf16* bg = F.PX + (lat ? hm_lat(sg, b, h) : hm_ctx(sg, b, h)) + 2 * F.lane;
    const bf16* bv = F.PX + (lat ? hm_lat(SIH, b, h) : hm_ctx(SIH, b, h));
#pragma unroll
    for (int i = 0; i < 8; ++i) { const int s = s0 + 8 * F.wave + i; const int tok = lat ? (dir ? 2047 - s : s) : (dir ? 255 - s : s);
        R.pq[i] = lat ? *(const unsigned*)(bq + (size_t)tok * HD) : 0u; R.pk[i] = *(const unsigned*)(bk + (size_t)tok * HD); R.pg[i] = *(const unsigned*)(bg + (size_t)tok * HD); }
#pragma unroll
    for (int j = 0; j < 2; ++j) { const int p = F.tid + 512 * j, Rr = p >> 4, ch = p & 15, s = s0 + Rr; const int tok = lat ? (dir ? 2047 - s : s) : (dir ? 255 - s : s);
        R.pv[j] = *(const v4u*)(bv + (size_t)tok * HD + ch * 8); }
}
__device__ __forceinline__ void gla_chunk(Frame& F, GlaRegs& R, f32x4 (&S)[8], int n, int b, int h, int dir, bf16* OUT) {
    const int lane = F.lane, wave = F.wave, tid = F.tid, kq = lane >> 4, fr = lane & 15;
    LAS unsigned char* L = F.lds;
    constexpr int PIT = 272;
    constexpr int O_QE = 0, O_QD = 17408, O_KD = 34816, O_V = 52224, O_KEX = 69632, O_ATT = 113152, O_SUB = 122368, O_DECL = 126464;
    const bool lat = n >= 4;
    const int s0 = lat ? 64 * (n - 4) : 64 * n;
#pragma unroll
    for (int j = 0; j < 2; ++j) { const int p = tid + 512 * j, Rr = p >> 4, ch = p & 15; *(LAS v4u*)(L + O_V + Rr * PIT + ch * 16) = R.pv[j]; }
    float qa[8], qb[8], ka[8], kb[8], ca[8], cb[8];
    float ra = 0.f, rb = 0.f;
#pragma unroll
    for (int i = 0; i < 8; ++i) { qa[i] = bflo(R.pq[i]); qb[i] = bfhi(R.pq[i]); ka[i] = bflo(R.pk[i]); kb[i] = bfhi(R.pk[i]); ra += bflo(R.pg[i]); rb += bfhi(R.pg[i]); ca[i] = ra; cb[i] = rb; }
    *(LAS f32x2*)(L + O_SUB + (wave * 128 + 2 * lane) * 4) = (f32x2){ra, rb};
    if (n + 2 < 36) gla_load(F, R, n + 2, b, h, dir);
    LDS_BAR();
    {
        float refa[4], refb[4], pa = 0.f, pb = 0.f, ta = 0.f, tb = 0.f;
#pragma unroll
        for (int w = 0; w < 8; ++w) { const f32x2 sv = *(const LAS f32x2*)(L + O_SUB + (w * 128 + 2 * lane) * 4);
            if ((w & 1) == 0) { refa[w >> 1] = ta; refb[w >> 1] = tb; }
            if (w < wave) { pa += sv.x; pb += sv.y; }
            ta += sv.x; tb += sv.y; }
        const int I = wave >> 1;
        float rIa = refa[0], rIb = refb[0];
#pragma unroll
        for (int q = 1; q < 4; ++q) if (I == q) { rIa = refa[q]; rIb = refb[q]; }
        const float eRa = __builtin_amdgcn_exp2f(rIa), eRb = __builtin_amdgcn_exp2f(rIb), eTa = __builtin_amdgcn_exp2f(ta - rIa), eTb = __builtin_amdgcn_exp2f(tb - rIb);
        float Rqa[4], Rqb[4];
#pragma unroll
        for (int q = 0; q < 4; ++q) { Rqa[q] = __builtin_amdgcn_exp2f(refa[q] - rIa); Rqb[q] = __builtin_amdgcn_exp2f(refb[q] - rIb); }
        const float da0 = pa - rIa, db0 = pb - rIb;
#pragma unroll
        for (int i = 0; i < 8; ++i) {
            const int Rr = 8 * wave + i;
            const float ea = __builtin_amdgcn_exp2f(da0 + ca[i]), eb = __builtin_amdgcn_exp2f(db0 + cb[i]);
            const float kra = ka[i] * __builtin_amdgcn_rcpf(ea), krb = kb[i] * __builtin_amdgcn_rcpf(eb);
            *(LAS unsigned*)(L + O_KD + Rr * PIT + 4 * lane) = pk2(kra * eTa, krb * eTb);
            if (lat) {
                const float qea = qa[i] * ea, qeb = qb[i] * eb;
                *(LAS unsigned*)(L + O_QE + Rr * PIT + 4 * lane) = pk2(qea, qeb);
                *(LAS unsigned*)(L + O_QD + Rr * PIT + 4 * lane) = pk2(qea * eRa, qeb * eRb);
#pragma unroll
                for (int Ip = 0; Ip < 4; ++Ip) if (Ip >= I) {
                    const int row = 16 * (Ip * (Ip + 1) / 2 + I) + (Rr & 15);
                    *(LAS unsigned*)(L + O_KEX + row * PIT + 4 * lane) = pk2(kra * Rqa[Ip], krb * Rqb[Ip]); }
            }
        }
        if (wave == 0) *(LAS f32x2*)(L + O_DECL + 8 * lane) = (f32x2){__builtin_amdgcn_exp2f(ta), __builtin_amdgcn_exp2f(tb)};
    }
    LDS_BAR();
    if (lat) {
        for (int tt = wave; tt < 10; tt += 8) {
            const int I = (tt >= 6) ? 3 : (tt >= 3) ? 2 : (tt >= 1) ? 1 : 0, J = tt - I * (I + 1) / 2;
            f32x4 X = (f32x4){0.f, 0.f, 0.f, 0.f};
#pragma unroll
            for (int ks = 0; ks < 4; ++ks) {
                const bf16x8 a = *(const LAS bf16x8*)(L + O_KEX + (16 * tt + fr) * PIT + ks * 64 + kq * 16);
                const bf16x8 bq = *(const LAS bf16x8*)(L + O_QE + (16 * I + fr) * PIT + ks * 64 + kq * 16);
                X = MFMA16(a, bq, X); }
            if (J == I) {
#pragma unroll
                for (int r = 0; r < 4; ++r) if (4 * kq + r > fr) X[r] = 0.f; }
            v2u o; o.x = pk2(X[0], X[1]); o.y = pk2(X[2], X[3]);
            *(LAS v2u*)(L + O_ATT + (16 * I + fr) * 144 + (16 * J + 4 * kq) * 2) = o;
        }
    }
    LDS_BAR();
    {
        const int q4 = fr >> 2, pp = fr & 3;
        bf16x8 Vf[2];
#pragma unroll
        for (int p = 0; p < 2; ++p) { const LAS unsigned char* vb = L + O_V + (32 * p + 8 * kq + q4) * PIT + (16 * wave + 4 * pp) * 2;
            Vf[p] = cat8(tr_read(vb), tr_read(vb + 4 * PIT)); }
        if (lat) {
            bf16x8 Sb[4];
#pragma unroll
            for (int ks = 0; ks < 4; ++ks) Sb[ks] = mk8(pk2(S[2 * ks][0], S[2 * ks][1]), pk2(S[2 * ks][2], S[2 * ks][3]), pk2(S[2 * ks + 1][0], S[2 * ks + 1][1]), pk2(S[2 * ks + 1][2], S[2 * ks + 1][3]));
#pragma unroll
            for (int I = 0; I < 4; ++I) {
                f32x4 o = (f32x4){0.f, 0.f, 0.f, 0.f};
#pragma unroll
                for (int p = 0; p < 2; ++p) if (p <= (I >> 1)) { const bf16x8 a = *(const LAS bf16x8*)(L + O_ATT + (16 * I + fr) * 144 + p * 64 + kq * 16); o = MFMA16(a, Vf[p], o); }
#pragma unroll
                for (int ks = 0; ks < 4; ++ks) { const LAS unsigned char* qp = L + O_QD + (16 * I + fr) * PIT + (32 * ks + 4 * kq) * 2;
                    const v2u lo = *(const LAS v2u*)qp, hi = *(const LAS v2u*)(qp + 32);
                    o = MFMA16(mk8(lo.x, lo.y, hi.x, hi.y), Sb[ks], o); }
#pragma unroll
                for (int j = 0; j < 2; ++j) {
                    const bool oddl = fr & 1;
                    const float snd = oddl ? o[j] : o[2 + j], own = oddl ? o[2 + j] : o[j];
                    const float rcv = __int_as_float(__builtin_amdgcn_mov_dpp(__float_as_int(snd), 0xB1, 0xf, 0xf, true));
                    const int s = s0 + 16 * I + 4 * kq + (oddl ? 2 : 0) + j, tok = dir ? 2047 - s : s;
                    *(unsigned*)(OUT + (size_t)(b * SEQ + tok) * MIXG + h * HD + 16 * wave + (fr & ~1)) = oddl ? pk2(rcv, own) : pk2(own, rcv); }
            }
        }
#pragma unroll
        for (int dkb = 0; dkb < 8; ++dkb) {
            const f32x4 dec = *(const LAS f32x4*)(L + O_DECL + (16 * dkb + 4 * kq) * 4);
            f32x4 s = S[dkb] * dec;
#pragma unroll
            for (int p = 0; p < 2; ++p) { const LAS unsigned char* kb_ = L + O_KD + (32 * p + 8 * kq + q4) * PIT + (16 * dkb + 4 * pp) * 2;
                s = MFMA16(cat8(tr_read(kb_), tr_read(kb_ + 4 * PIT)), Vf[p], s); }
            S[dkb] = s;
        }
    }
    LDS_BAR();
}
__device__ __forceinline__ void gla_chain(Frame& F, int chain) {
    const int b = chain >> 4, h = (chain >> 1) & 7, dir = chain & 1;
    for (int i = F.tid; i < 9216 / 4; i += 512) ((LAS unsigned*)(F.lds + 113152))[i] = 0u;
    f32x4 S[8];
#pragma unroll
    for (int i = 0; i < 8; ++i) S[i] = (f32x4){0.f, 0.f, 0.f, 0.f};
    bf16* OUT = dir ? F.OB : F.OF;
    GlaRegs R0, R1;
    gla_load(F, R0, 0, b, h, dir); gla_load(F, R1, 1, b, h, dir);
    for (int n = 0; n < 36; n += 2) { gla_chunk(F, R0, S, n, b, h, dir, OUT); gla_chunk(F, R1, S, n + 1, b, h, dir, OUT); }
}

__device__ __forceinline__ void attn_run(Frame& F, int ubase, int ustride, int ucnt) {
    const int lane = F.lane, wave = F.wave, tid = F.tid, kq = lane >> 4, fr = lane & 15, j = wave & 3, role = wave >> 2;
    LAS unsigned char* L = F.lds;
    constexpr int PIT = 272;
    constexpr int PITV = 288;
    constexpr int O_KW = 0, O_VW = 34816, O_KC = 71680, O_VC = 89088, O_RPB = 107520, O_MG = 0;
    const int kc0 = min(max(16 * j - 8, 0), 32), qcol = 16 * j + fr, cs = min(max(qcol - 8, 0), 48);
    const int q4 = fr >> 2, pp = fr & 3;
    unsigned inmask = 0u; const int dbase = kc0 + 4 * kq - qcol + 15;
#pragma unroll
    for (int e = 0; e < 8; ++e) { const int kc = kc0 + 16 * (e >> 2) + 4 * kq + (e & 3); inmask |= ((kc >= cs) && (kc < cs + 16)) ? (1u << e) : 0u; }
    v4u st[1][8], sc4[4];
    const unsigned tb = (unsigned)(((tid >> 4) * HD + (tid & 15) * 8) * 2);
#define ATT_LD16(basep_) (*(const v4u*)((const char*)(basep_) + tb))
#define ATT_LOAD(set_, u_, s_) do { const int b_ = (u_) >> 8, h_ = ((u_) >> 5) & 7, r_ = (u_) & 31, k0_ = min(max(r_ - 4, 0), 24); \
        const bf16* kb_ = F.PX + hm_lat(SKN, b_, h_) + (size_t)((k0_ + 2 * (s_)) * 64) * HD; const bf16* vb_ = F.PX + hm_lat(SVN, b_, h_) + (size_t)((k0_ + 2 * (s_)) * 64) * HD; \
        _Pragma("unroll") for (int m = 0; m < 4; ++m) { st[set_][m] = ATT_LD16(kb_ + 32 * m * HD); st[set_][4 + m] = ATT_LD16(vb_ + 32 * m * HD); } } while (0)
#define ATT_LOADC(u_, s_) do { const int b_ = (u_) >> 8, h_ = ((u_) >> 5) & 7; \
        const bf16* kc_ = F.PX + hm_ctx(SKN, b_, h_) + (size_t)(64 * (s_)) * HD; const bf16* vc_ = F.PX + hm_ctx(SVN, b_, h_) + (size_t)(64 * (s_)) * HD; \
        _Pragma("unroll") for (int m = 0; m < 2; ++m) { sc4[m] = ATT_LD16(kc_ + 32 * m * HD); sc4[2 + m] = ATT_LD16(vc_ + 32 * m * HD); } } while (0)
#define ATT_QLOAD(dst_, u_) do { const int b_ = (u_) >> 8, h_ = ((u_) >> 5) & 7, r_ = (u_) & 31; const bf16* qp = F.PX + hm_lat(SQN, b_, h_) + (size_t)(r_ * 64 + qcol) * HD + 8 * kq; \
        _Pragma("unroll") for (int ks = 0; ks < 4; ++ks) dst_[ks] = *(const bf16x8*)(qp + 32 * ks); } while (0)
    if (ucnt <= 0) return;
    const int u0 = ubase;
    ATT_LOAD(0, u0, 0); ATT_LOADC(u0, 0);
    bf16x8 qf[4];
    ATT_QLOAD(qf, u0);
    int hcur = -1;
    for (int ui = 0; ui < ucnt; ++ui) {
        const int u = ubase + ui * ustride, un = u + ustride; const bool more = ui + 1 < ucnt;
        const int b = u >> 8, h = (u >> 5) & 7, r = u & 31, kr0 = min(max(r - 4, 0), 24);
        if (h != hcur) { LDS_BAR(); for (int i = tid; i < 465; i += 512) ((LAS float*)(L + O_RPB))[i] = F.rpb[h * 465 + i]; hcur = h; }
        f32x4 O[8];
#pragma unroll
        for (int i = 0; i < 8; ++i) O[i] = (f32x4){0.f, 0.f, 0.f, 0.f};
        float mrun = -1e30f, lrun = 0.f;
#pragma unroll
        for (int s = 0; s < 4; ++s) {
            LDS_BAR();
#pragma unroll
            for (int m = 0; m < 8; ++m) { const int p = tid + 512 * (m & 3), R = p >> 4, ch = p & 15; *(LAS v4u*)(L + ((m < 4) ? O_KW + R * PIT : O_VW + R * PITV) + ch * 16) = st[0][m]; }
#pragma unroll
            for (int m = 0; m < 4; ++m) { const int p = tid + 512 * (m & 1), R = p >> 4, ch = p & 15; *(LAS v4u*)(L + ((m < 2) ? O_KC + R * PIT : O_VC + R * PITV) + ch * 16) = sc4[m]; }
            if (s < 3) ATT_LOAD(0, u, s + 1); else if (more) ATT_LOAD(0, un, 0);
            if (s < 3) ATT_LOADC(u, s + 1); else if (more) ATT_LOADC(un, 0);
            LDS_BAR();
            const LAS unsigned char* Kt = L + (role ? O_KC : O_KW);
            const LAS unsigned char* Vt = L + (role ? O_VC : O_VW);
            const int kb0 = role ? 0 : kc0, kb1 = role ? 32 : 64 + kc0;
            f32x4 sc[2][2];
#pragma unroll
            for (int g = 0; g < 2; ++g)
#pragma unroll
                for (int cb = 0; cb < 2; ++cb) { f32x4 a = (f32x4){0.f, 0.f, 0.f, 0.f};
#pragma unroll
                    for (int ks = 0; ks < 4; ++ks) a = MFMA16(*(const LAS bf16x8*)(Kt + ((g ? kb1 : kb0) + 16 * cb + fr) * PIT + ks * 64 + kq * 16), qf[ks], a);
                    sc[g][cb] = a; }
            if (s == 3 && more) { asm volatile("" ::: "memory"); ATT_QLOAD(qf, un); }
            if (role == 0) {
#pragma unroll
                for (int g = 0; g < 2; ++g) { const int drow = (kr0 + 2 * s + g) - r + 7; float bias[8];
#pragma unroll
                    for (int e = 0; e < 8; ++e) bias[e] = ((const LAS float*)(L + O_RPB))[drow * 31 + min(max(dbase + 16 * (e >> 2) + (e & 3), 0), 30)];
#pragma unroll
                    for (int e = 0; e < 8; ++e) { asm volatile("" : "+v"(bias[e])); const float v = sc[g][e >> 2][e & 3] + bias[e]; sc[g][e >> 2][e & 3] = ((inmask >> e) & 1u) ? v : -1e30f; } }
            }
            float mx = -1e30f;
#pragma unroll
            for (int g = 0; g < 2; ++g)
#pragma unroll
                for (int e = 0; e < 8; ++e) mx = fmaxf(mx, sc[g][e >> 2][e & 3]);
            mx = fmaxf(mx, __shfl_xor(mx, 16)); mx = fmaxf(mx, __shfl_xor(mx, 32));
            const float mnew = (mx > mrun + 6.f) ? mx : mrun, alpha = __expf(mrun - mnew);
            const bool resc = __any(mnew != mrun);
            float p[2][8], ps = 0.f;
#pragma unroll
            for (int g = 0; g < 2; ++g)
#pragma unroll
                for (int e = 0; e < 8; ++e) { p[g][e] = __expf(sc[g][e >> 2][e & 3] - mnew); ps += p[g][e]; }
            lrun = lrun * alpha + ps; mrun = mnew;
            bf16x8 pf[2];
#pragma unroll
            for (int g = 0; g < 2; ++g) pf[g] = mk8(pk2(p[g][0], p[g][1]), pk2(p[g][2], p[g][3]), pk2(p[g][4], p[g][5]), pk2(p[g][6], p[g][7]));
            if (resc) {
#pragma unroll
                for (int dvb = 0; dvb < 8; ++dvb) O[dvb] = O[dvb] * alpha; }
#pragma unroll
            for (int dvb = 0; dvb < 8; ++dvb) { f32x4 o = O[dvb];
#pragma unroll
                for (int g = 0; g < 2; ++g) { const LAS unsigned char* vb = Vt + ((g ? kb1 : kb0) + 4 * kq + q4) * PITV + (16 * dvb + 4 * pp) * 2;
                    o = MFMA16(cat8(tr_read(vb), tr_read(vb + 16 * PITV)), pf[g], o); }
                O[dvb] = o; }
        }
        lrun += __shfl_xor(lrun, 16); lrun += __shfl_xor(lrun, 32);
        LDS_BAR();
        if (role == 1) {
            LAS float* mg = (LAS float*)(L + O_MG + j * 8704);
#pragma unroll
            for (int dvb = 0; dvb < 8; ++dvb)
#pragma unroll
                for (int q = 0; q < 4; ++q) mg[(dvb * 4 + q) * 64 + lane] = O[dvb][q];
            mg[2048 + lane] = mrun; mg[2048 + 64 + lane] = lrun;
        }
        LDS_BAR();
        if (role == 0) {
            const LAS float* mg = (const LAS float*)(L + O_MG + j * 8704);
            const float m2 = mg[2048 + lane], l2 = mg[2048 + 64 + lane];
            const float m = fmaxf(mrun, m2), a1 = __expf(mrun - m), a2 = __expf(m2 - m), inv = rcp_f(lrun * a1 + l2 * a2);
            u8* op = (u8*)F.A2 + (size_t)(b * SEQ + r * 64 + qcol) * D + h * HD + 4 * kq;
#pragma unroll
            for (int dvb = 0; dvb < 8; ++dvb) { float o[4];
#pragma unroll
                for (int q = 0; q < 4; ++q) o[q] = (O[dvb][q] * a1 + mg[(dvb * 4 + q) * 64 + lane] * a2) * inv;
                *(unsigned*)(op + 16 * dvb) = pk4_fp8(o[0] * SA8, o[1] * SA8, o[2] * SA8, o[3] * SA8); }
        }
    }
#undef ATT_LOAD
#undef ATT_LOADC
#undef ATT_LD16
#undef ATT_QLOAD
}
__device__ __forceinline__ void p3_mixer(Frame& F) {
    for (int ch = (int)blockIdx.x; ch < 128; ch += F.G) { gla_chain(F, ch); }
    for (;;) {
        __syncthreads();
        if (F.tid == 0) F.MISC[0] = __hip_atomic_fetch_add((unsigned*)(F.ctl + CW_ATTQ), 1u, RLX_AGENT);
        __syncthreads();
        const int c = (int)F.MISC[0];
        if (c >= NB * HEADS * 32 / 4) break;
        attn_run(F, 4 * c, 1, 4);
    }
}

__device__ __forceinline__ void p4_hg_out(Frame& F) {
    const int gw = F.vcu * NWAVES + F.wave, NGW = F.G * NWAVES, lane = F.lane;
    for (int t = gw; t < T; t += NGW) {
        const v4u* pf = (const v4u*)(F.OF + (size_t)t * MIXG + 16 * lane); const v4u* pb = (const v4u*)(F.OB + (size_t)t * MIXG + 16 * lane);
        const v4u f0 = pf[0], f1 = pf[1], b0 = pb[0], b1 = pb[1];
        const unsigned fu[8] = {f0.x, f0.y, f0.z, f0.w, f1.x, f1.y, f1.z, f1.w}, bu[8] = {b0.x, b0.y, b0.z, b0.w, b1.x, b1.y, b1.z, b1.w};
        f32x4 o[4]; float ss = 0.f;
#pragma unroll
        for (int i = 0; i < 4; ++i) { o[i] = (f32x4){bflo(fu[2 * i]) + bflo(bu[2 * i]), bfhi(fu[2 * i]) + bfhi(bu[2 * i]), bflo(fu[2 * i + 1]) + bflo(bu[2 * i + 1]), bfhi(fu[2 * i + 1]) + bfhi(bu[2 * i + 1])};
            ss += (o[i].x * o[i].x + o[i].y * o[i].y) + (o[i].z * o[i].z + o[i].w * o[i].w); }
        ss += __shfl_xor(ss, 1); ss += __shfl_xor(ss, 2); ss += __shfl_xor(ss, 4);
        const float rstd = rsqrtf(ss * (1.f / HD) + EPS);
        const v4u* gp = (const v4u*)(F.PX + HM_GATE0 + (size_t)t * MIXG + 16 * lane);
        const v4u g0 = gp[0], g1 = gp[1];
        const unsigned gu[8] = {g0.x, g0.y, g0.z, g0.w, g1.x, g1.y, g1.z, g1.w};
        const f32x4* hp = (const f32x4*)(F.hg_norm + ((16 * lane) & 127));
        unsigned ow[4];
#pragma unroll
        for (int i = 0; i < 4; ++i) { const f32x4 gn = hp[i]; const f32x4 y = o[i] * rstd * gn;
            const float ga = bflo(gu[2 * i]), gb = bfhi(gu[2 * i]), gc = bflo(gu[2 * i + 1]), gd = bfhi(gu[2 * i + 1]);
            ow[i] = pk4_fp8(y.x * silu_f(ga) * SA8, y.y * silu_f(gb) * SA8, y.z * silu_f(gc) * SA8, y.w * silu_f(gd) * SA8); }
        *(v4u*)((u8*)F.A2 + (size_t)t * D + MIXG + 16 * lane) = (v4u){ow[0], ow[1], ow[2], ow[3]};
    }
}

struct EpiOutProj {
    static constexpr bool PERM = true, AFTER_DRAIN = false;
    const float* x; bf16* X1; const float* modf; float ascale;
    __device__ __forceinline__ void operator()(const f32x4 (&acc)[2][2][4][2], const pg8::Unit& u, int wr, int wc, int fr, int fq) const {
        const int row0 = u.pm * 256 + wr * 64 + fr, col0 = u.pn * 256 + wc * 32 + 8 * fq;
        const float* g1 = modf + (size_t)(u.pm >> 3) * (6 * D) + 2 * D;
        f32x4 gv[2][2];
#pragma unroll
        for (int bj = 0; bj < 2; ++bj)
#pragma unroll
            for (int n = 0; n < 2; ++n) gv[bj][n] = *(const f32x4*)(g1 + col0 + bj * 128 + n * 4) * ascale;
#pragma unroll
        for (int ai = 0; ai < 2; ++ai)
#pragma unroll
            for (int m = 0; m < 4; ++m) { const size_t ro = (size_t)(row0 + ai * 128 + m * 16) * D + col0;
#pragma unroll
                for (int bj = 0; bj < 2; ++bj) { const f32x4 x0 = *(const f32x4*)(x + ro + bj * 128), x1 = *(const f32x4*)(x + ro + bj * 128 + 4);
                    const f32x4 v0 = x0 + gv[bj][0] * acc[ai][bj][m][0], v1 = x1 + gv[bj][1] * acc[ai][bj][m][1];
                    v4u w; w.x = pk2(v0[0], v0[1]); w.y = pk2(v0[2], v0[3]); w.z = pk2(v1[0], v1[1]); w.w = pk2(v1[2], v1[3]);
                    *(v4u*)(X1 + ro + bj * 128) = w; } __builtin_amdgcn_sched_barrier(0); }
    }
};

__device__ __forceinline__ void p6_router(Frame& F) {
    const int lane = F.lane, wave = F.wave, tid = F.tid, kq = lane >> 4, fr = lane & 15, g = wave & 3, kh = wave >> 2;
    LAS unsigned char* L = F.lds;
    constexpr int O_SSQ = 16384, O_LG = 16384 + 512, O_HIST = O_LG + 2 * 64 * 33 * 4, O_BASE = O_HIST + 128, O_SLOT = O_BASE + 128;
    for (int blk = F.vcu; blk < 256; blk += F.G) {
        const int bb = blk >> 5;
        p1_build_vec(F, bb, 3 * D, 4 * D, F.norm_ffn, false);
        if (tid < 32) ((LAS unsigned*)(L + O_HIST))[tid] = 0u;
        const int row = blk * 64 + g * 16 + fr;
        const bf16* xr = F.X1 + (size_t)row * D + kh * 1024 + 32 * kq;
        float ss = 0.f;
#pragma unroll 8
        for (int s = 0; s < 32; ++s) { const v4u xw = *(const v4u*)(xr + 128 * (s >> 2) + 8 * (s & 3)); const f32x4 a = (f32x4){bflo(xw.x), bfhi(xw.x), bflo(xw.y), bfhi(xw.y)}, c = (f32x4){bflo(xw.z), bfhi(xw.z), bflo(xw.w), bfhi(xw.w)};
            ss += (a.x * a.x + a.y * a.y) + (a.z * a.z + a.w * a.w) + (c.x * c.x + c.y * c.y) + (c.z * c.z + c.w * c.w); }
        ss += __shfl_xor(ss, 16); ss += __shfl_xor(ss, 32);
        if (kq == 0) ((LAS float*)(L + O_SSQ))[kh * 64 + g * 16 + fr] = ss;
        __syncthreads();
        const float rstd = rsqrtf((((LAS float*)(L + O_SSQ))[g * 16 + fr] + ((LAS float*)(L + O_SSQ))[64 + g * 16 + fr]) * (1.f / D) + EPS);
        f32x4 lg0 = (f32x4){0.f, 0.f, 0.f, 0.f}, lg1 = lg0;
        const LAS float* Av = (const LAS float*)L; const LAS float* Bv = Av + D;
        const bf16* wh = F.WRT + (size_t)fr * D + kh * 1024 + 32 * kq;
        u8* hrow = F.HX2 + (size_t)row * D + kh * 1024 + 16 * kq;
#pragma unroll 1
        for (int s = 0; s < 8; ++s) {
            float hv[32];
#pragma unroll
            for (int j = 0; j < 4; ++j) {
                const int k = kh * 1024 + 128 * s + 32 * kq + 8 * j;
                const v4u xw = *(const v4u*)(xr + 128 * s + 8 * j); const f32x4 a = (f32x4){bflo(xw.x), bfhi(xw.x), bflo(xw.y), bfhi(xw.y)}, c = (f32x4){bflo(xw.z), bfhi(xw.z), bflo(xw.w), bfhi(xw.w)};
                const f32x4 A0 = *(const LAS f32x4*)(Av + k), A1 = *(const LAS f32x4*)(Av + k + 4), B0 = *(const LAS f32x4*)(Bv + k), B1 = *(const LAS f32x4*)(Bv + k + 4);
                const f32x4 h0 = a * rstd * A0 + B0, h1 = c * rstd * A1 + B1;
                hv[8 * j] = h0.x; hv[8 * j + 1] = h0.y; hv[8 * j + 2] = h0.z; hv[8 * j + 3] = h0.w; hv[8 * j + 4] = h1.x; hv[8 * j + 5] = h1.y; hv[8 * j + 6] = h1.z; hv[8 * j + 7] = h1.w;
                const unsigned u0 = pk2(h0.x, h0.y), u1 = pk2(h0.z, h0.w), u2 = pk2(h1.x, h1.y), u3 = pk2(h1.z, h1.w);
                const unsigned l0 = pk2(h0.x - bflo(u0), h0.y - bfhi(u0)), l1 = pk2(h0.z - bflo(u1), h0.w - bfhi(u1)), l2 = pk2(h1.x - bflo(u2), h1.y - bfhi(u2)), l3 = pk2(h1.z - bflo(u3), h1.w - bfhi(u3));
                const bf16x8 hh = mk8(u0, u1, u2, u3), hl = mk8(l0, l1, l2, l3);
                const bf16x8 w0h = *(const bf16x8*)(wh + 128 * s + 8 * j), w1h = *(const bf16x8*)(wh + 16 * D + 128 * s + 8 * j);
                const bf16x8 w0l = *(const bf16x8*)(wh + NE * D + 128 * s + 8 * j), w1l = *(const bf16x8*)(wh + NE * D + 16 * D + 128 * s + 8 * j);
                lg0 = MFMA16(hh, w0h, lg0); lg0 = MFMA16(hh, w0l, lg0); lg0 = MFMA16(hl, w0h, lg0);
                lg1 = MFMA16(hh, w1h, lg1); lg1 = MFMA16(hh, w1l, lg1); lg1 = MFMA16(hl, w1h, lg1);
            }
            v6u p; unsigned eb; mx6_pack(hv, p, eb);
            *(v4u*)(hrow + 128 * s) = (v4u){p[0], p[1], p[2], p[3]}; *(v4u*)(hrow + 128 * s + 64) = (v4u){p[4], p[5], eb, 0u};
        }
        { LAS float* lg = (LAS float*)(L + O_LG) + kh * 64 * 33;
#pragma unroll
          for (int r = 0; r < 4; ++r) { lg[(g * 16 + 4 * kq + r) * 33 + fr] = lg0[r]; lg[(g * 16 + 4 * kq + r) * 33 + 16 + fr] = lg1[r]; } }
        __syncthreads();
        int e4[4] = {0, 0, 0, 0}; int pl4[4] = {0, 0, 0, 0};
        if (tid < 64) {
            LAS float* lg = (LAS float*)(L + O_LG) + tid * 33;
            for (int e = 0; e < 32; ++e) lg[e] = lg[e] + lg[64 * 33 + e] + F.b_router[e];
            float v4[4];
#pragma unroll
            for (int p = 0; p < 4; ++p) { float best = -3.0e38f; int bi = 0;
                for (int e = 0; e < 32; ++e) { const float v = lg[e]; const bool used = (p > 0 && e == e4[0]) || (p > 1 && e == e4[1]) || (p > 2 && e == e4[2]); if (!used && v > best) { best = v; bi = e; } }
                e4[p] = bi; v4[p] = best; }
            const float e1 = __expf(v4[1] - v4[0]), e2 = __expf(v4[2] - v4[0]), e3 = __expf(v4[3] - v4[0]), inv = 1.f / (1.f + e1 + e2 + e3);
            const int t = blk * 64 + tid;
            *(f32x4*)(F.RT_G + (size_t)t * 4) = (f32x4){inv, e1 * inv, e2 * inv, e3 * inv};
            *(int4*)(F.RT_E + (size_t)t * 4) = make_int4(e4[0], e4[1], e4[2], e4[3]);
#pragma unroll
            for (int p = 0; p < 4; ++p) pl4[p] = (int)__hip_atomic_fetch_add((LAS unsigned*)(L + O_HIST) + e4[p], 1u, __ATOMIC_RELAXED, __HIP_MEMORY_SCOPE_WORKGROUP);
        }
        __syncthreads();
        if (tid < 32) { const unsigned c = ((LAS unsigned*)(L + O_HIST))[tid]; ((LAS unsigned*)(L + O_BASE))[tid] = c ? __hip_atomic_fetch_add((unsigned*)(F.ctl + CW_CNT + 64 * tid), c, RLX_AGENT) : 0u; }
        __syncthreads();
        if (tid < 64) { const int t = blk * 64 + tid; const LAS unsigned* base = (const LAS unsigned*)(L + O_BASE);
            const int4 ps = make_int4((int)base[e4[0]] + pl4[0], (int)base[e4[1]] + pl4[1], (int)base[e4[2]] + pl4[2], (int)base[e4[3]] + pl4[3]);
            *(int4*)(F.RT_POS + (size_t)t * 4) = ps;
            LAS int* sl = (LAS int*)(L + O_SLOT) + tid * 4;
            sl[0] = e4[0] * T + ps.x; sl[1] = e4[1] * T + ps.y; sl[2] = e4[2] * T + ps.z; sl[3] = e4[3] * T + ps.w; }
        __syncthreads();
        for (int a0 = wave; a0 < 256; a0 += 4 * NWAVES) {
            v4u rv[4][2];
#pragma unroll
            for (int q = 0; q < 4; ++q) { const int a = a0 + q * NWAVES, t = blk * 64 + (a >> 2); const v4u* src = (const v4u*)(F.HX2 + (size_t)t * D) + lane; rv[q][0] = src[0]; rv[q][1] = src[64]; }
#pragma unroll
            for (int q = 0; q < 4; ++q) { const int a = a0 + q * NWAVES, slot = ((const LAS int*)(L + O_SLOT))[a]; v4u* dst = (v4u*)(F.XG + (size_t)slot * D) + lane; dst[0] = rv[q][0]; dst[64] = rv[q][1]; }
        }
        __syncthreads();
    }
}

__device__ __forceinline__ int moe_tables(Frame& F) {
    LAS unsigned char* tile_e = F.lds + TILE_OFF; LAS int* offt = (LAS int*)(F.lds + OFFT_OFF);
    if (F.tid < 32) { int off = 0, mine = 0;
        for (int e = 0; e < 32; ++e) { const int c = (int)__hip_atomic_load((unsigned*)(F.ctl + CW_CNT + 64 * e), RLX_AGENT); const int nt = (c + 255) >> 8; if (e < F.tid) off += nt; if (e == F.tid) mine = nt; }
        offt[F.tid] = off; for (int t = 0; t < mine; ++t) tile_e[off + t] = (unsigned char)F.tid;
        if (F.tid == 31) offt[32] = off + mine; }
    __syncthreads();
    return offt[32];
}
#ifndef MOE_NB
#define MOE_NB 2
#endif
struct MoeOrder {
    static constexpr bool SPARSE_A = true;
    int nM, nN, nwg, G, c; const LAS unsigned char* tile_e; const LAS int* offt; bool sparse;
    __device__ void init(int nM_, int nN_, int G_, int c_, const LAS unsigned char* te, const LAS int* ot, bool sp) { nM = nM_; nN = nN_; nwg = nM * nN; G = G_; c = c_; tile_e = te; offt = ot; sparse = sp; }
    __device__ bool next(int i, pg8::Unit& u) const {
        const long Lq = (long)i * G + c; if (Lq >= nwg) return false;
        int wgid = (int)Lq; { const int q = nwg / 8, r = nwg % 8, xcd = wgid % 8, off = wgid / 8; wgid = (xcd < r ? xcd * (q + 1) : r * (q + 1) + (xcd - r) * q) + off; }
        const int e = __builtin_amdgcn_readfirstlane((int)tile_e[wgid / nN]);
        const int t0 = __builtin_amdgcn_readfirstlane(offt[e]), nt = __builtin_amdgcn_readfirstlane(offt[e + 1]) - t0, r = wgid - t0 * nN, blk = nt * MOE_NB, q = r / blk, r2 = r - q * blk;
        u.pm = t0 + r2 % nt; u.pn = e * nN + MOE_NB * q + r2 / nt;
        u.pa = sparse ? e * (T / 256) + (u.pm - t0) : u.pm; return true;
    }
    __device__ __forceinline__ void a_ready(const pg8::Unit&) const {}
    __device__ __forceinline__ void done(const pg8::Unit&) const {}
};
struct EpiSwiglu {
    static constexpr bool PERM = true, AFTER_DRAIN = false;
    u8* H; const float* b_gu;
    __device__ __forceinline__ void operator()(const f32x4 (&acc)[2][2][4][2], const pg8::Unit& u, int wr, int wc, int fr, int fq) const {
        const int e = u.pn >> 4, pl = u.pn & 15, row0 = u.pm * 256 + wr * 64 + fr, ccol = pl * 128 + wc * 32 + 8 * fq;
        const float* bg = b_gu + (size_t)e * 4096 + ccol;
        const f32x4 bg0 = *(const f32x4*)bg, bg1 = *(const f32x4*)(bg + 4), bl0 = *(const f32x4*)(bg + 2048), bl1 = *(const f32x4*)(bg + 2052);
#pragma unroll
        for (int ai = 0; ai < 2; ++ai)
#pragma unroll
            for (int m = 0; m < 4; ++m) { float y[8];
#pragma unroll
                for (int i = 0; i < 8; ++i) { const float gl = acc[ai][0][m][i >> 2][i & 3] + ((i < 4) ? bg0[i & 3] : bg1[i & 3]); const float ln = acc[ai][1][m][i >> 2][i & 3] + ((i < 4) ? bl0[i & 3] : bl1[i & 3]);
                    const float xg = fminf(gl, 7.f), xl = fminf(fmaxf(ln, -7.f), 7.f); y[i] = xg * rcp_f(1.f + __builtin_amdgcn_exp2f(-2.4554669595930156f * xg)) * (xl * SH8 + SH8); }
                v2u w; w.x = pk4_fp8_nc(y[0], y[1], y[2], y[3]); w.y = pk4_fp8_nc(y[4], y[5], y[6], y[7]);
                *(v2u*)(H + (size_t)(row0 + ai * 128 + m * 16) * FF + ccol) = w; __builtin_amdgcn_sched_barrier(0); }
    }
};
struct EpiDown {
    static constexpr bool PERM = true, AFTER_DRAIN = false;
    u8* Y; const float* b_down;
    __device__ __forceinline__ void operator()(const f32x4 (&acc)[2][2][4][2], const pg8::Unit& u, int wr, int wc, int fr, int fq) const {
        const int e = u.pn >> 3, pl = u.pn & 7, row0 = u.pm * 256 + wr * 64 + fr, col0 = pl * 256 + wc * 32 + 8 * fq;
        f32x4 bv[2][2];
#pragma unroll
        for (int bj = 0; bj < 2; ++bj)
#pragma unroll
            for (int n = 0; n < 2; ++n) bv[bj][n] = *(const f32x4*)(b_down + (size_t)e * D + col0 + bj * 128 + 4 * n);
#pragma unroll
        for (int ai = 0; ai < 2; ++ai)
#pragma unroll
            for (int m = 0; m < 4; ++m) { u8* rowp = Y + (size_t)(row0 + ai * 128 + m * 16) * D + col0;
#pragma unroll
                for (int bj = 0; bj < 2; ++bj) { const f32x4 v0 = (acc[ai][bj][m][0] * (1.f / (SH8 * SW8)) + bv[bj][0]) * SY8, v1 = (acc[ai][bj][m][1] * (1.f / (SH8 * SW8)) + bv[bj][1]) * SY8;
                    v2u w; w.x = pk4_fp8(v0[0], v0[1], v0[2], v0[3]); w.y = pk4_fp8(v1[0], v1[1], v1[2], v1[3]);
                    *(v2u*)(rowp + bj * 128) = w; } __builtin_amdgcn_sched_barrier(0); }
    }
};
__device__ __forceinline__ void p10_final(Frame& F, float oscale) {
    const int lane = (int)__builtin_amdgcn_mbcnt_hi(~0u, __builtin_amdgcn_mbcnt_lo(~0u, 0u));
    const int gw = F.vcu * NWAVES + F.wave, NGW = F.G * NWAVES;
    (void)moe_tables(F);
    const LAS int* offt = (const LAS int*)(F.lds + OFFT_OFF);
    for (int t = gw; t < T; t += NGW) {
        const int4 ee = *(const int4*)(F.RT_E + (size_t)t * 4), pp = *(const int4*)(F.RT_POS + (size_t)t * 4);
        const int4 sl = make_int4(offt[ee.x] * 256 + pp.x, offt[ee.y] * 256 + pp.y, offt[ee.z] * 256 + pp.z, offt[ee.w] * 256 + pp.w); const f32x4 gt = *(const f32x4*)(F.RT_G + (size_t)t * 4);
        const float* g2 = F.MODF + (size_t)(t >> 11) * (6 * D) + 5 * D;
        const v2u* xr = (const v2u*)(F.X1 + (size_t)t * D) + lane;
        const unsigned* y0 = (const unsigned*)(F.Y + (size_t)sl.x * D) + lane; const unsigned* y1 = (const unsigned*)(F.Y + (size_t)sl.y * D) + lane;
        const unsigned* y2 = (const unsigned*)(F.Y + (size_t)sl.z * D) + lane; const unsigned* y3 = (const unsigned*)(F.Y + (size_t)sl.w * D) + lane;
        const f32x4 gs = gt * (1.f / SY8);
        f32x4 v[8]; float ss = 0.f;
#pragma unroll
        for (int j = 0; j < 8; ++j) { const unsigned a = y0[64 * j], b = y1[64 * j], c = y2[64 * j], d = y3[64 * j];
            const f32x2 al = __builtin_amdgcn_cvt_pk_f32_fp8(a, false), ah = __builtin_amdgcn_cvt_pk_f32_fp8(a, true), bl = __builtin_amdgcn_cvt_pk_f32_fp8(b, false), bh = __builtin_amdgcn_cvt_pk_f32_fp8(b, true);
            const f32x2 cl = __builtin_amdgcn_cvt_pk_f32_fp8(c, false), ch = __builtin_amdgcn_cvt_pk_f32_fp8(c, true), dl = __builtin_amdgcn_cvt_pk_f32_fp8(d, false), dh = __builtin_amdgcn_cvt_pk_f32_fp8(d, true);
            f32x4 m;
            m.x = gs.x * al.x + gs.y * bl.x + gs.z * cl.x + gs.w * dl.x;
            m.y = gs.x * al.y + gs.y * bl.y + gs.z * cl.y + gs.w * dl.y;
            m.z = gs.x * ah.x + gs.y * bh.x + gs.z * ch.x + gs.w * dh.x;
            m.w = gs.x * ah.y + gs.y * bh.y + gs.z * ch.y + gs.w * dh.y;
            const f32x4 gg = *((const f32x4*)g2 + lane + 64 * j);
            const v2u xw = xr[64 * j]; const f32x4 xv = (f32x4){bflo(xw.x), bfhi(xw.x), bflo(xw.y), bfhi(xw.y)};
            v[j] = xv + gg * m; ss += (v[j].x * v[j].x + v[j].y * v[j].y) + (v[j].z * v[j].z + v[j].w * v[j].w); }
        const float rstd = rsqrtf(wave_sum(ss) * (1.f / D) + EPS) * oscale;
        f32x4* op = (f32x4*)(F.out + (size_t)t * D) + lane;
#pragma unroll
        for (int j = 0; j < 8; ++j) op[64 * j] = v[j] * rstd * *((const f32x4*)F.norm_final + lane + 64 * j);
    }
}

struct Args { const float* in[20]; float* out; unsigned char* ws; int ph_lo, ph_hi, li, pad; };
__global__ void __launch_bounds__(NWAVES * 64, 2) mk_fwd(Args args) {
    extern __shared__ __attribute__((aligned(16))) unsigned char lds[];
    Frame F;
    F.lds = (LAS unsigned char*)lds;
    F.MISC = (volatile LAS unsigned*)(F.lds + MISC_OFF);
    F.tid = threadIdx.x; F.lane = F.tid & 63; F.wave = __builtin_amdgcn_readfirstlane(F.tid >> 6);
    F.G = gridDim.x; { const int bx = blockIdx.x; F.vcu = (F.G % 8 == 0) ? (bx % 8) * (F.G / 8) + bx / 8 : bx; }
    unsigned char* ws = args.ws;
    F.ctl = (gu32*)(ws + WS_CTL);
    F.x = args.in[0]; F.c = args.in[1]; F.ctx = args.in[2]; F.c_ctx = args.in[3]; F.w_ada = args.in[4]; F.b_ada = args.in[5]; F.norm_mix = args.in[6]; F.norm_ffn = args.in[7];
    F.w_in = args.in[8]; F.lb_table = args.in[9]; F.hg_norm = args.in[10]; F.rpb = args.in[11]; F.w_out = args.in[12]; F.w_router = args.in[13]; F.b_router = args.in[14];
    F.w_gu = args.in[15]; F.b_gu = args.in[16]; F.w_down = args.in[17]; F.b_down = args.in[18]; F.norm_final = args.in[19]; F.out = args.out;
    F.MODP = (float*)(ws + WS_MODP); F.MODF = (float*)(ws + WS_MODF); F.OF = (bf16*)(ws + WS_OF); F.OB = (bf16*)(ws + WS_OB); F.X1 = (bf16*)(ws + WS_X1);
    F.WRT = (bf16*)(ws + WS_WRT); F.WIN = (bf16*)(ws + WS_WIN); F.WOUT = (bf16*)(ws + WS_WOUT); F.HXN = (bf16*)(ws + WS_HXN); F.PX = (bf16*)(ws + WS_PX); F.A2 = (bf16*)(ws + WS_A2);
    F.HX2 = (u8*)(ws + WS_HX2); F.XG = (u8*)(ws + WS_XG); F.H = (u8*)(ws + WS_H); F.Y = (u8*)(ws + WS_Y); F.WGU = (u8*)(ws + WS_WGU); F.WD = (u8*)(ws + WS_WD);
    F.RT_E = (int*)(ws + WS_RT); F.RT_POS = F.RT_E + T * 4; F.RT_G = (float*)(F.RT_POS + T * 4); F.RT_SLOT = (int*)(F.RT_G + T * 4);
    for (int u = F.tid; u < (LDS_BYTES - LDSCTL_OFF) / 4; u += NWAVES * 64) ((LAS unsigned*)(F.lds + LDSCTL_OFF))[u] = 0u;
    __syncthreads();
    const int NC = (N_LAUNCHES == 1 && F.G >= 256) ? NCONV : 0, NW = F.G - NC;
    const bool conv = (int)blockIdx.x >= NW;
    XcdBarrier barA, barW; barA.bar = (unsigned*)(F.ctl + CW_BAR); barA.x = 0; barA.st = nullptr; barA.total = 0; barW = barA;
    if (N_LAUNCHES == 1) { barA = xcd_barrier_post((unsigned*)(F.ctl + CW_BAR + args.li * 20480), F.MISC + 8, (unsigned)F.G);
        if (!conv) barW = xcd_barrier_post((unsigned*)(F.ctl + CW_BAR2 + args.li * 20480), F.MISC + 10, (unsigned)NW); }
#define GRID_BAR_A() do { if (N_LAUNCHES == 1) xcd_barrier(barA); } while (0)
#define GRID_BAR_W() do { if (N_LAUNCHES == 1) xcd_barrier(barW); } while (0)
#if defined(TPROBE)
    if (blockIdx.x == 0 && F.tid == 0) __hip_atomic_store((unsigned*)(F.ctl + 20000), (unsigned)__builtin_amdgcn_s_memrealtime(), RLX_AGENT);
#define TSTAMP(k) do { if (F.tid == 0) { unsigned t0_; int sp_ = 0; do { t0_ = __hip_atomic_load((unsigned*)(F.ctl + 20000), RLX_AGENT); } while (t0_ == 0u && ++sp_ < 1000000); \
        __hip_atomic_fetch_max((unsigned*)(F.ctl + 20064 + 64 * (k)), (unsigned)__builtin_amdgcn_s_memrealtime() - t0_, RLX_AGENT); } } while (0)
#else
#define TSTAMP(k) do {} while (0)
#endif
    const int lo = args.ph_lo, hi = args.ph_hi;
#define IN(k) (lo <= (k) && (k) < hi)
#define BOTH(k) (IN(k) && IN((k) + 1))
    constexpr int CV_N = NE * 2048 + NE * 1024;
    const int cvA = (NC > 0) ? CVA_PER_WAVE * F.G * NWAVES : 0;
    if (conv && args.ph_lo > 0) {} else
    if (conv) { convert_moe(F, (int)blockIdx.x * NWAVES + F.wave, F.G * NWAVES, 0, cvA); convert_moe(F, ((int)blockIdx.x - NW) * NWAVES + F.wave, NC * NWAVES, cvA, CV_N); TSTAMP(0); }
    else {
        const int Gall = F.G, vall = F.vcu;
        F.G = NW; { const int bx = blockIdx.x; F.vcu = (NW % 8 == 0) ? (bx % 8) * (NW / 8) + bx / 8 : bx; }
        if (IN(0)) { p0_prologue(F, NC == 0); convert_moe(F, (int)blockIdx.x * NWAVES + F.wave, Gall * NWAVES, 0, cvA); TSTAMP(1); if (BOTH(0)) GRID_BAR_W(); }
        if (IN(1)) { p1_norm(F); TSTAMP(2); if (BOTH(1)) GRID_BAR_W(); }
        if (IN(2)) {
            pg8::Gemm g{F.HXN, F.WIN, MTOT, 8192, D}; InProjOrder S; S.init(F.G, (int)blockIdx.x);
            EpiInProj E{F.PX, F.lb_table};
            pg8::gemm_phase<EpiInProj, InProjOrder, PG8_ALIGN, PG8_SP2>(F.lds + RING_OFF, g, S, E);
            TSTAMP(3); if (BOTH(2)) GRID_BAR_W();
        }
        if (IN(3)) { p3_mixer(F); TSTAMP(4); if (BOTH(3)) GRID_BAR_W(); }
        if (IN(4)) { p4_hg_out(F); TSTAMP(5); }
        F.G = Gall; F.vcu = vall;
    }
    if (BOTH(4)) GRID_BAR_A();
    if (IN(5)) {
        pg8::Gemm g{F.A2, F.WOUT, T, D, D}; pg8::StaticOrder S; S.init(T, D, F.G, (int)blockIdx.x);
        EpiOutProj E{F.x, F.X1, F.MODF, 1.f / (SA8 * SW8)};
        pg8::gemm_phase<EpiOutProj, pg8::StaticOrder, PG8_ALIGN, PG8_SP2, 1>(F.lds + RING_OFF, g, S, E);
        TSTAMP(6); if (BOTH(5)) GRID_BAR_A();
    }
    if (IN(6)) { p6_router(F); TSTAMP(7); if (BOTH(6)) GRID_BAR_A(); }
    if (IN(8)) {
        const int NT = moe_tables(F);
        pg8::Gemm g{(const bf16*)F.XG, (const bf16*)F.WGU, NE * T, NE * 4096, D}; MoeOrder S; S.init(NT, 16, F.G, (int)blockIdx.x, F.lds + TILE_OFF, (const LAS int*)(F.lds + OFFT_OFF), true);
        EpiSwiglu E{F.H, F.b_gu};
        pg8::gemm_phase<EpiSwiglu, MoeOrder, PG8_ALIGN, PG8_SP2, 2>(F.lds + RING_OFF, g, S, E);
        TSTAMP(9); if (BOTH(8)) GRID_BAR_A();
    }
    if (IN(9)) {
        const int NT = moe_tables(F);
        pg8::Gemm g{(const bf16*)F.H, (const bf16*)F.WD, CAP, NE * 2048, FF}; MoeOrder S; S.init(NT, 8, F.G, (int)blockIdx.x, F.lds + TILE_OFF, (const LAS int*)(F.lds + OFFT_OFF), false);
        EpiDown E{F.Y, F.b_down};
        pg8::gemm_phase<EpiDown, MoeOrder, PG8_ALIGN, PG8_SP2, 1>(F.lds + RING_OFF, g, S, E);
        TSTAMP(10); if (BOTH(9)) GRID_BAR_A();
    }
#if defined(TPROBE)
    if (IN(10)) { const unsigned tk = __hip_atomic_load((unsigned*)(F.ctl + 20064 + 64 * TPROBE), RLX_AGENT); p10_final(F, 1.f + (float)tk * 1e-6f); }
#else
    if (IN(10)) { p10_final(F, 1.f); }
#endif
#undef IN
#undef BOTH
}

extern "C" void kernel_launch(void* const* d_in, const int* in_sizes, int n_in, void* d_out, int out_size, void* d_ws, size_t ws_size, hipStream_t stream) {
    static int grid = 0;
    if (grid == 0) {
        if (n_in != 20 || out_size != T * D || ws_size < WS_END) { fprintf(stderr, "kernel_launch: unexpected shapes (n_in %d out %d ws %zu)\n", n_in, out_size, ws_size); grid = -1; return; }
        int dev = 0, cus = 0, per_cu = 0;
        if (hipGetDevice(&dev) != hipSuccess || hipDeviceGetAttribute(&cus, hipDeviceAttributeMultiprocessorCount, dev) != hipSuccess) { grid = -1; return; }
        if (hipFuncSetAttribute((const void*)mk_fwd, hipFuncAttributeMaxDynamicSharedMemorySize, LDS_BYTES) != hipSuccess) { fprintf(stderr, "kernel_launch: hipFuncSetAttribute failed\n"); grid = -1; return; }
        if (hipOccupancyMaxActiveBlocksPerMultiprocessor(&per_cu, (const void*)mk_fwd, NWAVES * 64, LDS_BYTES) != hipSuccess || per_cu < 1)
            fprintf(stderr, "kernel_launch: occupancy query reports %d workgroups per CU\n", per_cu);
        (void)hipGetLastError();
        grid = cus;
    }
    if (grid < 0) return;
    if (hipMemsetAsync((char*)d_ws + WS_CTL, 0, CTL_ZERO_BYTES, stream) != hipSuccess) return;
    Args a{};
    for (int i = 0; i < 20; ++i) a.in[i] = (const float*)d_in[i];
    a.out = (float*)d_out; a.ws = (unsigned char*)d_ws;
#if defined(PROBE_CUT)
    for (int li = 0; li < 2; ++li) {
        a.ph_lo = li == 0 ? 0 : PROBE_CUT; a.ph_hi = li == 0 ? PROBE_CUT + 1 : NPHASE; a.li = li; a.pad = 0;
        hipLaunchKernelGGL(mk_fwd, dim3(grid), dim3(NWAVES * 64), LDS_BYTES, stream, a);
    }
#else
    for (int li = 0; li < N_LAUNCHES; ++li) {
        a.ph_lo = (N_LAUNCHES == 1) ? 0 : li; a.ph_hi = (N_LAUNCHES == 1) ? NPHASE : li + 1; a.li = li; a.pad = 0;
        hipLaunchKernelGGL(mk_fwd, dim3(grid), dim3(NWAVES * 64), LDS_BYTES, stream, a);
        const hipError_t le = hipPeekAtLastError();
        if (le != hipSuccess) { fprintf(stderr, "kernel_launch: launch %d failed: %s\n", li, hipGetErrorName(le)); break; }
    }
#endif
}
```

```cpp
#include <hip/hip_runtime.h>
#include <cstdio>
#include <cstdint>
namespace pg8 {
#define PG8_LAS __attribute__((address_space(3)))
typedef unsigned short bf16_t;
typedef short bf16x8 __attribute__((ext_vector_type(8)));
typedef float f32x4 __attribute__((ext_vector_type(4)));
typedef unsigned u32x4 __attribute__((ext_vector_type(4)));
constexpr int BM = 256, BK = 64, HALF = 128, HTB = HALF * BK * 2  , STAGE_BYTES = 8 * HTB, NXCD = 8, WGM = 8;

__host__ __device__ __forceinline__ int lds_byte2(int r, int chunk) { return r * 128 + 16 * (chunk ^ ((r >> 1) & 7)); }
__host__ __device__ __forceinline__ void stage_rc2(int b, int& R, int& C) { const int row = (b >> 10) * 8 + ((b & 1023) >> 7), pos = (b >> 4) & 7; R = row; C = 8 * (pos ^ ((row >> 1) & 7)); }
__host__ __device__ __forceinline__ int lds_byte(int r, int c) { const int st = (r >> 4) * 2 + (c >> 5), rr = r & 15, cc = c & 31, ob = rr * 64 + cc * 2; return st * 1024 + (ob ^ (((ob >> 9) & 1) << 5)); }
__host__ __device__ __forceinline__ void stage_rc(int b, int& R, int& C) { const int st = b / 1024, sb = b % 1024, swz = sb ^ (((sb >> 9) & 1) << 5); R = (st >> 1) * 16 + swz / 64; C = (st & 1) * 32 + (swz % 64) / 2; }
__host__ __device__ __forceinline__ int perm32(int rho) { const int n = rho >> 4, i = rho & 15; return 8 * (i >> 2) + 4 * n + (i & 3); }

struct Unit { int pm, pn, pa; };
struct Gemm { const bf16_t* A; const bf16_t* Bt; int M, N, K; };

struct StaticOrder {
    static constexpr bool SPARSE_A = false;
    int nM, nN, nwg, G, c;
    __host__ __device__ void init(int M, int N, int G_, int c_) { nM = M / BM; nN = N / BM; nwg = nM * nN; G = G_; c = c_; }
    __host__ __device__ bool next(int i, Unit& u) const {
        const long L = (long)i * G + c; if (L >= nwg) return false;
        int wgid = (int)L; { const int q = nwg / NXCD, r = nwg % NXCD, xcd = wgid % NXCD, off = wgid / NXCD; wgid = (xcd < r ? xcd * (q + 1) : r * (q + 1) + (xcd - r) * q) + off; }
        const int nig = WGM * nN, gid = wgid / nig, fm = gid * WGM, gsz = (nM - fm) < WGM ? (nM - fm) : WGM;
        u.pm = fm + ((wgid % nig) % gsz); u.pn = (wgid % nig) / gsz; return true;
    }
    __device__ __forceinline__ void a_ready(const Unit&) const {}
    __device__ __forceinline__ void done(const Unit&) const {}
};

__device__ __forceinline__ unsigned cvt_pk_bf16(float lo, float hi) { unsigned r; asm volatile("v_cvt_pk_bf16_f32 %0, %1, %2" : "=v"(r) : "v"(lo), "v"(hi)); return r; }
typedef int v8i32 __attribute__((ext_vector_type(8))); typedef int v4i32 __attribute__((ext_vector_type(4))); typedef int v6i32 __attribute__((ext_vector_type(6)));
__device__ __forceinline__ v6i32 sub6(v8i32 x) { return __builtin_shufflevector(x, x, 0, 1, 2, 3, 4, 5); }
__device__ __forceinline__ v8i32 cat_i8(bf16x8 a, bf16x8 b) { const v4i32 x = __builtin_bit_cast(v4i32, a), y = __builtin_bit_cast(v4i32, b); return __builtin_shufflevector(x, y, 0, 1, 2, 3, 4, 5, 6, 7); }
template <class Epi, class Sched, bool ALIGN_EPI = false, bool SP2 = false, int F8 = 0>
__device__ __forceinline__ void gemm_phase(PG8_LAS unsigned char* lds, const Gemm g, const Sched& S, const Epi& E) {
    const int tid = threadIdx.x, wid = __builtin_amdgcn_readfirstlane(tid >> 6), lane = tid & 63, wr = wid >> 2, wc = wid & 3, fr = lane & 15, fq = lane >> 4;
    const int K = g.K, PB = F8 ? K : 2 * K  , nt = PB / 128;
    unsigned voffA[2], voffB[2];
#pragma unroll
    for (int i = 0; i < 2; ++i) { int R, C; stage_rc2(tid * 16 + i * 8192, R, C); const int Rb = Epi::PERM ? ((R & ~31) + perm32(R & 31)) : R;
        voffA[i] = (unsigned)(R * PB + C * 2); voffB[i] = (unsigned)(Rb * PB + C * 2); }
    const size_t kstep = (size_t)(BK * 2);
    const size_t hstep = (size_t)HALF * PB;
    const size_t tstep = 2 * hstep;
    const unsigned ldsw = (unsigned)wid * 1024u;
    const int aoff = lds_byte2(wr * 64 + fr, fq), boff = lds_byte2(wc * 32 + fr, fq), aoff1 = lds_byte2(wr * 64 + fr, fq + 4) - aoff, boff1 = lds_byte2(wc * 32 + fr, fq + 4) - boff;
#define PG8_SA(b, h) (((b) * 2 + (h)) * HTB)
#define PG8_SB(b, h) ((4 + (b) * 2 + (h)) * HTB)
#define PG8_STAGE(bufoff, gbase, voff) do { _Pragma("unroll") for (int _i = 0; _i < 2; ++_i) \
        __builtin_amdgcn_global_load_lds((const unsigned*)((const char*)(gbase) + (voff)[_i]), (PG8_LAS unsigned*)(lds + (bufoff) + ldsw + _i * 8192), 16, 0, 0); } while (0)
#define PG8_LDA(dst, b, h) do { _Pragma("unroll") for (int m = 0; m < 4; ++m) { if constexpr (F8) { dst##8[m] = cat_i8(*(const PG8_LAS bf16x8*)(lds + PG8_SA(b, h) + aoff + m * 2048), *(const PG8_LAS bf16x8*)(lds + PG8_SA(b, h) + aoff + aoff1 + m * 2048)); } \
        else { _Pragma("unroll") for (int k = 0; k < 2; ++k) dst[m][k] = *(const PG8_LAS bf16x8*)(lds + PG8_SA(b, h) + aoff + k * aoff1 + m * 2048); } } } while (0)
#define PG8_LDB(dst, b, h) do { _Pragma("unroll") for (int n = 0; n < 2; ++n) { if constexpr (F8) { dst##8[n] = cat_i8(*(const PG8_LAS bf16x8*)(lds + PG8_SB(b, h) + boff + n * 2048), *(const PG8_LAS bf16x8*)(lds + PG8_SB(b, h) + boff + boff1 + n * 2048)); } \
        else { _Pragma("unroll") for (int k = 0; k < 2; ++k) dst[n][k] = *(const PG8_LAS bf16x8*)(lds + PG8_SB(b, h) + boff + k * boff1 + n * 2048); } } } while (0)
#define PG8_MMA(ai, bj, At, Bt) do { __builtin_amdgcn_s_setprio(1); _Pragma("unroll") for (int m = 0; m < 4; ++m) _Pragma("unroll") for (int n = 0; n < 2; ++n) { \
        if constexpr (F8 == 2) { asm volatile("s_nop 1\n\tv_mfma_scale_f32_16x16x128_f8f6f4 %0, %1, %2, %0, %3, %4 op_sel_hi:[0,0,0] cbsz:2 blgp:2" : "+v"(acc[ai][bj][m][n]) : "v"(sub6(Bt##8[n])), "v"(sub6(At##8[m])), "v"(Bt##8[n][6]), "v"(At##8[m][6])); } \
        else if constexpr (F8 == 1) { asm volatile("v_mfma_scale_f32_16x16x128_f8f6f4 %0, %1, %2, %0, %3, %3 op_sel_hi:[0,0,0]" : "+v"(acc[ai][bj][m][n]) : "v"(Bt##8[n]), "v"(At##8[m]), "v"(f8scale)); } \
        else { _Pragma("unroll") for (int k = 0; k < 2; ++k) acc[ai][bj][m][n] = __builtin_amdgcn_mfma_f32_16x16x32_bf16(Bt[n][k], At[m][k], acc[ai][bj][m][n], 0, 0, 0); } } \
        __builtin_amdgcn_s_setprio(0); } while (0)
#define PG8_WAIT_V(n) asm volatile("s_waitcnt vmcnt(" #n ")" ::: "memory")
#define PG8_WAIT_L(n) asm volatile("s_waitcnt lgkmcnt(" #n ")" ::: "memory")
#define PG8_BAR __builtin_amdgcn_s_barrier()
#define PG8_SCHED __builtin_amdgcn_sched_barrier(0)
    Unit cur, nxt; int ui = 0;
    if (!S.next(0, cur)) return;
    f32x4 acc[2][2][4][2];
#pragma unroll
    for (int a = 0; a < 2; ++a)
#pragma unroll
        for (int b = 0; b < 2; ++b)
#pragma unroll
            for (int m = 0; m < 4; ++m)
#pragma unroll
                for (int n = 0; n < 2; ++n) acc[a][b][m][n] = (f32x4){0.f, 0.f, 0.f, 0.f};
    bf16x8 At[4][2], B0[2][2], B1[2][2]; v8i32 At8[4], B08[2], B18[2]; const int f8scale = 0x7F7F7F7F;
    const char* cA = (const char*)g.A + (size_t)(Sched::SPARSE_A ? cur.pa : cur.pm) * tstep; const char* cB = (const char*)g.Bt + (size_t)cur.pn * tstep;
    S.a_ready(cur);
    if constexpr (SP2) {
        PG8_STAGE(PG8_SB(0, 0), cB, voffB); PG8_STAGE(PG8_SB(0, 1), cB + hstep, voffB); PG8_STAGE(PG8_SA(0, 0), cA, voffA); PG8_STAGE(PG8_SA(0, 1), cA + hstep, voffA);
        if (wr == 1) PG8_BAR;
        PG8_WAIT_V(2); PG8_BAR;
        PG8_STAGE(PG8_SB(1, 0), cB + kstep, voffB); PG8_STAGE(PG8_SA(1, 0), cA + kstep, voffA); PG8_STAGE(PG8_SB(1, 1), cB + hstep + kstep, voffB);
        PG8_WAIT_V(6); PG8_BAR;
    } else {
        PG8_STAGE(PG8_SB(0, 0), cB, voffB); PG8_STAGE(PG8_SA(0, 0), cA, voffA); PG8_STAGE(PG8_SB(0, 1), cB + hstep, voffB); PG8_STAGE(PG8_SA(0, 1), cA + hstep, voffA);
        if (wr == 1) PG8_BAR;
        PG8_WAIT_V(4); PG8_BAR;
        PG8_STAGE(PG8_SB(1, 0), cB + kstep, voffB); PG8_STAGE(PG8_SA(1, 0), cA + kstep, voffA); PG8_STAGE(PG8_SB(1, 1), cB + hstep + kstep, voffB);
        PG8_WAIT_V(6); PG8_BAR;
    }
    for (;;) {
        const bool has_next = S.next(ui + 1, nxt);
        const char* nA = has_next ? (const char*)g.A + (size_t)(Sched::SPARSE_A ? nxt.pa : nxt.pm) * tstep : cA; const char* nB = has_next ? (const char*)g.Bt + (size_t)nxt.pn * tstep : cB;
        for (int t = 0; t < nt; t += 2) {
            const bool last = (t == nt - 2);
            const char* a1 = cA + (size_t)(t + 1) * kstep;
            const char* a2 = last ? nA : cA + (size_t)(t + 2) * kstep; const char* b2 = last ? nB : cB + (size_t)(t + 2) * kstep;
            const char* a3 = a2 + kstep; const char* b3 = b2 + kstep;
            if (last && has_next) S.a_ready(nxt);
            if constexpr (SP2) {
            PG8_LDB(B0, 0, 0); PG8_LDB(B1, 0, 1); PG8_SCHED; PG8_LDA(At, 0, 0); PG8_STAGE(PG8_SA(1, 1), a1 + hstep, voffA);
            PG8_WAIT_V(8); PG8_WAIT_L(0); PG8_BAR; PG8_MMA(0, 0, At, B0); PG8_MMA(0, 1, At, B1); PG8_BAR; PG8_SCHED;
            PG8_LDA(At, 0, 1); PG8_STAGE(PG8_SB(0, 0), b2, voffB); PG8_STAGE(PG8_SB(0, 1), b2 + hstep, voffB); PG8_STAGE(PG8_SA(0, 0), a2, voffA);
            PG8_WAIT_V(8); PG8_WAIT_L(0); PG8_BAR; PG8_MMA(1, 0, At, B0); PG8_MMA(1, 1, At, B1); PG8_BAR; PG8_SCHED;
            PG8_LDB(B0, 1, 0); PG8_LDB(B1, 1, 1); PG8_SCHED; PG8_LDA(At, 1, 0); PG8_STAGE(PG8_SA(0, 1), a2 + hstep, voffA);
            PG8_WAIT_V(8); PG8_WAIT_L(0); PG8_BAR; PG8_MMA(0, 0, At, B0); PG8_MMA(0, 1, At, B1); PG8_BAR; PG8_SCHED;
            PG8_LDA(At, 1, 1); PG8_STAGE(PG8_SB(1, 0), b3, voffB); PG8_STAGE(PG8_SB(1, 1), b3 + hstep, voffB); PG8_STAGE(PG8_SA(1, 0), a3, voffA);
            PG8_WAIT_V(8); PG8_WAIT_L(0); PG8_BAR; PG8_MMA(1, 0, At, B0); PG8_MMA(1, 1, At, B1); PG8_BAR; PG8_SCHED;
            } else {
            PG8_LDB(B0, 0, 0); PG8_SCHED; PG8_LDA(At, 0, 0); PG8_STAGE(PG8_SA(1, 1), a1 + hstep, voffA);
            PG8_WAIT_L(8); PG8_BAR; PG8_WAIT_L(0); PG8_MMA(0, 0, At, B0); PG8_BAR; PG8_SCHED;
            PG8_LDB(B1, 0, 1); PG8_STAGE(PG8_SB(0, 0), b2, voffB);
            PG8_BAR; PG8_WAIT_L(0); PG8_MMA(0, 1, At, B1); PG8_BAR;
            PG8_LDA(At, 0, 1); PG8_STAGE(PG8_SA(0, 0), a2, voffA);
            PG8_BAR; PG8_WAIT_L(0); PG8_MMA(1, 0, At, B0); PG8_BAR; PG8_SCHED;
            PG8_STAGE(PG8_SB(0, 1), b2 + hstep, voffB);
            PG8_WAIT_V(6); PG8_BAR; PG8_MMA(1, 1, At, B1); PG8_BAR;
            PG8_LDB(B0, 1, 0); PG8_SCHED; PG8_LDA(At, 1, 0); PG8_STAGE(PG8_SA(0, 1), a2 + hstep, voffA);
            PG8_WAIT_L(8); PG8_BAR; PG8_WAIT_L(0); PG8_MMA(0, 0, At, B0); PG8_BAR; PG8_SCHED;
            PG8_LDB(B1, 1, 1); PG8_STAGE(PG8_SB(1, 0), b3, voffB);
            PG8_BAR; PG8_WAIT_L(0); PG8_MMA(0, 1, At, B1); PG8_BAR;
            PG8_LDA(At, 1, 1); PG8_STAGE(PG8_SA(1, 0), a3, voffA);
            PG8_BAR; PG8_WAIT_L(0); PG8_MMA(1, 0, At, B0); PG8_BAR; PG8_SCHED;
            PG8_STAGE(PG8_SB(1, 1), b3 + hstep, voffB);
            PG8_WAIT_V(6); PG8_BAR; PG8_MMA(1, 1, At, B1); PG8_BAR;
            }
        }
        if constexpr (ALIGN_EPI) { if (wr == 0) PG8_BAR; }
        if constexpr (F8) { asm volatile("s_nop 15\n\ts_nop 15" ::: "memory"); }
        if constexpr (!Epi::AFTER_DRAIN) { E(acc, cur, wr, wc, fr, fq); S.done(cur); }
        if (!has_next) break;
#pragma unroll
        for (int a = 0; a < 2; ++a)
#pragma unroll
            for (int b = 0; b < 2; ++b)
#pragma unroll
                for (int m = 0; m < 4; ++m)
#pragma unroll
                    for (int n = 0; n < 2; ++n) acc[a][b][m][n] = (f32x4){0.f, 0.f, 0.f, 0.f};
        cur = nxt; cA = nA; cB = nB; ++ui;
        if constexpr (ALIGN_EPI) { if (wr == 1) PG8_BAR; }
    }
    PG8_WAIT_V(0);
    if constexpr (!ALIGN_EPI) { if (wr == 0) PG8_BAR; }
    PG8_BAR;
    if constexpr (Epi::AFTER_DRAIN) { E.fused(acc, cur, wr, wc, fr, fq, lds, wid, lane); S.done(cur); }
#undef PG8_SA
#undef PG8_SB
#undef PG8_STAGE
#undef PG8_LDA
#undef PG8_LDB
#undef PG8_MMA
#undef PG8_WAIT_V
#undef PG8_WAIT_L
#undef PG8_BAR
#undef PG8_SCHED
}
}

#ifndef PG8_SP2
#define PG8_SP2 true
#endif
#ifndef PG8_ALIGN
#define PG8_ALIGN true
#endif
constexpr int NWAVES = 8;
#ifndef MK_N_LAUNCHES
#define MK_N_LAUNCHES 1
#endif
constexpr int NPHASE = 11;
constexpr int N_LAUNCHES = MK_N_LAUNCHES;
static_assert(N_LAUNCHES == 1 || N_LAUNCHES == NPHASE, "MK_N_LAUNCHES is 1 or 11");

constexpr int D = 2048, NB = 8, SEQ = 2048, T = NB * SEQ, LC = 256, TC = NB * LC, MTOT = T + TC;
constexpr int HEADS = 8, HD = 128, MIXG = 1024;
constexpr int SQN = 0, SKN = 1, SVN = 2, SQH = 3, SKF = 4, SKB = 5, SIH = 6, SGF = 7, SGB = 8, NSTREAM = 9;
constexpr size_t HM_CTX0 = (size_t)NSTREAM * NB * HEADS * SEQ * HD, HM_GATE0 = HM_CTX0 + (size_t)NSTREAM * NB * HEADS * LC * HD;
constexpr int NE = 32, TOPK = 4, FF = 2048;
constexpr int CAP_TILES = 288, CAP = CAP_TILES * 256;
constexpr float EPS = 1e-6f;

constexpr size_t MiB = 1u << 20;
constexpr size_t WS_CTL = 0, CTL_ZERO_BYTES = 1 * MiB;
constexpr size_t WS_MODP = 4 * MiB;
constexpr size_t WS_MODF = 6 * MiB;
constexpr size_t WS_WRT = 7 * MiB;
constexpr size_t WS_WIN = 8 * MiB;
constexpr size_t WS_WOUT = 40 * MiB;
constexpr size_t WS_HXN = 48 * MiB;
constexpr size_t WS_PX = 120 * MiB;
constexpr size_t WS_A2 = 480 * MiB;
constexpr size_t WS_OF = 544 * MiB;
constexpr size_t WS_OB = 608 * MiB;
constexpr size_t WS_X1 = 672 * MiB;
constexpr size_t WS_HX2 = 800 * MiB;
constexpr size_t WS_RT = 864 * MiB;
constexpr size_t WS_XG = 2498 * MiB;
constexpr size_t WS_XG_OLD = 866 * MiB;
constexpr size_t WS_H = 1154 * MiB;
constexpr size_t WS_Y = 1442 * MiB;
constexpr size_t WS_WGU = 1730 * MiB;
constexpr size_t WS_WD = 2242 * MiB;
constexpr size_t WS_END = 3522 * MiB;
constexpr int CW_TMO = 0;
constexpr int CW_BAR = 4096, CW_BAR2 = 8192;
constexpr int NCONV = 54, CVA_PER_WAVE = 0;
constexpr int CW_ATTQ = 16384;
constexpr int CW_CNT = 16448;

constexpr int RING_OFF = 0, SCR_BYTES = 139264;
constexpr int LDSCTL_OFF = SCR_BYTES, MISC_OFF = LDSCTL_OFF + 320, TILE_OFF = MISC_OFF + 128, OFFT_OFF = TILE_OFF + 320;
constexpr int LDS_BYTES = 147456;
static_assert(OFFT_OFF + 256 <= LDS_BYTES, "LDS map");

#define GAS __attribute__((address_space(1)))
#define LAS __attribute__((address_space(3)))
typedef unsigned short bf16;
typedef unsigned char u8;
typedef unsigned v4u __attribute__((ext_vector_type(4)));
typedef unsigned v2u __attribute__((ext_vector_type(2)));
typedef float f32x4 __attribute__((ext_vector_type(4)));
typedef float f32x2 __attribute__((ext_vector_type(2)));
typedef short bf16x8 __attribute__((ext_vector_type(8)));
typedef short s16x4 __attribute__((ext_vector_type(4)));
typedef __bf16 bfv2 __attribute__((ext_vector_type(2)));
typedef GAS unsigned gu32;
#define RLX_AGENT __ATOMIC_RELAXED, __HIP_MEMORY_SCOPE_AGENT
#define LDS_WAIT() asm volatile("s_waitcnt lgkmcnt(0)" ::: "memory")
#define VM_WAIT() asm volatile("s_waitcnt vmcnt(0)" ::: "memory")
__device__ __forceinline__ unsigned pk2(float lo, float hi) { f32x2 v = {lo, hi}; bfv2 b = __builtin_convertvector(v, bfv2); return __builtin_bit_cast(unsigned, b); }
constexpr float SW8 = 256.f, SA8 = 8.f, SH8 = 4.f, SY8 = 16.f;
__device__ __forceinline__ unsigned pk4_fp8(float a, float b, float c, float d) {
    a = fminf(fmaxf(a, -448.f), 448.f); b = fminf(fmaxf(b, -448.f), 448.f); c = fminf(fmaxf(c, -448.f), 448.f); d = fminf(fmaxf(d, -448.f), 448.f);
    int w = __builtin_amdgcn_cvt_pk_fp8_f32(a, b, 0, false); w = __builtin_amdgcn_cvt_pk_fp8_f32(c, d, w, true); return (unsigned)w; }
__device__ __forceinline__ size_t hm_lat(int s, int b, int h) { return ((size_t)((s * NB + b) * HEADS + h) * SEQ) * HD; }
__device__ __forceinline__ size_t hm_ctx(int s, int b, int h) { return HM_CTX0 + ((size_t)((s * NB + b) * HEADS + h) * LC) * HD; }
__device__ __forceinline__ size_t hm_row(int s, int row, int h) { return row < T ? hm_lat(s, row >> 11, h) + (size_t)(row & 2047) * HD : hm_ctx(s, (row - T) >> 8, h) + (size_t)((row - T) & 255) * HD; }
__device__ __forceinline__ unsigned pk4_fp8_nc(float a, float b, float c, float d) {
    int w = __builtin_amdgcn_cvt_pk_fp8_f32(a, b, 0, false); w = __builtin_amdgcn_cvt_pk_fp8_f32(c, d, w, true); return (unsigned)w; }
typedef float v16f __attribute__((ext_vector_type(16))); typedef unsigned v6u __attribute__((ext_vector_type(6)));
__device__ __forceinline__ void mx6_pack(const float (&v)[32], v6u& p, unsigned& eb) {
    float m = fabsf(v[0]);
#pragma unroll
    for (int i = 1; i < 32; ++i) m = fmaxf(m, fabsf(v[i]));
    const unsigned mb = __float_as_uint(m);
    int e = (int)(mb >> 23) - 129 + (((mb & 0x7FFFFFu) > 0x700000u) ? 1 : 0);
    e = max(e, -126);
    const float inv = __uint_as_float((unsigned)(127 - e) << 23);
    v16f lo, hi;
#pragma unroll
    for (int i = 0; i < 16; ++i) { lo[i] = v[i] * inv; hi[i] = v[16 + i] * inv; }
    p = __builtin_amdgcn_cvt_scalef32_2xpk16_fp6_f32(lo, hi, 1.0f);
    eb = (unsigned)(e + 127);
}
__device__ __forceinline__ float bflo(unsigned u) { return __uint_as_float(u << 16); }
__device__ __forceinline__ float bfhi(unsigned u) { return __uint_as_float(u & 0xffff0000u); }
__device__ __forceinline__ float wave_sum(float v) {
#pragma unroll
    for (int o = 1; o < 64; o <<= 1) v += __shfl_xor(v, o);
    return v;
}
__device__ __forceinline__ float rcp_f(float x) { return __builtin_amdgcn_rcpf(x); }
__device__ __forceinline__ float silu_f(float x) { return x * rcp_f(1.f + __expf(-x)); }
__device__ __forceinline__ bf16x8 cat8(s16x4 a, s16x4 b) { return __builtin_shufflevector(a, b, 0, 1, 2, 3, 4, 5, 6, 7); }
__device__ __forceinline__ s16x4 tr_read(const LAS unsigned char* p) { return __builtin_amdgcn_ds_read_tr16_b64_v4i16((LAS s16x4*)p); }
__device__ __forceinline__ bf16x8 mk8(unsigned a, unsigned b, unsigned c, unsigned d) { v4u v = {a, b, c, d}; return __builtin_bit_cast(bf16x8, v); }
#define XB_TMO      128
#define XB_XCNT(j)  (256  + 64 * (j))
#define XB_XSUB(j)  (1280 + 64 * (j))
#define XB_XGEN(j)  (2304 + 64 * (j))
#define XB_TOP      3328
#define XB_TOPGEN   3392
#define XCD_BAR_WORDS 3456
#define XB_SPIN_CAP (1u << 18)

__device__ __forceinline__ unsigned xb_ld(unsigned* p)              { return __hip_atomic_load(p, __ATOMIC_RELAXED, __HIP_MEMORY_SCOPE_AGENT); }
__device__ __forceinline__ unsigned xb_add(unsigned* p, unsigned v) { return __hip_atomic_fetch_add(p, v, __ATOMIC_RELAXED, __HIP_MEMORY_SCOPE_AGENT); }
__device__ __forceinline__ unsigned xb_xcc_id() { return (unsigned)__builtin_amdgcn_s_getreg((3 << 11) | 20) & 0xFu; }
#define XB_SPIN(cond, bar) do { unsigned _sp = 0; while (cond) { __builtin_amdgcn_s_sleep(1); \
    if ((++_sp & 255u) == 0u) { if (xb_ld(&(bar)[XB_TMO])) break; if (_sp > XB_SPIN_CAP) { atomicAdd(&(bar)[XB_TMO], 1u); break; } } } } while (0)

struct XcdBarrier {
    unsigned* bar; unsigned x; unsigned total;
    volatile LAS unsigned* st;
};

__device__ __forceinline__ XcdBarrier xcd_barrier_post(unsigned* bar, volatile LAS unsigned* st, unsigned total) {
    XcdBarrier b; b.bar = bar; b.x = xb_xcc_id(); b.st = st; b.total = total;
    if (threadIdx.x == 0) (void)xb_add(&bar[XB_XCNT(b.x)], 1u);
    return b;
}
__device__ __forceinline__ void xcd_barrier_complete(unsigned* bar, unsigned x, unsigned G, unsigned& nloc, unsigned& nx) {
    unsigned sum, cnt, mine, sp = 0u;
    for (;;) {
        sum = 0u; cnt = 0u; mine = 0u;
#pragma unroll
        for (unsigned j = 0; j < 16; ++j) { const unsigned c = xb_ld(&bar[XB_XCNT(j)]); sum += c; cnt += (c > 0u) ? 1u : 0u; mine = (j == x) ? c : mine; }
        if (sum == G) break;
        __builtin_amdgcn_s_sleep(1);
        if ((++sp & 255u) == 0u) { if (xb_ld(&bar[XB_TMO])) break; if (sp > XB_SPIN_CAP) { atomicAdd(&bar[XB_TMO], 1u); break; } }
    }
    nloc = mine > 0u ? mine : 1u; nx = cnt > 0u ? cnt : 1u;
}

__device__ __forceinline__ void xcd_barrier(const XcdBarrier& b) {
    asm volatile("s_waitcnt vmcnt(0)" ::: "memory");
    __syncthreads();
    if (threadIdx.x == 0) {
        unsigned* bar = b.bar;
        __builtin_amdgcn_s_waitcnt(0);
        unsigned nloc = b.st[0], nx = b.st[1];
        if (nloc == 0u) { xcd_barrier_complete(bar, b.x, b.total, nloc, nx); b.st[0] = nloc; b.st[1] = nx; }
        const unsigned old = xb_add(&bar[XB_XSUB(b.x)], 1u);
        const unsigned gen = old / nloc;
        if (old + 1u == (gen + 1u) * nloc) {
            __builtin_amdgcn_fence(__ATOMIC_RELEASE, "agent");
            asm volatile("s_waitcnt vmcnt(0)" ::: "memory");
            const unsigned og = xb_add(&bar[XB_TOP], 1u);
            const unsigned tg = og / nx;
            if (og + 1u == (tg + 1u) * nx) xb_add(&bar[XB_TOPGEN], 1u);
            else XB_SPIN(xb_ld(&bar[XB_TOPGEN]) == tg, bar);
            __builtin_amdgcn_fence(__ATOMIC_ACQUIRE, "agent");
            xb_add(&bar[XB_XGEN(b.x)], 1u);
            asm volatile("s_waitcnt vmcnt(0)" ::: "memory");
        } else {
            XB_SPIN(xb_ld(&bar[XB_XGEN(b.x)]) == gen, bar);
            __builtin_amdgcn_fence(__ATOMIC_ACQUIRE, "agent");
            asm volatile("s_waitcnt vmcnt(0)" ::: "memory");
        }
    }
    __syncthreads();
}

struct Frame {
    LAS unsigned char* lds;
    volatile LAS unsigned* MISC;
    gu32* ctl;
    int tid, lane, wave;
    int vcu, G;
    const float *x, *c, *ctx, *c_ctx, *w_ada, *b_ada, *norm_mix, *norm_ffn, *w_in, *lb_table, *hg_norm, *rpb, *w_out, *w_router, *b_router, *w_gu, *b_gu, *w_down, *b_down, *norm_final;
    float* out;
    float *MODP, *MODF; bf16 *OF, *OB;
    bf16 *WRT, *WIN, *WOUT, *HXN, *PX, *A2, *X1; u8 *HX2, *XG, *H, *WGU, *WD, *Y;
    int *RT_E, *RT_POS, *RT_SLOT; float* RT_G;
};

__device__ __forceinline__ void p0_mod_unit(Frame& F, int unit) {
    const int slab = unit >> 2, ks = unit & 3, col0 = slab * 64, k0 = ks * 512;
    LAS float* cond = (LAS float*)(F.lds);
    LAS float* red = (LAS float*)(F.lds + 9 * 512 * 4);
    for (int i = F.tid; i < 9 * 512; i += 512) { const int r = i >> 9, k = i & 511; const float v = (r < 8) ? F.c[r * D + k0 + k] : F.c_ctx[k0 + k]; cond[i] = silu_f(v); }
    __syncthreads();
    const int c4 = F.tid & 15, kl = F.tid >> 4;
    float acc[9][4];
#pragma unroll
    for (int r = 0; r < 9; ++r) { acc[r][0] = 0.f; acc[r][1] = 0.f; acc[r][2] = 0.f; acc[r][3] = 0.f; }
    const float* wp = F.w_ada + (size_t)(k0 + kl) * (6 * D) + col0 + 4 * c4;
#pragma unroll 4
    for (int it = 0; it < 16; ++it) {
        const f32x4 w = *(const f32x4*)(wp + (size_t)(32 * it) * (6 * D));
#pragma unroll
        for (int r = 0; r < 9; ++r) { const float cv = cond[r * 512 + kl + 32 * it]; acc[r][0] += cv * w.x; acc[r][1] += cv * w.y; acc[r][2] += cv * w.z; acc[r][3] += cv * w.w; }
    }
#pragma unroll
    for (int r = 0; r < 9; ++r)
#pragma unroll
        for (int j = 0; j < 4; ++j) { float v = acc[r][j]; v += __shfl_xor(v, 16); v += __shfl_xor(v, 32); if (F.lane < 16) red[F.wave * 576 + r * 64 + 4 * c4 + j] = v; }
    __syncthreads();
    for (int o = F.tid; o < 576; o += 512) { float s = 0.f;
#pragma unroll
        for (int w = 0; w < 8; ++w) s += red[w * 576 + o];
        const int r = o >> 6, cc = o & 63; F.MODP[(size_t)(ks * 9 + r) * (6 * D) + col0 + cc] = s; }
    __syncthreads();
}
__device__ __forceinline__ void p0_tr_item(const float* W, int ldw, bf16* WT, size_t dst_row0, int k0, int n0, LAS float* scr, int lane, int hi_off = 0) {
#pragma unroll 4
    for (int i = 0; i < 16; ++i) { const int kk = 4 * i + (lane >> 4); const f32x4 v = *(const f32x4*)(W + (size_t)(k0 + kk) * ldw + n0 + 4 * (lane & 15));
        LAS float* s = scr + kk * 65 + 4 * (lane & 15); s[0] = v.x; s[1] = v.y; s[2] = v.z; s[3] = v.w; }
    LDS_WAIT(); asm volatile("" ::: "memory");
    const int c = lane & 7, nn = lane >> 3;
#pragma unroll
    for (int j = 0; j < 8; ++j) { const int n = 8 * j + nn; const LAS float* s = scr + (8 * c) * 65 + n;
        v4u o; o.x = pk2(s[0 * 65], s[1 * 65]); o.y = pk2(s[2 * 65], s[3 * 65]); o.z = pk2(s[4 * 65], s[5 * 65]); o.w = pk2(s[6 * 65], s[7 * 65]);
        *(v4u*)(WT + (dst_row0 + n + (n >= 32 ? hi_off : 0)) * 2048 + k0 + 8 * c) = o; }
    LDS_WAIT(); asm volatile("" ::: "memory");
}
__device__ __forceinline__ void p0_tr_item8(const float* W, int ldw, u8* WT, size_t dst_row0, int k0, int n0, LAS float* scr, int lane, float scale) {
#pragma unroll 4
    for (int i = 0; i < 16; ++i) { const int kk = 8 * i + (lane >> 3); const f32x4 v = *(const f32x4*)(W + (size_t)(k0 + kk) * ldw + n0 + 4 * (lane & 7)) * scale;
        LAS float* s = scr + kk * 33 + 4 * (lane & 7); s[0] = v.x; s[1] = v.y; s[2] = v.z; s[3] = v.w; }
    LDS_WAIT(); asm volatile("" ::: "memory");
    const int n = lane & 31, h = lane >> 5;
#pragma unroll
    for (int j = 0; j < 4; ++j) { const int cj = 2 * j + h; const LAS float* s = scr + (16 * cj) * 33 + n;
        v4u o; o.x = pk4_fp8(s[0 * 33], s[1 * 33], s[2 * 33], s[3 * 33]); o.y = pk4_fp8(s[4 * 33], s[5 * 33], s[6 * 33], s[7 * 33]);
        o.z = pk4_fp8(s[8 * 33], s[9 * 33], s[10 * 33], s[11 * 33]); o.w = pk4_fp8(s[12 * 33], s[13 * 33], s[14 * 33], s[15 * 33]);
        *(v4u*)(WT + (dst_row0 + n) * 2048 + k0 + 16 * cj) = o; }
    LDS_WAIT(); asm volatile("" ::: "memory");
}
__device__ __forceinline__ void p0_prologue(Frame& F, bool with_moe) {
    for (int u = F.vcu; u < 768; u += F.G) p0_mod_unit(F, u);
    LAS float* scr = (LAS float*)(F.lds + F.wave * 16896);
    const int gw = F.vcu * NWAVES + F.wave, NGW = F.G * NWAVES;
    constexpr int I_IN = 32 * 128, I_OUT = 32 * 32, I_GU = 32 * 64, I_DN = 32 * 32;
    const int NITEMS = I_IN + I_OUT + (with_moe ? NE * I_GU + NE * I_DN : 0);
    for (int it = gw; it < NITEMS; it += NGW) {
        int r = it;
        if (r < I_IN) { const int kb = r >> 7, nb = r & 127, n0 = nb * 64, part = n0 >> 10;
            const bool prm = (part >= 3 && part <= 5); const int cl = n0 & 255;
            const size_t drow = prm ? (size_t)((n0 & ~255) + 32 * ((cl >> 7) * 2 + ((cl >> 6) & 1))) : (size_t)n0;
            p0_tr_item(F.w_in, 8192, F.WIN, drow, kb * 64, n0, scr, F.lane, prm ? 96 : 0); continue; } r -= I_IN;
        if (r < I_OUT) { const int kb = r >> 6, nb = r & 63; p0_tr_item8(F.w_out, 2048, (u8*)F.WOUT, (size_t)nb * 32, kb * 128, nb * 32, scr, F.lane, SW8); continue; } r -= I_OUT;
        if (r < NE * I_GU) { const int e = r >> 11, q = r & 2047, kb = q >> 7, nb = q & 127, n0 = nb * 32;
            const size_t drow = (size_t)e * 4096 + (size_t)(((n0 & 2047) >> 7) * 256 + (n0 >> 11) * 128 + (n0 & 127));
            p0_tr_item8(F.w_gu + (size_t)e * 2048 * 4096, 4096, F.WGU, drow, kb * 128, n0, scr, F.lane, SW8); continue; } r -= NE * I_GU;
        { const int e = r >> 10, q = r & 1023, kb = q >> 6, nb = q & 63; p0_tr_item8(F.w_down + (size_t)e * 2048 * 2048, 2048, F.WD, (size_t)e * 2048 + nb * 32, kb * 128, nb * 32, scr, F.lane, SW8); }
    }
    for (int i = F.vcu * 512 + F.tid; i < NE * D; i += F.G * 512) { const int e = i >> 11, k = i & 2047; const float w = F.w_router[k * NE + e];
        const unsigned hi = pk2(w, 0.f) & 0xffffu; const float wl = w - bflo(hi); F.WRT[i] = (bf16)hi; F.WRT[NE * D + i] = (bf16)(pk2(wl, 0.f) & 0xffffu); }
}

struct CvItem { const float* src; u8* dst; int ldw; int t6; };
__device__ __forceinline__ CvItem cv_decode(Frame& F, int r) {
    CvItem c;
    if (r < NE * 2048) { const int e = r >> 11, q = r & 2047, kb = q >> 7, nb = q & 127, n0 = nb * 32;
        const size_t drow = (size_t)e * 4096 + (size_t)(((n0 & 2047) >> 7) * 256 + (n0 >> 11) * 128 + (n0 & 127));
        c.src = F.w_gu + (size_t)e * 2048 * 4096 + (size_t)(kb * 128) * 4096 + n0; c.ldw = 4096; c.dst = F.WGU + drow * 2048 + kb * 128; c.t6 = 1; }
    else { r -= NE * 2048; const int e = r >> 10, q = r & 1023, kb = q >> 6, nb = q & 63;
        c.src = F.w_down + (size_t)e * 2048 * 2048 + (size_t)(kb * 128) * 2048 + nb * 32; c.ldw = 2048; c.dst = F.WD + ((size_t)e * 2048 + nb * 32) * 2048 + kb * 128; c.t6 = 0; }
    return c;
}
__device__ __forceinline__ void cv_load(f32x4 (&v)[16], const CvItem& c, int lane) {
    const float* p = c.src + (size_t)(16 * (lane >> 3)) * c.ldw + 4 * (lane & 7);
#pragma unroll
    for (int i = 0; i < 16; ++i) v[i] = __builtin_nontemporal_load((const f32x4*)(p + (size_t)i * c.ldw));
}
__device__ __forceinline__ void cv_proc(const f32x4 (&v)[16], const CvItem& c, LAS float* scr, int lane) {
    (void)scr;
    if (c.t6) {
        const bool odd = (lane >> 3) & 1;
        float lo[2][16], hi[2][16];
#pragma unroll
        for (int i = 0; i < 16; ++i) {
            const float sx = odd ? v[i].x : v[i].z, sy = odd ? v[i].y : v[i].w, ox = odd ? v[i].z : v[i].x, oy = odd ? v[i].w : v[i].y;
            const float rx = __int_as_float(__builtin_amdgcn_mov_dpp(__float_as_int(sx), 0x128, 0xf, 0xf, true)), ry = __int_as_float(__builtin_amdgcn_mov_dpp(__float_as_int(sy), 0x128, 0xf, 0xf, true));
            lo[0][i] = odd ? rx : ox; hi[0][i] = odd ? ox : rx; lo[1][i] = odd ? ry : oy; hi[1][i] = odd ? oy : ry; }
        u8* d6 = c.dst + (size_t)(4 * (lane & 7) + (odd ? 2 : 0)) * 2048 + 16 * (lane >> 4);
#pragma unroll
        for (int cc = 0; cc < 2; ++cc) { float hv[32];
#pragma unroll
            for (int j = 0; j < 16; ++j) { hv[j] = lo[cc][j]; hv[16 + j] = hi[cc][j]; }
            v6u p; unsigned eb; mx6_pack(hv, p, eb);
            __builtin_nontemporal_store((v4u){p[0], p[1], p[2], p[3]}, (v4u*)(d6 + (size_t)cc * 2048)); __builtin_nontemporal_store((v4u){p[4], p[5], eb, 0u}, (v4u*)(d6 + (size_t)cc * 2048 + 64)); }
        return; }
    u8* d = c.dst + (size_t)(4 * (lane & 7)) * 2048 + 16 * (lane >> 3);
#pragma unroll
    for (int cc = 0; cc < 4; ++cc) { v4u o;
        o.x = pk4_fp8(v[0][cc] * SW8, v[1][cc] * SW8, v[2][cc] * SW8, v[3][cc] * SW8); o.y = pk4_fp8(v[4][cc] * SW8, v[5][cc] * SW8, v[6][cc] * SW8, v[7][cc] * SW8);
        o.z = pk4_fp8(v[8][cc] * SW8, v[9][cc] * SW8, v[10][cc] * SW8, v[11][cc] * SW8); o.w = pk4_fp8(v[12][cc] * SW8, v[13][cc] * SW8, v[14][cc] * SW8, v[15][cc] * SW8);
        __builtin_nontemporal_store(o, (v4u*)(d + (size_t)cc * 2048)); }
}
__device__ __forceinline__ void convert_moe(Frame& F, int gw, int ngw, int lo, int hi) {
    f32x4 va[16], vb[16];
    int it = lo + gw;
    if (it >= hi) return;
    CvItem ca = cv_decode(F, it), cb = ca;
    cv_load(va, ca, F.lane);
    for (;;) {
        const bool hb = it + ngw < hi;
        if (hb) { cb = cv_decode(F, it + ngw); cv_load(vb, cb, F.lane); }
        cv_proc(va, ca, nullptr, F.lane);
        if (!hb) break;
        it += ngw;
        const bool ha = it + ngw < hi;
        if (ha) { ca = cv_decode(F, it + ngw); cv_load(va, ca, F.lane); }
        cv_proc(vb, cb, nullptr, F.lane);
        if (!ha) break;
        it += ngw;
    }
}

__device__ __forceinline__ void p1_build_vec(Frame& F, int bb, int sh_off, int sc_off, const float* gain, bool from_partials) {
    LAS float* Av = (LAS float*)(F.lds); LAS float* Bv = Av + D;
    for (int c = F.tid; c < D; c += 512) {
        float sh, sc;
        if (from_partials) { sh = F.b_ada[sh_off + c]; sc = F.b_ada[sc_off + c];
#pragma unroll
            for (int ks = 0; ks < 4; ++ks) { sh += F.MODP[(size_t)(ks * 9 + bb) * (6 * D) + sh_off + c]; sc += F.MODP[(size_t)(ks * 9 + bb) * (6 * D) + sc_off + c]; } }
        else { sh = F.MODF[(size_t)bb * (6 * D) + sh_off + c]; sc = F.MODF[(size_t)bb * (6 * D) + sc_off + c]; }
        Av[c] = gain[c] * (1.f + sc); Bv[c] = sh; }
    __syncthreads();
}
__device__ __forceinline__ void norm_row_bf16(Frame& F, const float* xrow, bf16* orow) {
    const LAS f32x4* Av = (const LAS f32x4*)(F.lds); const LAS f32x4* Bv = Av + D / 4;
    const f32x4* xr = (const f32x4*)xrow + F.lane;
    f32x4 v[8]; float s = 0.f;
#pragma unroll
    for (int j = 0; j < 8; ++j) { v[j] = xr[64 * j]; s += (v[j].x * v[j].x + v[j].y * v[j].y) + (v[j].z * v[j].z + v[j].w * v[j].w); }
    const float rstd = rsqrtf(wave_sum(s) * (1.f / D) + EPS);
    v2u* o8 = (v2u*)orow + F.lane;
#pragma unroll
    for (int j = 0; j < 8; ++j) { const f32x4 a = Av[F.lane + 64 * j], b = Bv[F.lane + 64 * j]; const f32x4 y = v[j] * rstd * a + b;
        v2u o; o.x = pk2(y.x, y.y); o.y = pk2(y.z, y.w); o8[64 * j] = o; }
}
__device__ __forceinline__ void p1_norm(Frame& F) {
    for (int i = F.vcu * 512 + F.tid; i < 9 * 6 * D; i += F.G * 512) { float s = F.b_ada[i % (6 * D)];
#pragma unroll
        for (int ks = 0; ks < 4; ++ks) s += F.MODP[(size_t)ks * 9 * 6 * D + i];
        F.MODF[i] = s; }
    for (int blk = F.vcu; blk < 256; blk += F.G) {
        const int bb = blk >> 5;
        p1_build_vec(F, bb, 0, D, F.norm_mix, true);
        for (int r = F.wave; r < 64; r += NWAVES) { const int row = blk * 64 + r; norm_row_bf16(F, F.x + (size_t)row * D, F.HXN + (size_t)row * D); }
        __syncthreads();
        p1_build_vec(F, 8, 0, D, F.norm_mix, true);
        { const int row = blk * 8 + F.wave; norm_row_bf16(F, F.ctx + (size_t)row * D, F.HXN + (size_t)(T + row) * D); }
        __syncthreads();
    }
}

struct InProjOrder {
    static constexpr bool SPARSE_A = false;
    pg8::StaticOrder so; int G, c;
    __device__ void init(int G_, int c_) { so.init(T, 8192, G_, c_); G = G_; c = c_; }
    __device__ bool next(int i, pg8::Unit& u) const {
        const int L = i * G + c;
        if (L < 2048) return so.next(i, u);
        const int idx = L - 2048; if (idx >= 160) return false;
        const int q = idx % 20; u.pm = 64 + idx / 20; u.pn = q < 8 ? 4 + q : 8 + q; return true;
    }
    __device__ __forceinline__ void a_ready(const pg8::Unit&) const {}
    __device__ __forceinline__ void done(const pg8::Unit&) const {}
};
struct EpiInProj {
    static constexpr bool PERM = true, AFTER_DRAIN = false;
    bf16* PX; const float* lbt;
    __device__ __forceinline__ void operator()(const f32x4 (&acc)[2][2][4][2], const pg8::Unit& u, int wr, int wc, int fr, int fq) const {
        const int row0 = u.pm * 256 + wr * 64 + fr, part = u.pn >> 2;
        if (part >= 3 && part <= 5) {
            const int axis = wc & 1, cbase = u.pn * 256 + (wc >> 1) * 128 + axis * 64 + 8 * fq;
            const int hh = (u.pn & 3) * 2 + (wc >> 1), cc0 = axis * 64 + 8 * fq, sk = (part == 3) ? SQH : (part == 4 ? SKF : SKB), sg = (part == 4) ? SGF : SGB;
            const bool lat = u.pm < 64, gate = part != 3;
            float invf[8], lb1[8], lb2[8];
#pragma unroll
            for (int i = 0; i < 8; ++i) { invf[i] = __expf(-(float)(8 * fq + i) * 0.28782313662425574f); lb1[i] = 0.f; lb2[i] = 0.f; }
            if (gate) {
#pragma unroll
                for (int i = 0; i < 8; ++i) { const int c1 = cbase + i - 4096; lb1[i] = rcp_f(1.f + __expf(lbt[2048 + c1] - lbt[c1])); lb2[i] = rcp_f(1.f + __expf(lbt[2048 + c1 + 32] - lbt[c1 + 32])); } }
#pragma unroll
            for (int ai = 0; ai < 2; ++ai) {
                const float prow = (float)(((u.pm * 256 + ai * 128 + wr * 64) & 2047) >> 6);
#pragma unroll
                for (int m = 0; m < 4; ++m) {
                    const float pos = axis ? (float)(16 * m + fr) : prow;
                    const int row = row0 + ai * 128 + m * 16; bf16* rowp = PX + hm_row(sk, row, hh) + cc0; bf16* rowg = PX + hm_row(sg, row, hh) + cc0;
                    float x1[8], x2[8];
#pragma unroll
                    for (int i = 0; i < 8; ++i) { x1[i] = acc[ai][0][m][i >> 2][i & 3]; x2[i] = acc[ai][1][m][i >> 2][i & 3]; }
                    if (gate) {
                        float g1[8], g2[8];
#pragma unroll
                        for (int i = 0; i < 8; ++i) {
                            const float xa = fminf(fmaxf(x1[i], -30.f), 30.f), xb = fminf(fmaxf(x2[i], -30.f), 30.f);
                            const float sa = rcp_f(1.f + __expf(-xa)), sb = rcp_f(1.f + __expf(-xb));
                            g1[i] = __log2f(lb1[i] + (1.f - lb1[i]) * sa); g2[i] = __log2f(lb2[i] + (1.f - lb2[i]) * sb);
                            x1[i] = (1.f - lb1[i]) * (1.f - sa); x2[i] = (1.f - lb2[i]) * (1.f - sb); }
                        v4u w; w.x = pk2(g1[0], g1[1]); w.y = pk2(g1[2], g1[3]); w.z = pk2(g1[4], g1[5]); w.w = pk2(g1[6], g1[7]); *(v4u*)(rowg) = w;
                        w.x = pk2(g2[0], g2[1]); w.y = pk2(g2[2], g2[3]); w.z = pk2(g2[4], g2[5]); w.w = pk2(g2[6], g2[7]); *(v4u*)(rowg + 32) = w;
                    }
                    if (lat) {
#pragma unroll
                        for (int i = 0; i < 8; ++i) { const float a = pos * invf[i], cs = __cosf(a), sn = __sinf(a); const float o1 = x1[i] * cs - x2[i] * sn, o2 = x2[i] * cs + x1[i] * sn; x1[i] = o1; x2[i] = o2; } }
                    v4u w; w.x = pk2(x1[0], x1[1]); w.y = pk2(x1[2], x1[3]); w.z = pk2(x1[4], x1[5]); w.w = pk2(x1[6], x1[7]); *(v4u*)(rowp) = w;
                    w.x = pk2(x2[0], x2[1]); w.y = pk2(x2[2], x2[3]); w.z = pk2(x2[4], x2[5]); w.w = pk2(x2[6], x2[7]); *(v4u*)(rowp + 32) = w;
                    __builtin_amdgcn_sched_barrier(0);
                }
            }
        } else {
            const float sc = (part == 0) ? 0.08838834764831845f : 1.f;
            const int strm = (part == 6) ? SIH : part, cp = (u.pn & 3) * 256 + wc * 32 + 8 * fq;
#pragma unroll
            for (int ai = 0; ai < 2; ++ai)
#pragma unroll
                for (int m = 0; m < 4; ++m) { const int row = row0 + ai * 128 + m * 16;
#pragma unroll
                    for (int bj = 0; bj < 2; ++bj) { const f32x4 v0 = acc[ai][bj][m][0] * sc, v1 = acc[ai][bj][m][1] * sc;
                        v4u w; w.x = pk2(v0[0], v0[1]); w.y = pk2(v0[2], v0[3]); w.z = pk2(v1[0], v1[1]); w.w = pk2(v1[2], v1[3]);
                        const int cq = cp + bj * 128;
                        bf16* dst = (part == 7) ? PX + HM_GATE0 + (size_t)row * MIXG + cq : PX + hm_row(strm, row, cq >> 7) + (cq & 127);
                        *(v4u*)dst = w; } __builtin_amdgcn_sched_barrier(0); }
        }
    }
};

#define LDS_BAR() do { asm volatile("s_waitcnt lgkmcnt(0)" ::: "memory"); __builtin_amdgcn_s_barrier(); asm volatile("" ::: "memory"); } while (0)
#define MFMA16(a, b, c) __builtin_amdgcn_mfma_f32_16x16x32_bf16((a), (b), (c), 0, 0, 0)
struct GlaRegs { unsigned pq[8], pk[8], pg[8]; v4u pv[2]; };
__device__ __forceinline__ void gla_load(Frame& F, GlaRegs& R, int n, int b, int h, int dir) {
    const int lat = n >= 4, s0 = lat ? 64 * (n - 4) : 64 * n, sk = dir ? SKB : SKF, sg = dir ? SGB : SGF;
    const bf16* bq = F.PX + hm_lat(SQH, b, h) + 2 * F.lane;
    const bf16* bk = F.PX + (lat ? hm_lat(sk, b, h) : hm_ctx(sk, b, h)) + 2 * F.lane;
    const bf16* bg = F.PX + (lat ? hm_lat(sg, b, h) : hm_ctx(sg, b, h)) + 2 * F.lane;
    const bf16* bv = F.PX + (lat ? hm_lat(SIH, b, h) : hm_ctx(SIH, b, h));
#pragma unroll
    for (int i = 0; i < 8; ++i) { const int s = s0 + 8 * F.wave + i; const int tok = lat ? (dir ? 2047 - s : s) : (dir ? 255 - s : s);
        R.pq[i] = lat ? *(const unsigned*)(bq + (size_t)tok * HD) : 0u; R.pk[i] = *(const unsigned*)(bk + (size_t)tok * HD); R.pg[i] = *(const unsigned*)(bg + (size_t)tok * HD); }
#pragma unroll
    for (int j = 0; j < 2; ++j) { const int p = F.tid + 512 * j, Rr = p >> 4, ch = p & 15, s = s0 + Rr; const int tok = lat ? (dir ? 2047 - s : s) : (dir ? 255 - s : s);
        R.pv[j] = *(const v4u*)(bv + (size_t)tok * HD + ch * 8); }
}
__device__ __forceinline__ void gla_chunk(Frame& F, GlaRegs& R, f32x4 (&S)[8], int n, int b, int h, int dir, bf16* OUT) {
    const int lane = F.lane, wave = F.wave, tid = F.tid, kq = lane >> 4, fr = lane & 15;
    LAS unsigned char* L = F.lds;
    constexpr int PIT = 272;
    constexpr int O_QE = 0, O_QD = 17408, O_KD = 34816, O_V = 52224, O_KEX = 69632, O_ATT = 113152, O_SUB = 122368, O_DECL = 126464;
    const bool lat = n >= 4;
    const int s0 = lat ? 64 * (n - 4) : 64 * n;
#pragma unroll
    for (int j = 0; j < 2; ++j) { const int p = tid + 512 * j, Rr = p >> 4, ch = p & 15; *(LAS v4u*)(L + O_V + Rr * PIT + ch * 16) = R.pv[j]; }
    float qa[8], qb[8], ka[8], kb[8], ca[8], cb[8];
    float ra = 0.f, rb = 0.f;
#pragma unroll
    for (int i = 0; i < 8; ++i) { qa[i] = bflo(R.pq[i]); qb[i] = bfhi(R.pq[i]); ka[i] = bflo(R.pk[i]); kb[i] = bfhi(R.pk[i]); ra += bflo(R.pg[i]); rb += bfhi(R.pg[i]); ca[i] = ra; cb[i] = rb; }
    *(LAS f32x2*)(L + O_SUB + (wave * 128 + 2 * lane) * 4) = (f32x2){ra, rb};
    if (n + 2 < 36) gla_load(F, R, n + 2, b, h, dir);
    LDS_BAR();
    {
        float refa[4], refb[4], pa = 0.f, pb = 0.f, ta = 0.f, tb = 0.f;
#pragma unroll
        for (int w = 0; w < 8; ++w) { const f32x2 sv = *(const LAS f32x2*)(L + O_SUB + (w * 128 + 2 * lane) * 4);
            if ((w & 1) == 0) { refa[w >> 1] = ta; refb[w >> 1] = tb; }
            if (w < wave) { pa += sv.x; pb += sv.y; }
            ta += sv.x; tb += sv.y; }
        const int I = wave >> 1;
        float rIa = refa[0], rIb = refb[0];
#pragma unroll
        for (int q = 1; q < 4; ++q) if (I == q) { rIa = refa[q]; rIb = refb[q]; }
        const float eRa = __builtin_amdgcn_exp2f(rIa), eRb = __builtin_amdgcn_exp2f(rIb), eTa = __builtin_amdgcn_exp2f(ta - rIa), eTb = __builtin_amdgcn_exp2f(tb - rIb);
        float Rqa[4], Rqb[4];
#pragma unroll
        for (int q = 0; q < 4; ++q) { Rqa[q] = __builtin_amdgcn_exp2f(refa[q] - rIa); Rqb[q] = __builtin_amdgcn_exp2f(refb[q] - rIb); }
        const float da0 = pa - rIa, db0 = pb - rIb;
#pragma unroll
        for (int i = 0; i < 8; ++i) {
            const int Rr = 8 * wave + i;
            const float ea = __builtin_amdgcn_exp2f(da0 + ca[i]), eb = __builtin_amdgcn_exp2f(db0 + cb[i]);
            const float kra = ka[i] * __builtin_amdgcn_rcpf(ea), krb = kb[i] * __builtin_amdgcn_rcpf(eb);
            *(LAS unsigned*)(L + O_KD + Rr * PIT + 4 * lane) = pk2(kra * eTa, krb * eTb);
            if (lat) {
                const float qea = qa[i] * ea, qeb = qb[i] * eb;
                *(LAS unsigned*)(L + O_QE + Rr * PIT + 4 * lane) = pk2(qea, qeb);
                *(LAS unsigned*)(L + O_QD + Rr * PIT + 4 * lane) = pk2(qea * eRa, qeb * eRb);
#pragma unroll
                for (int Ip = 0; Ip < 4; ++Ip) if (Ip >= I) {
                    const int row = 16 * (Ip * (Ip + 1) / 2 + I) + (Rr & 15);
                    *(LAS unsigned*)(L + O_KEX + row * PIT + 4 * lane) = pk2(kra * Rqa[Ip], krb * Rqb[Ip]); }
            }
        }
        if (wave == 0) *(LAS f32x2*)(L + O_DECL + 8 * lane) = (f32x2){__builtin_amdgcn_exp2f(ta), __builtin_amdgcn_exp2f(tb)};
    }
    LDS_BAR();
    if (lat) {
        for (int tt = wave; tt < 10; tt += 8) {
            const int I = (tt >= 6) ? 3 : (tt >= 3) ? 2 : (tt >= 1) ? 1 : 0, J = tt - I * (I + 1) / 2;
            f32x4 X = (f32x4){0.f, 0.f, 0.f, 0.f};
#pragma unroll
            for (int ks = 0; ks < 4; ++ks) {
                const bf16x8 a = *(const LAS bf16x8*)(L + O_KEX + (16 * tt + fr) * PIT + ks * 64 + kq * 16);
                const bf16x8 bq = *(const LAS bf16x8*)(L + O_QE + (16 * I + fr) * PIT + ks * 64 + kq * 16);
                X = MFMA16(a, bq, X); }
            if (J == I) {
#pragma unroll
                for (int r = 0; r < 4; ++r) if (4 * kq + r > fr) X[r] = 0.f; }
            v2u o; o.x = pk2(X[0], X[1]); o.y = pk2(X[2], X[3]);
            *(LAS v2u*)(L + O_ATT + (16 * I + fr) * 144 + (16 * J + 4 * kq) * 2) = o;
        }
    }
    LDS_BAR();
    {
        const int q4 = fr >> 2, pp = fr & 3;
        bf16x8 Vf[2];
#pragma unroll
        for (int p = 0; p < 2; ++p) { const LAS unsigned char* vb = L + O_V + (32 * p + 8 * kq + q4) * PIT + (16 * wave + 4 * pp) * 2;
            Vf[p] = cat8(tr_read(vb), tr_read(vb + 4 * PIT)); }
        if (lat) {
            bf16x8 Sb[4];
#pragma unroll
            for (int ks = 0; ks < 4; ++ks) Sb[ks] = mk8(pk2(S[2 * ks][0], S[2 * ks][1]), pk2(S[2 * ks][2], S[2 * ks][3]), pk2(S[2 * ks + 1][0], S[2 * ks + 1][1]), pk2(S[2 * ks + 1][2], S[2 * ks + 1][3]));
#pragma unroll
            for (int I = 0; I < 4; ++I) {
                f32x4 o = (f32x4){0.f, 0.f, 0.f, 0.f};
#pragma unroll
                for (int p = 0; p < 2; ++p) if (p <= (I >> 1)) { const bf16x8 a = *(const LAS bf16x8*)(L + O_ATT + (16 * I + fr) * 144 + p * 64 + kq * 16); o = MFMA16(a, Vf[p], o); }
#pragma unroll
                for (int ks = 0; ks < 4; ++ks) { const LAS unsigned char* qp = L + O_QD + (16 * I + fr) * PIT + (32 * ks + 4 * kq) * 2;
                    const v2u lo = *(const LAS v2u*)qp, hi = *(const LAS v2u*)(qp + 32);
                    o = MFMA16(mk8(lo.x, lo.y, hi.x, hi.y), Sb[ks], o); }
#pragma unroll
                for (int j = 0; j < 2; ++j) {
                    const bool oddl = fr & 1;
                    const float snd = oddl ? o[j] : o[2 + j], own = oddl ? o[2 + j] : o[j];
                    const float rcv = __int_as_float(__builtin_amdgcn_mov_dpp(__float_as_int(snd), 0xB1, 0xf, 0xf, true));
                    const int s = s0 + 16 * I + 4 * kq + (oddl ? 2 : 0) + j, tok = dir ? 2047 - s : s;
                    *(unsigned*)(OUT + (size_t)(b * SEQ + tok) * MIXG + h * HD + 16 * wave + (fr & ~1)) = oddl ? pk2(rcv, own) : pk2(own, rcv); }
            }
        }
#pragma unroll
        for (int dkb = 0; dkb < 8; ++dkb) {
            const f32x4 dec = *(const LAS f32x4*)(L + O_DECL + (16 * dkb + 4 * kq) * 4);
            f32x4 s = S[dkb] * dec;
#pragma unroll
            for (int p = 0; p < 2; ++p) { const LAS unsigned char* kb_ = L + O_KD + (32 * p + 8 * kq + q4) * PIT + (16 * dkb + 4 * pp) * 2;
                s = MFMA16(cat8(tr_read(kb_), tr_read(kb_ + 4 * PIT)), Vf[p], s); }
            S[dkb] = s;
        }
    }
    LDS_BAR();
}
__device__ __forceinline__ void gla_chain(Frame& F, int chain) {
    const int b = chain >> 4, h = (chain >> 1) & 7, dir = chain & 1;
    for (int i = F.tid; i < 9216 / 4; i += 512) ((LAS unsigned*)(F.lds + 113152))[i] = 0u;
    f32x4 S[8];
#pragma unroll
    for (int i = 0; i < 8; ++i) S[i] = (f32x4){0.f, 0.f, 0.f, 0.f};
    bf16* OUT = dir ? F.OB : F.OF;
    GlaRegs R0, R1;
    gla_load(F, R0, 0, b, h, dir); gla_load(F, R1, 1, b, h, dir);
    for (int n = 0; n < 36; n += 2) { gla_chunk(F, R0, S, n, b, h, dir, OUT); gla_chunk(F, R1, S, n + 1, b, h, dir, OUT); }
}

__device__ __forceinline__ void attn_run(Frame& F, int ubase, int ustride, int ucnt) {
    const int lane = F.lane, wave = F.wave, tid = F.tid, kq = lane >> 4, fr = lane & 15, j = wave & 3, role = wave >> 2;
    LAS unsigned char* L = F.lds;
    constexpr int PIT = 272;
    constexpr int PITV = 288;
    constexpr int O_KW = 0, O_VW = 34816, O_KC = 71680, O_VC = 89088, O_RPB = 107520, O_MG = 0;
    const int kc0 = min(max(16 * j - 8, 0), 32), qcol = 16 * j + fr, cs = min(max(qcol - 8, 0), 48);
    const int q4 = fr >> 2, pp = fr & 3;
    unsigned inmask = 0u; const int dbase = kc0 + 4 * kq - qcol + 15;
#pragma unroll
    for (int e = 0; e < 8; ++e) { const int kc = kc0 + 16 * (e >> 2) + 4 * kq + (e & 3); inmask |= ((kc >= cs) && (kc < cs + 16)) ? (1u << e) : 0u; }
    v4u st[1][8], sc4[4];
    const unsigned tb = (unsigned)(((tid >> 4) * HD + (tid & 15) * 8) * 2);
#define ATT_LD16(basep_) (*(const v4u*)((const char*)(basep_) + tb))
#define ATT_LOAD(set_, u_, s_) do { const int b_ = (u_) >> 8, h_ = ((u_) >> 5) & 7, r_ = (u_) & 31, k0_ = min(max(r_ - 4, 0), 24); \
        const bf16* kb_ = F.PX + hm_lat(SKN, b_, h_) + (size_t)((k0_ + 2 * (s_)) * 64) * HD; const bf16* vb_ = F.PX + hm_lat(SVN, b_, h_) + (size_t)((k0_ + 2 * (s_)) * 64) * HD; \
        _Pragma("unroll") for (int m = 0; m < 4; ++m) { st[set_][m] = ATT_LD16(kb_ + 32 * m * HD); st[set_][4 + m] = ATT_LD16(vb_ + 32 * m * HD); } } while (0)
#define ATT_LOADC(u_, s_) do { const int b_ = (u_) >> 8, h_ = ((u_) >> 5) & 7; \
        const bf16* kc_ = F.PX + hm_ctx(SKN, b_, h_) + (size_t)(64 * (s_)) * HD; const bf16* vc_ = F.PX + hm_ctx(SVN, b_, h_) + (size_t)(64 * (s_)) * HD; \
        _Pragma("unroll") for (int m = 0; m < 2; ++m) { sc4[m] = ATT_LD16(kc_ + 32 * m * HD); sc4[2 + m] = ATT_LD16(vc_ + 32 * m * HD); } } while (0)
#define ATT_QLOAD(dst_, u_) do { const int b_ = (u_) >> 8, h_ = ((u_) >> 5) & 7, r_ = (u_) & 31; const bf16* qp = F.PX + hm_lat(SQN, b_, h_) + (size_t)(r_ * 64 + qcol) * HD + 8 * kq; \
        _Pragma("unroll") for (int ks = 0; ks < 4; ++ks) dst_[ks] = *(const bf16x8*)(qp + 32 * ks); } while (0)
    if (ucnt <= 0) return;
    const int u0 = ubase;
    ATT_LOAD(0, u0, 0); ATT_LOADC(u0, 0);
    bf16x8 qf[4];
    ATT_QLOAD(qf, u0);
    int hcur = -1;
    for (int ui = 0; ui < ucnt; ++ui) {
        const int u = ubase + ui * ustride, un = u + ustride; const bool more = ui + 1 < ucnt;
        const int b = u >> 8, h = (u >> 5) & 7, r = u & 31, kr0 = min(max(r - 4, 0), 24);
        if (h != hcur) { LDS_BAR(); for (int i = tid; i < 465; i += 512) ((LAS float*)(L + O_RPB))[i] = F.rpb[h * 465 + i]; hcur = h; }
        f32x4 O[8];
#pragma unroll
        for (int i = 0; i < 8; ++i) O[i] = (f32x4){0.f, 0.f, 0.f, 0.f};
        float mrun = -1e30f, lrun = 0.f;
#pragma unroll
        for (int s = 0; s < 4; ++s) {
            LDS_BAR();
#pragma unroll
            for (int m = 0; m < 8; ++m) { const int p = tid + 512 * (m & 3), R = p >> 4, ch = p & 15; *(LAS v4u*)(L + ((m < 4) ? O_KW + R * PIT : O_VW + R * PITV) + ch * 16) = st[0][m]; }
#pragma unroll
            for (int m = 0; m < 4; ++m) { const int p = tid + 512 * (m & 1), R = p >> 4, ch = p & 15; *(LAS v4u*)(L + ((m < 2) ? O_KC + R * PIT : O_VC + R * PITV) + ch * 16) = sc4[m]; }
            if (s < 3) ATT_LOAD(0, u, s + 1); else if (more) ATT_LOAD(0, un, 0);
            if (s < 3) ATT_LOADC(u, s + 1); else if (more) ATT_LOADC(un, 0);
            LDS_BAR();
            const LAS unsigned char* Kt = L + (role ? O_KC : O_KW);
            const LAS unsigned char* Vt = L + (role ? O_VC : O_VW);
            const int kb0 = role ? 0 : kc0, kb1 = role ? 32 : 64 + kc0;
            f32x4 sc[2][2];
#pragma unroll
            for (int g = 0; g < 2; ++g)
#pragma unroll
                for (int cb = 0; cb < 2; ++cb) { f32x4 a = (f32x4){0.f, 0.f, 0.f, 0.f};
#pragma unroll
                    for (int ks = 0; ks < 4; ++ks) a = MFMA16(*(const LAS bf16x8*)(Kt + ((g ? kb1 : kb0) + 16 * cb + fr) * PIT + ks * 64 + kq * 16), qf[ks], a);
                    sc[g][cb] = a; }
            if (s == 3 && more) { asm volatile("" ::: "memory"); ATT_QLOAD(qf, un); }
            if (role == 0) {
#pragma unroll
                for (int g = 0; g < 2; ++g) { const int drow = (kr0 + 2 * s + g) - r + 7; float bias[8];
#pragma unroll
                    for (int e = 0; e < 8; ++e) bias[e] = ((const LAS float*)(L + O_RPB))[drow * 31 + min(max(dbase + 16 * (e >> 2) + (e & 3), 0), 30)];
#pragma unroll
                    for (int e = 0; e < 8; ++e) { asm volatile("" : "+v"(bias[e])); const float v = sc[g][e >> 2][e & 3] + bias[e]; sc[g][e >> 2][e & 3] = ((inmask >> e) & 1u) ? v : -1e30f; } }
            }
            float mx = -1e30f;
#pragma unroll
            for (int g = 0; g < 2; ++g)
#pragma unroll
                for (int e = 0; e < 8; ++e) mx = fmaxf(mx, sc[g][e >> 2][e & 3]);
            mx = fmaxf(mx, __shfl_xor(mx, 16)); mx = fmaxf(mx, __shfl_xor(mx, 32));
            const float mnew = (mx > mrun + 6.f) ? mx : mrun, alpha = __expf(mrun - mnew);
            const bool resc = __any(mnew != mrun);
            float p[2][8], ps = 0.f;
#pragma unroll
            for (int g = 0; g < 2; ++g)
#pragma unroll
                for (int e = 0; e < 8; ++e) { p[g][e] = __expf(sc[g][e >> 2][e & 3] - mnew); ps += p[g][e]; }
            lrun = lrun * alpha + ps; mrun = mnew;
            bf16x8 pf[2];
#pragma unroll
            for (int g = 0; g < 2; ++g) pf[g] = mk8(pk2(p[g][0], p[g][1]), pk2(p[g][2], p[g][3]), pk2(p[g][4], p[g][5]), pk2(p[g][6], p[g][7]));
            if (resc) {
#pragma unroll
                for (int dvb = 0; dvb < 8; ++dvb) O[dvb] = O[dvb] * alpha; }
#pragma unroll
            for (int dvb = 0; dvb < 8; ++dvb) { f32x4 o = O[dvb];
#pragma unroll
                for (int g = 0; g < 2; ++g) { const LAS unsigned char* vb = Vt + ((g ? kb1 : kb0) + 4 * kq + q4) * PITV + (16 * dvb + 4 * pp) * 2;
                    o = MFMA16(cat8(tr_read(vb), tr_read(vb + 16 * PITV)), pf[g], o); }
                O[dvb] = o; }
        }
        lrun += __shfl_xor(lrun, 16); lrun += __shfl_xor(lrun, 32);
        LDS_BAR();
        if (role == 1) {
            LAS float* mg = (LAS float*)(L + O_MG + j * 8704);
#pragma unroll
            for (int dvb = 0; dvb < 8; ++dvb)
#pragma unroll
                for (int q = 0; q < 4; ++q) mg[(dvb * 4 + q) * 64 + lane] = O[dvb][q];
            mg[2048 + lane] = mrun; mg[2048 + 64 + lane] = lrun;
        }
        LDS_BAR();
        if (role == 0) {
            const LAS float* mg = (const LAS float*)(L + O_MG + j * 8704);
            const float m2 = mg[2048 + lane], l2 = mg[2048 + 64 + lane];
            const float m = fmaxf(mrun, m2), a1 = __expf(mrun - m), a2 = __expf(m2 - m), inv = rcp_f(lrun * a1 + l2 * a2);
            u8* op = (u8*)F.A2 + (size_t)(b * SEQ + r * 64 + qcol) * D + h * HD + 4 * kq;
#pragma unroll
            for (int dvb = 0; dvb < 8; ++dvb) { float o[4];
#pragma unroll
                for (int q = 0; q < 4; ++q) o[q] = (O[dvb][q] * a1 + mg[(dvb * 4 + q) * 64 + lane] * a2) * inv;
                *(unsigned*)(op + 16 * dvb) = pk4_fp8(o[0] * SA8, o[1] * SA8, o[2] * SA8, o[3] * SA8); }
        }
    }
#undef ATT_LOAD
#undef ATT_LOADC
#undef ATT_LD16
#undef ATT_QLOAD
}
__device__ __forceinline__ void p3_mixer(Frame& F) {
    for (int ch = (int)blockIdx.x; ch < 128; ch += F.G) { gla_chain(F, ch); }
    for (;;) {
        __syncthreads();
        if (F.tid == 0) F.MISC[0] = __hip_atomic_fetch_add((unsigned*)(F.ctl + CW_ATTQ), 1u, RLX_AGENT);
        __syncthreads();
        const int c = (int)F.MISC[0];
        if (c >= NB * HEADS * 32 / 4) break;
        attn_run(F, 4 * c, 1, 4);
    }
}

__device__ __forceinline__ void p4_hg_out(Frame& F) {
    const int gw = F.vcu * NWAVES + F.wave, NGW = F.G * NWAVES, lane = F.lane;
    for (int t = gw; t < T; t += NGW) {
        const v4u* pf = (const v4u*)(F.OF + (size_t)t * MIXG + 16 * lane); const v4u* pb = (const v4u*)(F.OB + (size_t)t * MIXG + 16 * lane);
        const v4u f0 = pf[0], f1 = pf[1], b0 = pb[0], b1 = pb[1];
        const unsigned fu[8] = {f0.x, f0.y, f0.z, f0.w, f1.x, f1.y, f1.z, f1.w}, bu[8] = {b0.x, b0.y, b0.z, b0.w, b1.x, b1.y, b1.z, b1.w};
        f32x4 o[4]; float ss = 0.f;
#pragma unroll
        for (int i = 0; i < 4; ++i) { o[i] = (f32x4){bflo(fu[2 * i]) + bflo(bu[2 * i]), bfhi(fu[2 * i]) + bfhi(bu[2 * i]), bflo(fu[2 * i + 1]) + bflo(bu[2 * i + 1]), bfhi(fu[2 * i + 1]) + bfhi(bu[2 * i + 1])};
            ss += (o[i].x * o[i].x + o[i].y * o[i].y) + (o[i].z * o[i].z + o[i].w * o[i].w); }
        ss += __shfl_xor(ss, 1); ss += __shfl_xor(ss, 2); ss += __shfl_xor(ss, 4);
        const float rstd = rsqrtf(ss * (1.f / HD) + EPS);
        const v4u* gp = (const v4u*)(F.PX + HM_GATE0 + (size_t)t * MIXG + 16 * lane);
        const v4u g0 = gp[0], g1 = gp[1];
        const unsigned gu[8] = {g0.x, g0.y, g0.z, g0.w, g1.x, g1.y, g1.z, g1.w};
        const f32x4* hp = (const f32x4*)(F.hg_norm + ((16 * lane) & 127));
        unsigned ow[4];
#pragma unroll
        for (int i = 0; i < 4; ++i) { const f32x4 gn = hp[i]; const f32x4 y = o[i] * rstd * gn;
            const float ga = bflo(gu[2 * i]), gb = bfhi(gu[2 * i]), gc = bflo(gu[2 * i + 1]), gd = bfhi(gu[2 * i + 1]);
            ow[i] = pk4_fp8(y.x * silu_f(ga) * SA8, y.y * silu_f(gb) * SA8, y.z * silu_f(gc) * SA8, y.w * silu_f(gd) * SA8); }
        *(v4u*)((u8*)F.A2 + (size_t)t * D + MIXG + 16 * lane) = (v4u){ow[0], ow[1], ow[2], ow[3]};
    }
}

struct EpiOutProj {
    static constexpr bool PERM = true, AFTER_DRAIN = false;
    const float* x; bf16* X1; const float* modf; float ascale;
    __device__ __forceinline__ void operator()(const f32x4 (&acc)[2][2][4][2], const pg8::Unit& u, int wr, int wc, int fr, int fq) const {
        const int row0 = u.pm * 256 + wr * 64 + fr, col0 = u.pn * 256 + wc * 32 + 8 * fq;
        const float* g1 = modf + (size_t)(u.pm >> 3) * (6 * D) + 2 * D;
        f32x4 gv[2][2];
#pragma unroll
        for (int bj = 0; bj < 2; ++bj)
#pragma unroll
            for (int n = 0; n < 2; ++n) gv[bj][n] = *(const f32x4*)(g1 + col0 + bj * 128 + n * 4) * ascale;
#pragma unroll
        for (int ai = 0; ai < 2; ++ai)
#pragma unroll
            for (int m = 0; m < 4; ++m) { const size_t ro = (size_t)(row0 + ai * 128 + m * 16) * D + col0;
#pragma unroll
                for (int bj = 0; bj < 2; ++bj) { const f32x4 x0 = *(const f32x4*)(x + ro + bj * 128), x1 = *(const f32x4*)(x + ro + bj * 128 + 4);
                    const f32x4 v0 = x0 + gv[bj][0] * acc[ai][bj][m][0], v1 = x1 + gv[bj][1] * acc[ai][bj][m][1];
                    v4u w; w.x = pk2(v0[0], v0[1]); w.y = pk2(v0[2], v0[3]); w.z = pk2(v1[0], v1[1]); w.w = pk2(v1[2], v1[3]);
                    *(v4u*)(X1 + ro + bj * 128) = w; } __builtin_amdgcn_sched_barrier(0); }
    }
};

__device__ __forceinline__ void p6_router(Frame& F) {
    const int lane = F.lane, wave = F.wave, tid = F.tid, kq = lane >> 4, fr = lane & 15, g = wave & 3, kh = wave >> 2;
    LAS unsigned char* L = F.lds;
    constexpr int O_SSQ = 16384, O_LG = 16384 + 512, O_HIST = O_LG + 2 * 64 * 33 * 4, O_BASE = O_HIST + 128, O_SLOT = O_BASE + 128;
    for (int blk = F.vcu; blk < 256; blk += F.G) {
        const int bb = blk >> 5;
        p1_build_vec(F, bb, 3 * D, 4 * D, F.norm_ffn, false);
        if (tid < 32) ((LAS unsigned*)(L + O_HIST))[tid] = 0u;
        const int row = blk * 64 + g * 16 + fr;
        const bf16* xr = F.X1 + (size_t)row * D + kh * 1024 + 32 * kq;
        float ss = 0.f;
#pragma unroll 8
        for (int s = 0; s < 32; ++s) { const v4u xw = *(const v4u*)(xr + 128 * (s >> 2) + 8 * (s & 3)); const f32x4 a = (f32x4){bflo(xw.x), bfhi(xw.x), bflo(xw.y), bfhi(xw.y)}, c = (f32x4){bflo(xw.z), bfhi(xw.z), bflo(xw.w), bfhi(xw.w)};
            ss += (a.x * a.x + a.y * a.y) + (a.z * a.z + a.w * a.w) + (c.x * c.x + c.y * c.y) + (c.z * c.z + c.w * c.w); }
        ss += __shfl_xor(ss, 16); ss += __shfl_xor(ss, 32);
        if (kq == 0) ((LAS float*)(L + O_SSQ))[kh * 64 + g * 16 + fr] = ss;
        __syncthreads();
        const float rstd = rsqrtf((((LAS float*)(L + O_SSQ))[g * 16 + fr] + ((LAS float*)(L + O_SSQ))[64 + g * 16 + fr]) * (1.f / D) + EPS);
        f32x4 lg0 = (f32x4){0.f, 0.f, 0.f, 0.f}, lg1 = lg0;
        const LAS float* Av = (const LAS float*)L; const LAS float* Bv = Av + D;
        const bf16* wh = F.WRT + (size_t)fr * D + kh * 1024 + 32 * kq;
        u8* hrow = F.HX2 + (size_t)row * D + kh * 1024 + 16 * kq;
#pragma unroll 1
        for (int s = 0; s < 8; ++s) {
            float hv[32];
#pragma unroll
            for (int j = 0; j < 4; ++j) {
                const int k = kh * 1024 + 128 * s + 32 * kq + 8 * j;
                const v4u xw = *(const v4u*)(xr + 128 * s + 8 * j); const f32x4 a = (f32x4){bflo(xw.x), bfhi(xw.x), bflo(xw.y), bfhi(xw.y)}, c = (f32x4){bflo(xw.z), bfhi(xw.z), bflo(xw.w), bfhi(xw.w)};
                const f32x4 A0 = *(const LAS f32x4*)(Av + k), A1 = *(const LAS f32x4*)(Av + k + 4), B0 = *(const LAS f32x4*)(Bv + k), B1 = *(const LAS f32x4*)(Bv + k + 4);
                const f32x4 h0 = a * rstd * A0 + B0, h1 = c * rstd * A1 + B1;
                hv[8 * j] = h0.x; hv[8 * j + 1] = h0.y; hv[8 * j + 2] = h0.z; hv[8 * j + 3] = h0.w; hv[8 * j + 4] = h1.x; hv[8 * j + 5] = h1.y; hv[8 * j + 6] = h1.z; hv[8 * j + 7] = h1.w;
                const unsigned u0 = pk2(h0.x, h0.y), u1 = pk2(h0.z, h0.w), u2 = pk2(h1.x, h1.y), u3 = pk2(h1.z, h1.w);
                const unsigned l0 = pk2(h0.x - bflo(u0), h0.y - bfhi(u0)), l1 = pk2(h0.z - bflo(u1), h0.w - bfhi(u1)), l2 = pk2(h1.x - bflo(u2), h1.y - bfhi(u2)), l3 = pk2(h1.z - bflo(u3), h1.w - bfhi(u3));
                const bf16x8 hh = mk8(u0, u1, u2, u3), hl = mk8(l0, l1, l2, l3);
                const bf16x8 w0h = *(const bf16x8*)(wh + 128 * s + 8 * j), w1h = *(const bf16x8*)(wh + 16 * D + 128 * s + 8 * j);
                const bf16x8 w0l = *(const bf16x8*)(wh + NE * D + 128 * s + 8 * j), w1l = *(const bf16x8*)(wh + NE * D + 16 * D + 128 * s + 8 * j);
                lg0 = MFMA16(hh, w0h, lg0); lg0 = MFMA16(hh, w0l, lg0); lg0 = MFMA16(hl, w0h, lg0);
                lg1 = MFMA16(hh, w1h, lg1); lg1 = MFMA16(hh, w1l, lg1); lg1 = MFMA16(hl, w1h, lg1);
            }
            v6u p; unsigned eb; mx6_pack(hv, p, eb);
            *(v4u*)(hrow + 128 * s) = (v4u){p[0], p[1], p[2], p[3]}; *(v4u*)(hrow + 128 * s + 64) = (v4u){p[4], p[5], eb, 0u};
        }
        { LAS float* lg = (LAS float*)(L + O_LG) + kh * 64 * 33;
#pragma unroll
          for (int r = 0; r < 4; ++r) { lg[(g * 16 + 4 * kq + r) * 33 + fr] = lg0[r]; lg[(g * 16 + 4 * kq + r) * 33 + 16 + fr] = lg1[r]; } }
        __syncthreads();
        int e4[4] = {0, 0, 0, 0}; int pl4[4] = {0, 0, 0, 0};
        if (tid < 64) {
            LAS float* lg = (LAS float*)(L + O_LG) + tid * 33;
            for (int e = 0; e < 32; ++e) lg[e] = lg[e] + lg[64 * 33 + e] + F.b_router[e];
            float v4[4];
#pragma unroll
            for (int p = 0; p < 4; ++p) { float best = -3.0e38f; int bi = 0;
                for (int e = 0; e < 32; ++e) { const float v = lg[e]; const bool used = (p > 0 && e == e4[0]) || (p > 1 && e == e4[1]) || (p > 2 && e == e4[2]); if (!used && v > best) { best = v; bi = e; } }
                e4[p] = bi; v4[p] = best; }
            const float e1 = __expf(v4[1] - v4[0]), e2 = __expf(v4[2] - v4[0]), e3 = __expf(v4[3] - v4[0]), inv = 1.f / (1.f + e1 + e2 + e3);
            const int t = blk * 64 + tid;
            *(f32x4*)(F.RT_G + (size_t)t * 4) = (f32x4){inv, e1 * inv, e2 * inv, e3 * inv};
            *(int4*)(F.RT_E + (size_t)t * 4) = make_int4(e4[0], e4[1], e4[2], e4[3]);
#pragma unroll
            for (int p = 0; p < 4; ++p) pl4[p] = (int)__hip_atomic_fetch_add((LAS unsigned*)(L + O_HIST) + e4[p], 1u, __ATOMIC_RELAXED, __HIP_MEMORY_SCOPE_WORKGROUP);
        }
        __syncthreads();
        if (tid < 32) { const unsigned c = ((LAS unsigned*)(L + O_HIST))[tid]; ((LAS unsigned*)(L + O_BASE))[tid] = c ? __hip_atomic_fetch_add((unsigned*)(F.ctl + CW_CNT + 64 * tid), c, RLX_AGENT) : 0u; }
        __syncthreads();
        if (tid < 64) { const int t = blk * 64 + tid; const LAS unsigned* base = (const LAS unsigned*)(L + O_BASE);
            const int4 ps = make_int4((int)base[e4[0]] + pl4[0], (int)base[e4[1]] + pl4[1], (int)base[e4[2]] + pl4[2], (int)base[e4[3]] + pl4[3]);
            *(int4*)(F.RT_POS + (size_t)t * 4) = ps;
            LAS int* sl = (LAS int*)(L + O_SLOT) + tid * 4;
            sl[0] = e4[0] * T + ps.x; sl[1] = e4[1] * T + ps.y; sl[2] = e4[2] * T + ps.z; sl[3] = e4[3] * T + ps.w; }
        __syncthreads();
        for (int a0 = wave; a0 < 256; a0 += 4 * NWAVES) {
            v4u rv[4][2];
#pragma unroll
            for (int q = 0; q < 4; ++q) { const int a = a0 + q * NWAVES, t = blk * 64 + (a >> 2); const v4u* src = (const v4u*)(F.HX2 + (size_t)t * D) + lane; rv[q][0] = src[0]; rv[q][1] = src[64]; }
#pragma unroll
            for (int q = 0; q < 4; ++q) { const int a = a0 + q * NWAVES, slot = ((const LAS int*)(L + O_SLOT))[a]; v4u* dst = (v4u*)(F.XG + (size_t)slot * D) + lane; dst[0] = rv[q][0]; dst[64] = rv[q][1]; }
        }
        __syncthreads();
    }
}

__device__ __forceinline__ int moe_tables(Frame& F) {
    LAS unsigned char* tile_e = F.lds + TILE_OFF; LAS int* offt = (LAS int*)(F.lds + OFFT_OFF);
    if (F.tid < 32) { int off = 0, mine = 0;
        for (int e = 0; e < 32; ++e) { const int c = (int)__hip_atomic_load((unsigned*)(F.ctl + CW_CNT + 64 * e), RLX_AGENT); const int nt = (c + 255) >> 8; if (e < F.tid) off += nt; if (e == F.tid) mine = nt; }
        offt[F.tid] = off; for (int t = 0; t < mine; ++t) tile_e[off + t] = (unsigned char)F.tid;
        if (F.tid == 31) offt[32] = off + mine; }
    __syncthreads();
    return offt[32];
}
#ifndef MOE_NB
#define MOE_NB 2
#endif
struct MoeOrder {
    static constexpr bool SPARSE_A = true;
    int nM, nN, nwg, G, c; const LAS unsigned char* tile_e; const LAS int* offt; bool sparse;
    __device__ void init(int nM_, int nN_, int G_, int c_, const LAS unsigned char* te, const LAS int* ot, bool sp) { nM = nM_; nN = nN_; nwg = nM * nN; G = G_; c = c_; tile_e = te; offt = ot; sparse = sp; }
    __device__ bool next(int i, pg8::Unit& u) const {
        const long Lq = (long)i * G + c; if (Lq >= nwg) return false;
        int wgid = (int)Lq; { const int q = nwg / 8, r = nwg % 8, xcd = wgid % 8, off = wgid / 8; wgid = (xcd < r ? xcd * (q + 1) : r * (q + 1) + (xcd - r) * q) + off; }
        const int e = __builtin_amdgcn_readfirstlane((int)tile_e[wgid / nN]);
        const int t0 = __builtin_amdgcn_readfirstlane(offt[e]), nt = __builtin_amdgcn_readfirstlane(offt[e + 1]) - t0, r = wgid - t0 * nN, blk = nt * MOE_NB, q = r / blk, r2 = r - q * blk;
        u.pm = t0 + r2 % nt; u.pn = e * nN + MOE_NB * q + r2 / nt;
        u.pa = sparse ? e * (T / 256) + (u.pm - t0) : u.pm; return true;
    }
    __device__ __forceinline__ void a_ready(const pg8::Unit&) const {}
    __device__ __forceinline__ void done(const pg8::Unit&) const {}
};
struct EpiSwiglu {
    static constexpr bool PERM = true, AFTER_DRAIN = false;
    u8* H; const float* b_gu;
    __device__ __forceinline__ void operator()(const f32x4 (&acc)[2][2][4][2], const pg8::Unit& u, int wr, int wc, int fr, int fq) const {
        const int e = u.pn >> 4, pl = u.pn & 15, row0 = u.pm * 256 + wr * 64 + fr, ccol = pl * 128 + wc * 32 + 8 * fq;
        const float* bg = b_gu + (size_t)e * 4096 + ccol;
        const f32x4 bg0 = *(const f32x4*)bg, bg1 = *(const f32x4*)(bg + 4), bl0 = *(const f32x4*)(bg + 2048), bl1 = *(const f32x4*)(bg + 2052);
#pragma unroll
        for (int ai = 0; ai < 2; ++ai)
#pragma unroll
            for (int m = 0; m < 4; ++m) { float y[8];
#pragma unroll
                for (int i = 0; i < 8; ++i) { const float gl = acc[ai][0][m][i >> 2][i & 3] + ((i < 4) ? bg0[i & 3] : bg1[i & 3]); const float ln = acc[ai][1][m][i >> 2][i & 3] + ((i < 4) ? bl0[i & 3] : bl1[i & 3]);
                    const float xg = fminf(gl, 7.f), xl = fminf(fmaxf(ln, -7.f), 7.f); y[i] = xg * rcp_f(1.f + __builtin_amdgcn_exp2f(-2.4554669595930156f * xg)) * (xl * SH8 + SH8); }
                v2u w; w.x = pk4_fp8_nc(y[0], y[1], y[2], y[3]); w.y = pk4_fp8_nc(y[4], y[5], y[6], y[7]);
                *(v2u*)(H + (size_t)(row0 + ai * 128 + m * 16) * FF + ccol) = w; __builtin_amdgcn_sched_barrier(0); }
    }
};
struct EpiDown {
    static constexpr bool PERM = true, AFTER_DRAIN = false;
    u8* Y; const float* b_down;
    __device__ __forceinline__ void operator()(const f32x4 (&acc)[2][2][4][2], const pg8::Unit& u, int wr, int wc, int fr, int fq) const {
        const int e = u.pn >> 3, pl = u.pn & 7, row0 = u.pm * 256 + wr * 64 + fr, col0 = pl * 256 + wc * 32 + 8 * fq;
        f32x4 bv[2][2];
#pragma unroll
        for (int bj = 0; bj < 2; ++bj)
#pragma unroll
            for (int n = 0; n < 2; ++n) bv[bj][n] = *(const f32x4*)(b_down + (size_t)e * D + col0 + bj * 128 + 4 * n);
#pragma unroll
        for (int ai = 0; ai < 2; ++ai)
#pragma unroll
            for (int m = 0; m < 4; ++m) { u8* rowp = Y + (size_t)(row0 + ai * 128 + m * 16) * D + col0;
#pragma unroll
                for (int bj = 0; bj < 2; ++bj) { const f32x4 v0 = (acc[ai][bj][m][0] * (1.f / (SH8 * SW8)) + bv[bj][0]) * SY8, v1 = (acc[ai][bj][m][1] * (1.f / (SH8 * SW8)) + bv[bj][1]) * SY8;
                    v2u w; w.x = pk4_fp8(v0[0], v0[1], v0[2], v0[3]); w.y = pk4_fp8(v1[0], v1[1], v1[2], v1[3]);
                    *(v2u*)(rowp + bj * 128) = w; } __builtin_amdgcn_sched_barrier(0); }
    }
};
__device__ __forceinline__ void p10_final(Frame& F, float oscale) {
    const int lane = (int)__builtin_amdgcn_mbcnt_hi(~0u, __builtin_amdgcn_mbcnt_lo(~0u, 0u));
    const int gw = F.vcu * NWAVES + F.wave, NGW = F.G * NWAVES;
    (void)moe_tables(F);
    const LAS int* offt = (const LAS int*)(F.lds + OFFT_OFF);
    for (int t = gw; t < T; t += NGW) {
        const int4 ee = *(const int4*)(F.RT_E + (size_t)t * 4), pp = *(const int4*)(F.RT_POS + (size_t)t * 4);
        const int4 sl = make_int4(offt[ee.x] * 256 + pp.x, offt[ee.y] * 256 + pp.y, offt[ee.z] * 256 + pp.z, offt[ee.w] * 256 + pp.w); const f32x4 gt = *(const f32x4*)(F.RT_G + (size_t)t * 4);
        const float* g2 = F.MODF + (size_t)(t >> 11) * (6 * D) + 5 * D;
        const v2u* xr = (const v2u*)(F.X1 + (size_t)t * D) + lane;
        const unsigned* y0 = (const unsigned*)(F.Y + (size_t)sl.x * D) + lane; const unsigned* y1 = (const unsigned*)(F.Y + (size_t)sl.y * D) + lane;
        const unsigned* y2 = (const unsigned*)(F.Y + (size_t)sl.z * D) + lane; const unsigned* y3 = (const unsigned*)(F.Y + (size_t)sl.w * D) + lane;
        const f32x4 gs = gt * (1.f / SY8);
        f32x4 v[8]; float ss = 0.f;
#pragma unroll
        for (int j = 0; j < 8; ++j) { const unsigned a = y0[64 * j], b = y1[64 * j], c = y2[64 * j], d = y3[64 * j];
            const f32x2 al = __builtin_amdgcn_cvt_pk_f32_fp8(a, false), ah = __builtin_amdgcn_cvt_pk_f32_fp8(a, true), bl = __builtin_amdgcn_cvt_pk_f32_fp8(b, false), bh = __builtin_amdgcn_cvt_pk_f32_fp8(b, true);
            const f32x2 cl = __builtin_amdgcn_cvt_pk_f32_fp8(c, false), ch = __builtin_amdgcn_cvt_pk_f32_fp8(c, true), dl = __builtin_amdgcn_cvt_pk_f32_fp8(d, false), dh = __builtin_amdgcn_cvt_pk_f32_fp8(d, true);
            f32x4 m;
            m.x = gs.x * al.x + gs.y * bl.x + gs.z * cl.x + gs.w * dl.x;
            m.y = gs.x * al.y + gs.y * bl.y + gs.z * cl.y + gs.w * dl.y;
            m.z = gs.x * ah.x + gs.y * bh.x + gs.z * ch.x + gs.w * dh.x;
            m.w = gs.x * ah.y + gs.y * bh.y + gs.z * ch.y + gs.w * dh.y;
            const f32x4 gg = *((const f32x4*)g2 + lane + 64 * j);
            const v2u xw = xr[64 * j]; const f32x4 xv = (f32x4){bflo(xw.x), bfhi(xw.x), bflo(xw.y), bfhi(xw.y)};
            v[j] = xv + gg * m; ss += (v[j].x * v[j].x + v[j].y * v[j].y) + (v[j].z * v[j].z + v[j].w * v[j].w); }
        const float rstd = rsqrtf(wave_sum(ss) * (1.f / D) + EPS) * oscale;
        f32x4* op = (f32x4*)(F.out + (size_t)t * D) + lane;
#pragma unroll
        for (int j = 0; j < 8; ++j) op[64 * j] = v[j] * rstd * *((const f32x4*)F.norm_final + lane + 64 * j);
    }
}

struct Args { const float* in[20]; float* out; unsigned char* ws; int ph_lo, ph_hi, li, pad; };
__global__ void __launch_bounds__(NWAVES * 64, 2) mk_fwd(Args args) {
    extern __shared__ __attribute__((aligned(16))) unsigned char lds[];
    Frame F;
    F.lds = (LAS unsigned char*)lds;
    F.MISC = (volatile LAS unsigned*)(F.lds + MISC_OFF);
    F.tid = threadIdx.x; F.lane = F.tid & 63; F.wave = __builtin_amdgcn_readfirstlane(F.tid >> 6);
    F.G = gridDim.x; { const int bx = blockIdx.x; F.vcu = (F.G % 8 == 0) ? (bx % 8) * (F.G / 8) + bx / 8 : bx; }
    unsigned char* ws = args.ws;
    F.ctl = (gu32*)(ws + WS_CTL);
    F.x = args.in[0]; F.c = args.in[1]; F.ctx = args.in[2]; F.c_ctx = args.in[3]; F.w_ada = args.in[4]; F.b_ada = args.in[5]; F.norm_mix = args.in[6]; F.norm_ffn = args.in[7];
    F.w_in = args.in[8]; F.lb_table = args.in[9]; F.hg_norm = args.in[10]; F.rpb = args.in[11]; F.w_out = args.in[12]; F.w_router = args.in[13]; F.b_router = args.in[14];
    F.w_gu = args.in[15]; F.b_gu = args.in[16]; F.w_down = args.in[17]; F.b_down = args.in[18]; F.norm_final = args.in[19]; F.out = args.out;
    F.MODP = (float*)(ws + WS_MODP); F.MODF = (float*)(ws + WS_MODF); F.OF = (bf16*)(ws + WS_OF); F.OB = (bf16*)(ws + WS_OB); F.X1 = (bf16*)(ws + WS_X1);
    F.WRT = (bf16*)(ws + WS_WRT); F.WIN = (bf16*)(ws + WS_WIN); F.WOUT = (bf16*)(ws + WS_WOUT); F.HXN = (bf16*)(ws + WS_HXN); F.PX = (bf16*)(ws + WS_PX); F.A2 = (bf16*)(ws + WS_A2);
    F.HX2 = (u8*)(ws + WS_HX2); F.XG = (u8*)(ws + WS_XG); F.H = (u8*)(ws + WS_H); F.Y = (u8*)(ws + WS_Y); F.WGU = (u8*)(ws + WS_WGU); F.WD = (u8*)(ws + WS_WD);
    F.RT_E = (int*)(ws + WS_RT); F.RT_POS = F.RT_E + T * 4; F.RT_G = (float*)(F.RT_POS + T * 4); F.RT_SLOT = (int*)(F.RT_G + T * 4);
    for (int u = F.tid; u < (LDS_BYTES - LDSCTL_OFF) / 4; u += NWAVES * 64) ((LAS unsigned*)(F.lds + LDSCTL_OFF))[u] = 0u;
    __syncthreads();
    const int NC = (N_LAUNCHES == 1 && F.G >= 256) ? NCONV : 0, NW = F.G - NC;
    const bool conv = (int)blockIdx.x >= NW;
    XcdBarrier barA, barW; barA.bar = (unsigned*)(F.ctl + CW_BAR); barA.x = 0; barA.st = nullptr; barA.total = 0; barW = barA;
    if (N_LAUNCHES == 1) { barA = xcd_barrier_post((unsigned*)(F.ctl + CW_BAR + args.li * 20480), F.MISC + 8, (unsigned)F.G);
        if (!conv) barW = xcd_barrier_post((unsigned*)(F.ctl + CW_BAR2 + args.li * 20480), F.MISC + 10, (unsigned)NW); }
#define GRID_BAR_A() do { if (N_LAUNCHES == 1) xcd_barrier(barA); } while (0)
#define GRID_BAR_W() do { if (N_LAUNCHES == 1) xcd_barrier(barW); } while (0)
#if defined(TPROBE)
    if (blockIdx.x == 0 && F.tid == 0) __hip_atomic_store((unsigned*)(F.ctl + 20000), (unsigned)__builtin_amdgcn_s_memrealtime(), RLX_AGENT);
#define TSTAMP(k) do { if (F.tid == 0) { unsigned t0_; int sp_ = 0; do { t0_ = __hip_atomic_load((unsigned*)(F.ctl + 20000), RLX_AGENT); } while (t0_ == 0u && ++sp_ < 1000000); \
        __hip_atomic_fetch_max((unsigned*)(F.ctl + 20064 + 64 * (k)), (unsigned)__builtin_amdgcn_s_memrealtime() - t0_, RLX_AGENT); } } while (0)
#else
#define TSTAMP(k) do {} while (0)
#endif
    const int lo = args.ph_lo, hi = args.ph_hi;
#define IN(k) (lo <= (k) && (k) < hi)
#define BOTH(k) (IN(k) && IN((k) + 1))
    constexpr int CV_N = NE * 2048 + NE * 1024;
    const int cvA = (NC > 0) ? CVA_PER_WAVE * F.G * NWAVES : 0;
    if (conv && args.ph_lo > 0) {} else
    if (conv) { convert_moe(F, (int)blockIdx.x * NWAVES + F.wave, F.G * NWAVES, 0, cvA); convert_moe(F, ((int)blockIdx.x - NW) * NWAVES + F.wave, NC * NWAVES, cvA, CV_N); TSTAMP(0); }
    else {
        const int Gall = F.G, vall = F.vcu;
        F.G = NW; { const int bx = blockIdx.x; F.vcu = (NW % 8 == 0) ? (bx % 8) * (NW / 8) + bx / 8 : bx; }
        if (IN(0)) { p0_prologue(F, NC == 0); convert_moe(F, (int)blockIdx.x * NWAVES + F.wave, Gall * NWAVES, 0, cvA); TSTAMP(1); if (BOTH(0)) GRID_BAR_W(); }
        if (IN(1)) { p1_norm(F); TSTAMP(2); if (BOTH(1)) GRID_BAR_W(); }
        if (IN(2)) {
            pg8::Gemm g{F.HXN, F.WIN, MTOT, 8192, D}; InProjOrder S; S.init(F.G, (int)blockIdx.x);
            EpiInProj E{F.PX, F.lb_table};
            pg8::gemm_phase<EpiInProj, InProjOrder, PG8_ALIGN, PG8_SP2>(F.lds + RING_OFF, g, S, E);
            TSTAMP(3); if (BOTH(2)) GRID_BAR_W();
        }
        if (IN(3)) { p3_mixer(F); TSTAMP(4); if (BOTH(3)) GRID_BAR_W(); }
        if (IN(4)) { p4_hg_out(F); TSTAMP(5); }
        F.G = Gall; F.vcu = vall;
    }
    if (BOTH(4)) GRID_BAR_A();
    if (IN(5)) {
        pg8::Gemm g{F.A2, F.WOUT, T, D, D}; pg8::StaticOrder S; S.init(T, D, F.G, (int)blockIdx.x);
        EpiOutProj E{F.x, F.X1, F.MODF, 1.f / (SA8 * SW8)};
        pg8::gemm_phase<EpiOutProj, pg8::StaticOrder, PG8_ALIGN, PG8_SP2, 1>(F.lds + RING_OFF, g, S, E);
        TSTAMP(6); if (BOTH(5)) GRID_BAR_A();
    }
    if (IN(6)) { p6_router(F); TSTAMP(7); if (BOTH(6)) GRID_BAR_A(); }
    if (IN(8)) {
        const int NT = moe_tables(F);
        pg8::Gemm g{(const bf16*)F.XG, (const bf16*)F.WGU, NE * T, NE * 4096, D}; MoeOrder S; S.init(NT, 16, F.G, (int)blockIdx.x, F.lds + TILE_OFF, (const LAS int*)(F.lds + OFFT_OFF), true);
        EpiSwiglu E{F.H, F.b_gu};
        pg8::gemm_phase<EpiSwiglu, MoeOrder, PG8_ALIGN, PG8_SP2, 2>(F.lds + RING_OFF, g, S, E);
        TSTAMP(9); if (BOTH(8)) GRID_BAR_A();
    }
    if (IN(9)) {
        const int NT = moe_tables(F);
        pg8::Gemm g{(const bf16*)F.H, (const bf16*)F.WD, CAP, NE * 2048, FF}; MoeOrder S; S.init(NT, 8, F.G, (int)blockIdx.x, F.lds + TILE_OFF, (const LAS int*)(F.lds + OFFT_OFF), false);
        EpiDown E{F.Y, F.b_down};
        pg8::gemm_phase<EpiDown, MoeOrder, PG8_ALIGN, PG8_SP2, 1>(F.lds + RING_OFF, g, S, E);
        TSTAMP(10); if (BOTH(9)) GRID_BAR_A();
    }
#if defined(TPROBE)
    if (IN(10)) { const unsigned tk = __hip_atomic_load((unsigned*)(F.ctl + 20064 + 64 * TPROBE), RLX_AGENT); p10_final(F, 1.f + (float)tk * 1e-6f); }
#else
    if (IN(10)) { p10_final(F, 1.f); }
#endif
#undef IN
#undef BOTH
}

extern "C" void kernel_launch(void* const* d_in, const int* in_sizes, int n_in, void* d_out, int out_size, void* d_ws, size_t ws_size, hipStream_t stream) {
    static int grid = 0;
    if (grid == 0) {
        if (n_in != 20 || out_size != T * D || ws_size < WS_END) { fprintf(stderr, "kernel_launch: unexpected shapes (n_in %d out %d ws %zu)\n", n_in, out_size, ws_size); grid = -1; return; }
        int dev = 0, cus = 0, per_cu = 0;
        if (hipGetDevice(&dev) != hipSuccess || hipDeviceGetAttribute(&cus, hipDeviceAttributeMultiprocessorCount, dev) != hipSuccess) { grid = -1; return; }
        if (hipFuncSetAttribute((const void*)mk_fwd, hipFuncAttributeMaxDynamicSharedMemorySize, LDS_BYTES) != hipSuccess) { fprintf(stderr, "kernel_launch: hipFuncSetAttribute failed\n"); grid = -1; return; }
        if (hipOccupancyMaxActiveBlocksPerMultiprocessor(&per_cu, (const void*)mk_fwd, NWAVES * 64, LDS_BYTES) != hipSuccess || per_cu < 1)
            fprintf(stderr, "kernel_launch: occupancy query reports %d workgroups per CU\n", per_cu);
        (void)hipGetLastError();
        grid = cus;
    }
    if (grid < 0) return;
    if (hipMemsetAsync((char*)d_ws + WS_CTL, 0, CTL_ZERO_BYTES, stream) != hipSuccess) return;
    Args a{};
    for (int i = 0; i < 20; ++i) a.in[i] = (const float*)d_in[i];
    a.out = (float*)d_out; a.ws = (unsigned char*)d_ws;
#if defined(PROBE_CUT)
    for (int li = 0; li < 2; ++li) {
        a.ph_lo = li == 0 ? 0 : PROBE_CUT; a.ph_hi = li == 0 ? PROBE_CUT + 1 : NPHASE; a.li = li; a.pad = 0;
        hipLaunchKernelGGL(mk_fwd, dim3(grid), dim3(NWAVES * 64), LDS_BYTES, stream, a);
    }
#else
    for (int li = 0; li < N_LAUNCHES; ++li) {
        a.ph_lo = (N_LAUNCHES == 1) ? 0 : li; a.ph_hi = (N_LAUNCHES == 1) ? NPHASE : li + 1; a.li = li; a.pad = 0;
        hipLaunchKernelGGL(mk_fwd, dim3(grid), dim3(NWAVES * 64), LDS_BYTES, stream, a);
        const hipError_t le = hipPeekAtLastError();
        if (le != hipSuccess) { fprintf(stderr, "kernel_launch: launch %d failed: %s\n", li, hipGetErrorName(le)); break; }
    }
#endif
}
```

```cpp
#define INPROJ_F6 1
#include <hip/hip_runtime.h>
#include <cstdio>
#include <cstdint>
namespace pg8 {
#define PG8_LAS __attribute__((address_space(3)))
typedef unsigned short bf16_t;
typedef short bf16x8 __attribute__((ext_vector_type(8)));
typedef float f32x4 __attribute__((ext_vector_type(4)));
typedef unsigned u32x4 __attribute__((ext_vector_type(4)));
constexpr int BM = 256, BK = 64, HALF = 128, HTB = HALF * BK * 2  , STAGE_BYTES = 8 * HTB, NXCD = 8, WGM = 8;

__host__ __device__ __forceinline__ int lds_byte2(int r, int chunk) { return r * 128 + 16 * (chunk ^ ((r >> 1) & 7)); }
__host__ __device__ __forceinline__ void stage_rc2(int b, int& R, int& C) { const int row = (b >> 10) * 8 + ((b & 1023) >> 7), pos = (b >> 4) & 7; R = row; C = 8 * (pos ^ ((row >> 1) & 7)); }
__host__ __device__ __forceinline__ int lds_byte(int r, int c) { const int st = (r >> 4) * 2 + (c >> 5), rr = r & 15, cc = c & 31, ob = rr * 64 + cc * 2; return st * 1024 + (ob ^ (((ob >> 9) & 1) << 5)); }
__host__ __device__ __forceinline__ void stage_rc(int b, int& R, int& C) { const int st = b / 1024, sb = b % 1024, swz = sb ^ (((sb >> 9) & 1) << 5); R = (st >> 1) * 16 + swz / 64; C = (st & 1) * 32 + (swz % 64) / 2; }
__host__ __device__ __forceinline__ int perm32(int rho) { const int n = rho >> 4, i = rho & 15; return 8 * (i >> 2) + 4 * n + (i & 3); }

struct Unit { int pm, pn, pa; };
struct Gemm { const bf16_t* A; const bf16_t* Bt; int M, N, K; };

struct StaticOrder {
    static constexpr bool SPARSE_A = false;
    int nM, nN, nwg, G, c;
    __host__ __device__ void init(int M, int N, int G_, int c_) { nM = M / BM; nN = N / BM; nwg = nM * nN; G = G_; c = c_; }
    __host__ __device__ bool next(int i, Unit& u) const {
        const long L = (long)i * G + c; if (L >= nwg) return false;
        int wgid = (int)L; { const int q = nwg / NXCD, r = nwg % NXCD, xcd = wgid % NXCD, off = wgid / NXCD; wgid = (xcd < r ? xcd * (q + 1) : r * (q + 1) + (xcd - r) * q) + off; }
        const int nig = WGM * nN, gid = wgid / nig, fm = gid * WGM, gsz = (nM - fm) < WGM ? (nM - fm) : WGM;
        u.pm = fm + ((wgid % nig) % gsz); u.pn = (wgid % nig) / gsz; return true;
    }
    __device__ __forceinline__ void a_ready(const Unit&) const {}
    __device__ __forceinline__ void done(const Unit&) const {}
};

__device__ __forceinline__ unsigned cvt_pk_bf16(float lo, float hi) { unsigned r; asm volatile("v_cvt_pk_bf16_f32 %0, %1, %2" : "=v"(r) : "v"(lo), "v"(hi)); return r; }
typedef int v8i32 __attribute__((ext_vector_type(8))); typedef int v4i32 __attribute__((ext_vector_type(4))); typedef int v6i32 __attribute__((ext_vector_type(6)));
__device__ __forceinline__ v6i32 sub6(v8i32 x) { return __builtin_shufflevector(x, x, 0, 1, 2, 3, 4, 5); }
__device__ __forceinline__ v8i32 cat_i8(bf16x8 a, bf16x8 b) { const v4i32 x = __builtin_bit_cast(v4i32, a), y = __builtin_bit_cast(v4i32, b); return __builtin_shufflevector(x, y, 0, 1, 2, 3, 4, 5, 6, 7); }
template <class Epi, class Sched, bool ALIGN_EPI = false, bool SP2 = false, int F8 = 0>
__device__ __forceinline__ void gemm_phase(PG8_LAS unsigned char* lds, const Gemm g, const Sched& S, const Epi& E) {
    const int tid = threadIdx.x, wid = __builtin_amdgcn_readfirstlane(tid >> 6), lane = tid & 63, wr = wid >> 2, wc = wid & 3, fr = lane & 15, fq = lane >> 4;
    const int K = g.K, PB = F8 ? K : 2 * K  , nt = PB / 128;
    unsigned voffA[2], voffB[2];
#pragma unroll
    for (int i = 0; i < 2; ++i) { int R, C; stage_rc2(tid * 16 + i * 8192, R, C); const int Rb = Epi::PERM ? ((R & ~31) + perm32(R & 31)) : R;
        voffA[i] = (unsigned)(R * PB + C * 2); voffB[i] = (unsigned)(Rb * PB + C * 2); }
    const size_t kstep = (size_t)(BK * 2);
    const size_t hstep = (size_t)HALF * PB;
    const size_t tstep = 2 * hstep;
    const unsigned ldsw = (unsigned)wid * 1024u;
    const int aoff = lds_byte2(wr * 64 + fr, fq), boff = lds_byte2(wc * 32 + fr, fq), aoff1 = lds_byte2(wr * 64 + fr, fq + 4) - aoff, boff1 = lds_byte2(wc * 32 + fr, fq + 4) - boff;
#define PG8_SA(b, h) (((b) * 2 + (h)) * HTB)
#define PG8_SB(b, h) ((4 + (b) * 2 + (h)) * HTB)
#define PG8_STAGE(bufoff, gbase, voff) do { _Pragma("unroll") for (int _i = 0; _i < 2; ++_i) \
        __builtin_amdgcn_global_load_lds((const unsigned*)((const char*)(gbase) + (voff)[_i]), (PG8_LAS unsigned*)(lds + (bufoff) + ldsw + _i * 8192), 16, 0, 0); } while (0)
#define PG8_LDA(dst, b, h) do { _Pragma("unroll") for (int m = 0; m < 4; ++m) { if constexpr (F8) { dst##8[m] = cat_i8(*(const PG8_LAS bf16x8*)(lds + PG8_SA(b, h) + aoff + m * 2048), *(const PG8_LAS bf16x8*)(lds + PG8_SA(b, h) + aoff + aoff1 + m * 2048)); } \
        else { _Pragma("unroll") for (int k = 0; k < 2; ++k) dst[m][k] = *(const PG8_LAS bf16x8*)(lds + PG8_SA(b, h) + aoff + k * aoff1 + m * 2048); } } } while (0)
#define PG8_LDB(dst, b, h) do { _Pragma("unroll") for (int n = 0; n < 2; ++n) { if constexpr (F8) { dst##8[n] = cat_i8(*(const PG8_LAS bf16x8*)(lds + PG8_SB(b, h) + boff + n * 2048), *(const PG8_LAS bf16x8*)(lds + PG8_SB(b, h) + boff + boff1 + n * 2048)); } \
        else { _Pragma("unroll") for (int k = 0; k < 2; ++k) dst[n][k] = *(const PG8_LAS bf16x8*)(lds + PG8_SB(b, h) + boff + k * boff1 + n * 2048); } } } while (0)
#define PG8_MMA(ai, bj, At, Bt) do { __builtin_amdgcn_s_setprio(1); _Pragma("unroll") for (int m = 0; m < 4; ++m) _Pragma("unroll") for (int n = 0; n < 2; ++n) { \
        if constexpr (F8 == 2) { asm volatile("s_nop 1\n\tv_mfma_scale_f32_16x16x128_f8f6f4 %0, %1, %2, %0, %3, %4 op_sel_hi:[0,0,0] cbsz:2 blgp:2" : "+v"(acc[ai][bj][m][n]) : "v"(sub6(Bt##8[n])), "v"(sub6(At##8[m])), "v"(Bt##8[n][6]), "v"(At##8[m][6])); } \
        else if constexpr (F8 == 1) { asm volatile("v_mfma_scale_f32_16x16x128_f8f6f4 %0, %1, %2, %0, %3, %3 op_sel_hi:[0,0,0]" : "+v"(acc[ai][bj][m][n]) : "v"(Bt##8[n]), "v"(At##8[m]), "v"(f8scale)); } \
        else { _Pragma("unroll") for (int k = 0; k < 2; ++k) acc[ai][bj][m][n] = __builtin_amdgcn_mfma_f32_16x16x32_bf16(Bt[n][k], At[m][k], acc[ai][bj][m][n], 0, 0, 0); } } \
        __builtin_amdgcn_s_setprio(0); } while (0)
#define PG8_WAIT_V(n) asm volatile("s_waitcnt vmcnt(" #n ")" ::: "memory")
#define PG8_WAIT_L(n) asm volatile("s_waitcnt lgkmcnt(" #n ")" ::: "memory")
#define PG8_BAR __builtin_amdgcn_s_barrier()
#define PG8_SCHED __builtin_amdgcn_sched_barrier(0)
    Unit cur, nxt; int ui = 0;
    if (!S.next(0, cur)) return;
    f32x4 acc[2][2][4][2];
#pragma unroll
    for (int a = 0; a < 2; ++a)
#pragma unroll
        for (int b = 0; b < 2; ++b)
#pragma unroll
            for (int m = 0; m < 4; ++m)
#pragma unroll
                for (int n = 0; n < 2; ++n) acc[a][b][m][n] = (f32x4){0.f, 0.f, 0.f, 0.f};
    bf16x8 At[4][2], B0[2][2], B1[2][2]; v8i32 At8[4], B08[2], B18[2]; const int f8scale = 0x7F7F7F7F;
    const char* cA = (const char*)g.A + (size_t)(Sched::SPARSE_A ? cur.pa : cur.pm) * tstep; const char* cB = (const char*)g.Bt + (size_t)cur.pn * tstep;
    S.a_ready(cur);
    if constexpr (SP2) {
        PG8_STAGE(PG8_SB(0, 0), cB, voffB); PG8_STAGE(PG8_SB(0, 1), cB + hstep, voffB); PG8_STAGE(PG8_SA(0, 0), cA, voffA); PG8_STAGE(PG8_SA(0, 1), cA + hstep, voffA);
        if (wr == 1) PG8_BAR;
        PG8_WAIT_V(2); PG8_BAR;
        PG8_STAGE(PG8_SB(1, 0), cB + kstep, voffB); PG8_STAGE(PG8_SA(1, 0), cA + kstep, voffA); PG8_STAGE(PG8_SB(1, 1), cB + hstep + kstep, voffB);
        PG8_WAIT_V(6); PG8_BAR;
    } else {
        PG8_STAGE(PG8_SB(0, 0), cB, voffB); PG8_STAGE(PG8_SA(0, 0), cA, voffA); PG8_STAGE(PG8_SB(0, 1), cB + hstep, voffB); PG8_STAGE(PG8_SA(0, 1), cA + hstep, voffA);
        if (wr == 1) PG8_BAR;
        PG8_WAIT_V(4); PG8_BAR;
        PG8_STAGE(PG8_SB(1, 0), cB + kstep, voffB); PG8_STAGE(PG8_SA(1, 0), cA + kstep, voffA); PG8_STAGE(PG8_SB(1, 1), cB + hstep + kstep, voffB);
        PG8_WAIT_V(6); PG8_BAR;
    }
    for (;;) {
        const bool has_next = S.next(ui + 1, nxt);
        const char* nA = has_next ? (const char*)g.A + (size_t)(Sched::SPARSE_A ? nxt.pa : nxt.pm) * tstep : cA; const char* nB = has_next ? (const char*)g.Bt + (size_t)nxt.pn * tstep : cB;
        for (int t = 0; t < nt; t += 2) {
            const bool last = (t == nt - 2);
            const char* a1 = cA + (size_t)(t + 1) * kstep;
            const char* a2 = last ? nA : cA + (size_t)(t + 2) * kstep; const char* b2 = last ? nB : cB + (size_t)(t + 2) * kstep;
            const char* a3 = a2 + kstep; const char* b3 = b2 + kstep;
            if (last && has_next) S.a_ready(nxt);
            if constexpr (SP2) {
            PG8_LDB(B0, 0, 0); PG8_LDB(B1, 0, 1); PG8_SCHED; PG8_LDA(At, 0, 0); PG8_STAGE(PG8_SA(1, 1), a1 + hstep, voffA);
            PG8_WAIT_V(8); PG8_WAIT_L(0); PG8_BAR; PG8_MMA(0, 0, At, B0); PG8_MMA(0, 1, At, B1); PG8_BAR; PG8_SCHED;
            PG8_LDA(At, 0, 1); PG8_STAGE(PG8_SB(0, 0), b2, voffB); PG8_STAGE(PG8_SB(0, 1), b2 + hstep, voffB); PG8_STAGE(PG8_SA(0, 0), a2, voffA);
            PG8_WAIT_V(8); PG8_WAIT_L(0); PG8_BAR; PG8_MMA(1, 0, At, B0); PG8_MMA(1, 1, At, B1); PG8_BAR; PG8_SCHED;
            PG8_LDB(B0, 1, 0); PG8_LDB(B1, 1, 1); PG8_SCHED; PG8_LDA(At, 1, 0); PG8_STAGE(PG8_SA(0, 1), a2 + hstep, voffA);
            PG8_WAIT_V(8); PG8_WAIT_L(0); PG8_BAR; PG8_MMA(0, 0, At, B0); PG8_MMA(0, 1, At, B1); PG8_BAR; PG8_SCHED;
            PG8_LDA(At, 1, 1); PG8_STAGE(PG8_SB(1, 0), b3, voffB); PG8_STAGE(PG8_SB(1, 1), b3 + hstep, voffB); PG8_STAGE(PG8_SA(1, 0), a3, voffA);
            PG8_WAIT_V(8); PG8_WAIT_L(0); PG8_BAR; PG8_MMA(1, 0, At, B0); PG8_MMA(1, 1, At, B1); PG8_BAR; PG8_SCHED;
            } else {
            PG8_LDB(B0, 0, 0); PG8_SCHED; PG8_LDA(At, 0, 0); PG8_STAGE(PG8_SA(1, 1), a1 + hstep, voffA);
            PG8_WAIT_L(8); PG8_BAR; PG8_WAIT_L(0); PG8_MMA(0, 0, At, B0); PG8_BAR; PG8_SCHED;
            PG8_LDB(B1, 0, 1); PG8_STAGE(PG8_SB(0, 0), b2, voffB);
            PG8_BAR; PG8_WAIT_L(0); PG8_MMA(0, 1, At, B1); PG8_BAR;
            PG8_LDA(At, 0, 1); PG8_STAGE(PG8_SA(0, 0), a2, voffA);
            PG8_BAR; PG8_WAIT_L(0); PG8_MMA(1, 0, At, B0); PG8_BAR; PG8_SCHED;
            PG8_STAGE(PG8_SB(0, 1), b2 + hstep, voffB);
            PG8_WAIT_V(6); PG8_BAR; PG8_MMA(1, 1, At, B1); PG8_BAR;
            PG8_LDB(B0, 1, 0); PG8_SCHED; PG8_LDA(At, 1, 0); PG8_STAGE(PG8_SA(0, 1), a2 + hstep, voffA);
            PG8_WAIT_L(8); PG8_BAR; PG8_WAIT_L(0); PG8_MMA(0, 0, At, B0); PG8_BAR; PG8_SCHED;
            PG8_LDB(B1, 1, 1); PG8_STAGE(PG8_SB(1, 0), b3, voffB);
            PG8_BAR; PG8_WAIT_L(0); PG8_MMA(0, 1, At, B1); PG8_BAR;
            PG8_LDA(At, 1, 1); PG8_STAGE(PG8_SA(1, 0), a3, voffA);
            PG8_BAR; PG8_WAIT_L(0); PG8_MMA(1, 0, At, B0); PG8_BAR; PG8_SCHED;
            PG8_STAGE(PG8_SB(1, 1), b3 + hstep, voffB);
            PG8_WAIT_V(6); PG8_BAR; PG8_MMA(1, 1, At, B1); PG8_BAR;
            }
        }
        if constexpr (ALIGN_EPI) { if (wr == 0) PG8_BAR; }
        if constexpr (F8) { asm volatile("s_nop 15\n\ts_nop 15" ::: "memory"); }
        if constexpr (!Epi::AFTER_DRAIN) { const int ln_ = (int)__builtin_amdgcn_mbcnt_hi(~0u, __builtin_amdgcn_mbcnt_lo(~0u, 0u));
            E(acc, cur, wr, wc, ln_ & 15, ln_ >> 4); S.done(cur); }
        if (!has_next) break;
#pragma unroll
        for (int a = 0; a < 2; ++a)
#pragma unroll
            for (int b = 0; b < 2; ++b)
#pragma unroll
                for (int m = 0; m < 4; ++m)
#pragma unroll
                    for (int n = 0; n < 2; ++n) acc[a][b][m][n] = (f32x4){0.f, 0.f, 0.f, 0.f};
        cur = nxt; cA = nA; cB = nB; ++ui;
        if constexpr (ALIGN_EPI) { if (wr == 1) PG8_BAR; }
    }
    PG8_WAIT_V(0);
    if constexpr (!ALIGN_EPI) { if (wr == 0) PG8_BAR; }
    PG8_BAR;
    if constexpr (Epi::AFTER_DRAIN) { E.fused(acc, cur, wr, wc, fr, fq, lds, wid, lane); S.done(cur); }
#undef PG8_SA
#undef PG8_SB
#undef PG8_STAGE
#undef PG8_LDA
#undef PG8_LDB
#undef PG8_MMA
#undef PG8_WAIT_V
#undef PG8_WAIT_L
#undef PG8_BAR
#undef PG8_SCHED
}
}

#ifndef PG8_SP2
#define PG8_SP2 true
#endif
#ifndef PG8_ALIGN
#define PG8_ALIGN true
#endif
constexpr int NWAVES = 8;
#ifndef MK_N_LAUNCHES
#define MK_N_LAUNCHES 1
#endif
constexpr int NPHASE = 11;
constexpr int N_LAUNCHES = MK_N_LAUNCHES;
static_assert(N_LAUNCHES == 1 || N_LAUNCHES == NPHASE, "MK_N_LAUNCHES is 1 or 11");

constexpr int D = 2048, NB = 8, SEQ = 2048, T = NB * SEQ, LC = 256, TC = NB * LC, MTOT = T + TC;
constexpr int HEADS = 8, HD = 128, MIXG = 1024;
constexpr int SQN = 0, SKN = 1, SVN = 2, SQH = 3, SKF = 4, SKB = 5, SIH = 6, SGF = 7, SGB = 8, NSTREAM = 9;
constexpr size_t HM_CTX0 = (size_t)NSTREAM * NB * HEADS * SEQ * HD, HM_GATE0 = HM_CTX0 + (size_t)NSTREAM * NB * HEADS * LC * HD;
constexpr int NE = 32, TOPK = 4, FF = 2048;
constexpr int CAP_TILES = 288, CAP = CAP_TILES * 256;
constexpr float EPS = 1e-6f;

constexpr size_t MiB = 1u << 20;
constexpr size_t WS_CTL = 0, CTL_ZERO_BYTES = 1 * MiB;
constexpr size_t WS_MODP = 4 * MiB;
constexpr size_t WS_MODF = 6 * MiB;
constexpr size_t WS_WRT = 7 * MiB;
constexpr size_t WS_WIN = 8 * MiB;
constexpr size_t WS_WOUT = 40 * MiB;
constexpr size_t WS_HXN = 48 * MiB;
constexpr size_t WS_PX = 120 * MiB;
constexpr size_t WS_A2 = 480 * MiB;
constexpr size_t WS_OF = 544 * MiB;
constexpr size_t WS_OB = 608 * MiB;
constexpr size_t WS_X1 = 672 * MiB;
constexpr size_t WS_HX2 = 800 * MiB;
constexpr size_t WS_RT = 864 * MiB;
constexpr size_t WS_XG = 2498 * MiB;
constexpr size_t WS_XG_OLD = 866 * MiB;
constexpr size_t WS_H = 1154 * MiB;
constexpr size_t WS_Y = 1442 * MiB;
constexpr size_t WS_WGU = 1730 * MiB;
constexpr size_t WS_WD = 2242 * MiB;
constexpr size_t WS_END = 3522 * MiB;
constexpr int CW_TMO = 0;
constexpr int CW_BAR = 4096, CW_BAR2 = 8192;
constexpr int NCONV = 66, CVA_PER_WAVE = 0;
constexpr int CW_ATTQ = 16384;
constexpr int CW_CNT = 16448;

constexpr int RING_OFF = 0, SCR_BYTES = 139264;
constexpr int LDSCTL_OFF = SCR_BYTES, MISC_OFF = LDSCTL_OFF + 320, TILE_OFF = MISC_OFF + 128, OFFT_OFF = TILE_OFF + 320;
constexpr int LDS_BYTES = 147456;
static_assert(OFFT_OFF + 256 <= LDS_BYTES, "LDS map");

#define GAS __attribute__((address_space(1)))
#define LAS __attribute__((address_space(3)))
typedef unsigned short bf16;
typedef unsigned char u8;
typedef unsigned v4u __attribute__((ext_vector_type(4)));
typedef unsigned v2u __attribute__((ext_vector_type(2)));
typedef float f32x4 __attribute__((ext_vector_type(4)));
typedef float f32x2 __attribute__((ext_vector_type(2)));
typedef short bf16x8 __attribute__((ext_vector_type(8)));
typedef short s16x4 __attribute__((ext_vector_type(4)));
typedef __bf16 bfv2 __attribute__((ext_vector_type(2)));
typedef GAS unsigned gu32;
#define RLX_AGENT __ATOMIC_RELAXED, __HIP_MEMORY_SCOPE_AGENT
#define LDS_WAIT() asm volatile("s_waitcnt lgkmcnt(0)" ::: "memory")
#define VM_WAIT() asm volatile("s_waitcnt vmcnt(0)" ::: "memory")
__device__ __forceinline__ unsigned pk2(float lo, float hi) { f32x2 v = {lo, hi}; bfv2 b = __builtin_convertvector(v, bfv2); return __builtin_bit_cast(unsigned, b); }
constexpr float SW8 = 256.f, SA8 = 8.f, SH8 = 4.f, SY8 = 16.f;
__device__ __forceinline__ unsigned pk4_fp8(float a, float b, float c, float d) {
    a = fminf(fmaxf(a, -448.f), 448.f); b = fminf(fmaxf(b, -448.f), 448.f); c = fminf(fmaxf(c, -448.f), 448.f); d = fminf(fmaxf(d, -448.f), 448.f);
    int w = __builtin_amdgcn_cvt_pk_fp8_f32(a, b, 0, false); w = __builtin_amdgcn_cvt_pk_fp8_f32(c, d, w, true); return (unsigned)w; }
__device__ __forceinline__ size_t hm_lat(int s, int b, int h) { return ((size_t)((s * NB + b) * HEADS + h) * SEQ) * HD; }
__device__ __forceinline__ size_t hm_ctx(int s, int b, int h) { return HM_CTX0 + ((size_t)((s * NB + b) * HEADS + h) * LC) * HD; }
__device__ __forceinline__ size_t hm_row(int s, int row, int h) { return row < T ? hm_lat(s, row >> 11, h) + (size_t)(row & 2047) * HD : hm_ctx(s, (row - T) >> 8, h) + (size_t)((row - T) & 255) * HD; }
__device__ __forceinline__ unsigned pk4_fp8_nc(float a, float b, float c, float d) {
    int w = __builtin_amdgcn_cvt_pk_fp8_f32(a, b, 0, false); w = __builtin_amdgcn_cvt_pk_fp8_f32(c, d, w, true); return (unsigned)w; }
typedef float v16f __attribute__((ext_vector_type(16))); typedef unsigned v6u __attribute__((ext_vector_type(6)));
__device__ __forceinline__ void mx6_pack(const float (&v)[32], v6u& p, unsigned& eb) {
    float m = fabsf(v[0]);
#pragma unroll
    for (int i = 1; i < 32; ++i) m = fmaxf(m, fabsf(v[i]));
    const unsigned mb = __float_as_uint(m);
    int e = (int)(mb >> 23) - 129 + (((mb & 0x7FFFFFu) > 0x700000u) ? 1 : 0);
    e = max(e, -126);
    const float inv = __uint_as_float((unsigned)(127 - e) << 23);
    v16f lo, hi;
#pragma unroll
    for (int i = 0; i < 16; ++i) { lo[i] = v[i] * inv; hi[i] = v[16 + i] * inv; }
    p = __builtin_amdgcn_cvt_scalef32_2xpk16_fp6_f32(lo, hi, 1.0f);
    eb = (unsigned)(e + 127);
}
__device__ __forceinline__ float bflo(unsigned u) { return __uint_as_float(u << 16); }
__device__ __forceinline__ float bfhi(unsigned u) { return __uint_as_float(u & 0xffff0000u); }
__device__ __forceinline__ float wave_sum(float v) {
#pragma unroll
    for (int o = 1; o < 64; o <<= 1) v += __shfl_xor(v, o);
    return v;
}
__device__ __forceinline__ float rcp_f(float x) { return __builtin_amdgcn_rcpf(x); }
__device__ __forceinline__ float silu_f(float x) { return x * rcp_f(1.f + __expf(-x)); }
__device__ __forceinline__ bf16x8 cat8(s16x4 a, s16x4 b) { return __builtin_shufflevector(a, b, 0, 1, 2, 3, 4, 5, 6, 7); }
__device__ __forceinline__ s16x4 tr_read(const LAS unsigned char* p) { return __builtin_amdgcn_ds_read_tr16_b64_v4i16((LAS s16x4*)p); }
__device__ __forceinline__ bf16x8 mk8(unsigned a, unsigned b, unsigned c, unsigned d) { v4u v = {a, b, c, d}; return __builtin_bit_cast(bf16x8, v); }
#define XB_TMO      128
#define XB_XCNT(j)  (256  + 64 * (j))
#define XB_XSUB(j)  (1280 + 64 * (j))
#define XB_XGEN(j)  (2304 + 64 * (j))
#define XB_TOP      3328
#define XB_TOPGEN   3392
#define XCD_BAR_WORDS 3456
#define XB_SPIN_CAP (1u << 18)

__device__ __forceinline__ unsigned xb_ld(unsigned* p)              { return __hip_atomic_load(p, __ATOMIC_RELAXED, __HIP_MEMORY_SCOPE_AGENT); }
__device__ __forceinline__ unsigned xb_add(unsigned* p, unsigned v) { return __hip_atomic_fetch_add(p, v, __ATOMIC_RELAXED, __HIP_MEMORY_SCOPE_AGENT); }
__device__ __forceinline__ unsigned xb_xcc_id() { return (unsigned)__builtin_amdgcn_s_getreg((3 << 11) | 20) & 0xFu; }
#define XB_SPIN(cond, bar) do { unsigned _sp = 0; while (cond) { __builtin_amdgcn_s_sleep(1); \
    if ((++_sp & 255u) == 0u) { if (xb_ld(&(bar)[XB_TMO])) break; if (_sp > XB_SPIN_CAP) { atomicAdd(&(bar)[XB_TMO], 1u); break; } } } } while (0)

struct XcdBarrier {
    unsigned* bar; unsigned x; unsigned total;
    volatile LAS unsigned* st;
};

__device__ __forceinline__ XcdBarrier xcd_barrier_post(unsigned* bar, volatile LAS unsigned* st, unsigned total) {
    XcdBarrier b; b.bar = bar; b.x = xb_xcc_id(); b.st = st; b.total = total;
    if (threadIdx.x == 0) (void)xb_add(&bar[XB_XCNT(b.x)], 1u);
    return b;
}
__device__ __forceinline__ void xcd_barrier_complete(unsigned* bar, unsigned x, unsigned G, unsigned& nloc, unsigned& nx) {
    unsigned sum, cnt, mine, sp = 0u;
    for (;;) {
        sum = 0u; cnt = 0u; mine = 0u;
#pragma unroll
        for (unsigned j = 0; j < 16; ++j) { const unsigned c = xb_ld(&bar[XB_XCNT(j)]); sum += c; cnt += (c > 0u) ? 1u : 0u; mine = (j == x) ? c : mine; }
        if (sum == G) break;
        __builtin_amdgcn_s_sleep(1);
        if ((++sp & 255u) == 0u) { if (xb_ld(&bar[XB_TMO])) break; if (sp > XB_SPIN_CAP) { atomicAdd(&bar[XB_TMO], 1u); break; } }
    }
    nloc = mine > 0u ? mine : 1u; nx = cnt > 0u ? cnt : 1u;
}

__device__ __forceinline__ void xcd_barrier(const XcdBarrier& b) {
    asm volatile("s_waitcnt vmcnt(0)" ::: "memory");
    __syncthreads();
    if (threadIdx.x == 0) {
        unsigned* bar = b.bar;
        __builtin_amdgcn_s_waitcnt(0);
        unsigned nloc = b.st[0], nx = b.st[1];
        if (nloc == 0u) { xcd_barrier_complete(bar, b.x, b.total, nloc, nx); b.st[0] = nloc; b.st[1] = nx; }
        const unsigned old = xb_add(&bar[XB_XSUB(b.x)], 1u);
        const unsigned gen = old / nloc;
        if (old + 1u == (gen + 1u) * nloc) {
            __builtin_amdgcn_fence(__ATOMIC_RELEASE, "agent");
            asm volatile("s_waitcnt vmcnt(0)" ::: "memory");
            const unsigned og = xb_add(&bar[XB_TOP], 1u);
            const unsigned tg = og / nx;
            if (og + 1u == (tg + 1u) * nx) xb_add(&bar[XB_TOPGEN], 1u);
            else XB_SPIN(xb_ld(&bar[XB_TOPGEN]) == tg, bar);
            __builtin_amdgcn_fence(__ATOMIC_ACQUIRE, "agent");
            xb_add(&bar[XB_XGEN(b.x)], 1u);
            asm volatile("s_waitcnt vmcnt(0)" ::: "memory");
        } else {
            XB_SPIN(xb_ld(&bar[XB_XGEN(b.x)]) == gen, bar);
            __builtin_amdgcn_fence(__ATOMIC_ACQUIRE, "agent");
            asm volatile("s_waitcnt vmcnt(0)" ::: "memory");
        }
    }
    __syncthreads();
}

struct Frame {
    LAS unsigned char* lds;
    volatile LAS unsigned* MISC;
    gu32* ctl;
    int tid, lane, wave;
    int vcu, G;
    const float *x, *c, *ctx, *c_ctx, *w_ada, *b_ada, *norm_mix, *norm_ffn, *w_in, *lb_table, *hg_norm, *rpb, *w_out, *w_router, *b_router, *w_gu, *b_gu, *w_down, *b_down, *norm_final;
    float* out;
    float *MODP, *MODF; bf16 *OF, *OB;
    bf16 *WRT, *WIN, *WOUT, *HXN, *PX, *A2, *X1; u8 *HX2, *XG, *H, *WGU, *WD, *Y;
    int *RT_E, *RT_POS, *RT_SLOT; float* RT_G;
};

__device__ __forceinline__ void p0_mod_unit(Frame& F, int unit) {
    const int slab = unit >> 2, ks = unit & 3, col0 = slab * 64, k0 = ks * 512;
    LAS float* cond = (LAS float*)(F.lds);
    LAS float* red = (LAS float*)(F.lds + 9 * 512 * 4);
    for (int i = F.tid; i < 9 * 512; i += 512) { const int r = i >> 9, k = i & 511; const float v = (r < 8) ? F.c[r * D + k0 + k] : F.c_ctx[k0 + k]; cond[i] = silu_f(v); }
    __syncthreads();
    const int c4 = F.tid & 15, kl = F.tid >> 4;
    float acc[9][4];
#pragma unroll
    for (int r = 0; r < 9; ++r) { acc[r][0] = 0.f; acc[r][1] = 0.f; acc[r][2] = 0.f; acc[r][3] = 0.f; }
    const float* wp = F.w_ada + (size_t)(k0 + kl) * (6 * D) + col0 + 4 * c4;
#pragma unroll 4
    for (int it = 0; it < 16; ++it) {
        const f32x4 w = *(const f32x4*)(wp + (size_t)(32 * it) * (6 * D));
#pragma unroll
        for (int r = 0; r < 9; ++r) { const float cv = cond[r * 512 + kl + 32 * it]; acc[r][0] += cv * w.x; acc[r][1] += cv * w.y; acc[r][2] += cv * w.z; acc[r][3] += cv * w.w; }
    }
#pragma unroll
    for (int r = 0; r < 9; ++r)
#pragma unroll
        for (int j = 0; j < 4; ++j) { float v = acc[r][j]; v += __shfl_xor(v, 16); v += __shfl_xor(v, 32); if (F.lane < 16) red[F.wave * 576 + r * 64 + 4 * c4 + j] = v; }
    __syncthreads();
    for (int o = F.tid; o < 576; o += 512) { float s = 0.f;
#pragma unroll
        for (int w = 0; w < 8; ++w) s += red[w * 576 + o];
        const int r = o >> 6, cc = o & 63; F.MODP[(size_t)(ks * 9 + r) * (6 * D) + col0 + cc] = s; }
    __syncthreads();
}
__device__ __forceinline__ void p0_tr_item(const float* W, int ldw, bf16* WT, size_t dst_row0, int k0, int n0, LAS float* scr, int lane, int hi_off = 0) {
#pragma unroll 4
    for (int i = 0; i < 16; ++i) { const int kk = 4 * i + (lane >> 4); const f32x4 v = *(const f32x4*)(W + (size_t)(k0 + kk) * ldw + n0 + 4 * (lane & 15));
        LAS float* s = scr + kk * 65 + 4 * (lane & 15); s[0] = v.x; s[1] = v.y; s[2] = v.z; s[3] = v.w; }
    LDS_WAIT(); asm volatile("" ::: "memory");
    const int c = lane & 7, nn = lane >> 3;
#pragma unroll
    for (int j = 0; j < 8; ++j) { const int n = 8 * j + nn; const LAS float* s = scr + (8 * c) * 65 + n;
        v4u o; o.x = pk2(s[0 * 65], s[1 * 65]); o.y = pk2(s[2 * 65], s[3 * 65]); o.z = pk2(s[4 * 65], s[5 * 65]); o.w = pk2(s[6 * 65], s[7 * 65]);
        *(v4u*)(WT + (dst_row0 + n + (n >= 32 ? hi_off : 0)) * 2048 + k0 + 8 * c) = o; }
    LDS_WAIT(); asm volatile("" ::: "memory");
}
__device__ __forceinline__ void p0_tr_item8(const float* W, int ldw, u8* WT, size_t dst_row0, int k0, int n0, LAS float* scr, int lane, float scale) {
#pragma unroll 4
    for (int i = 0; i < 16; ++i) { const int kk = 8 * i + (lane >> 3); const f32x4 v = *(const f32x4*)(W + (size_t)(k0 + kk) * ldw + n0 + 4 * (lane & 7)) * scale;
        LAS float* s = scr + kk * 33 + 4 * (lane & 7); s[0] = v.x; s[1] = v.y; s[2] = v.z; s[3] = v.w; }
    LDS_WAIT(); asm volatile("" ::: "memory");
    const int n = lane & 31, h = lane >> 5;
#pragma unroll
    for (int j = 0; j < 4; ++j) { const int cj = 2 * j + h; const LAS float* s = scr + (16 * cj) * 33 + n;
        v4u o; o.x = pk4_fp8(s[0 * 33], s[1 * 33], s[2 * 33], s[3 * 33]); o.y = pk4_fp8(s[4 * 33], s[5 * 33], s[6 * 33], s[7 * 33]);
        o.z = pk4_fp8(s[8 * 33], s[9 * 33], s[10 * 33], s[11 * 33]); o.w = pk4_fp8(s[12 * 33], s[13 * 33], s[14 * 33], s[15 * 33]);
        *(v4u*)(WT + (dst_row0 + n) * 2048 + k0 + 16 * cj) = o; }
    LDS_WAIT(); asm volatile("" ::: "memory");
}
__device__ __forceinline__ void p0_prologue(Frame& F, bool with_moe) {
    for (int u = F.vcu; u < 768; u += F.G) p0_mod_unit(F, u);
    LAS float* scr = (LAS float*)(F.lds + F.wave * 16896);
    const int gw = F.vcu * NWAVES + F.wave, NGW = F.G * NWAVES;
#ifdef INPROJ_F6
    constexpr int I_IN = 0, I_OUT = 32 * 32,
#else
    constexpr int I_IN = 32 * 128, I_OUT = 32 * 32,
#endif
    I_GU = 32 * 64, I_DN = 32 * 32;
    const int NITEMS = I_IN + I_OUT + (with_moe ? NE * I_GU + NE * I_DN : 0);
    for (int it = gw; it < NITEMS; it += NGW) {
        int r = it;
        if (r < I_IN) { const int kb = r >> 7, nb = r & 127, n0 = nb * 64, part = n0 >> 10;
            const bool prm = (part >= 3 && part <= 5); const int cl = n0 & 255;
            const size_t drow = prm ? (size_t)((n0 & ~255) + 32 * ((cl >> 7) * 2 + ((cl >> 6) & 1))) : (size_t)n0;
            p0_tr_item(F.w_in, 8192, F.WIN, drow, kb * 64, n0, scr, F.lane, prm ? 96 : 0); continue; } r -= I_IN;
        if (r < I_OUT) { const int kb = r >> 6, nb = r & 63; p0_tr_item8(F.w_out, 2048, (u8*)F.WOUT, (size_t)nb * 32, kb * 128, nb * 32, scr, F.lane, SW8); continue; } r -= I_OUT;
        if (r < NE * I_GU) { const int e = r >> 11, q = r & 2047, kb = q >> 7, nb = q & 127, n0 = nb * 32;
            const size_t drow = (size_t)e * 4096 + (size_t)(((n0 & 2047) >> 7) * 256 + (n0 >> 11) * 128 + (n0 & 127));
            p0_tr_item8(F.w_gu + (size_t)e * 2048 * 4096, 4096, F.WGU, drow, kb * 128, n0, scr, F.lane, SW8); continue; } r -= NE * I_GU;
        { const int e = r >> 10, q = r & 1023, kb = q >> 6, nb = q & 63; p0_tr_item8(F.w_down + (size_t)e * 2048 * 2048, 2048, F.WD, (size_t)e * 2048 + nb * 32, kb * 128, nb * 32, scr, F.lane, SW8); }
    }
    for (int i = F.vcu * 512 + F.tid; i < NE * D; i += F.G * 512) { const int e = i >> 11, k = i & 2047; const float w = F.w_router[k * NE + e];
        const unsigned hi = pk2(w, 0.f) & 0xffffu; const float wl = w - bflo(hi); F.WRT[i] = (bf16)hi; F.WRT[NE * D + i] = (bf16)(pk2(wl, 0.f) & 0xffffu); }
}

struct CvItem { const float* src; u8* dst; int ldw; int t6; };
__device__ __forceinline__ CvItem cv_decode(Frame& F, int r) {
    CvItem c;
    if (r < NE * 2048) { const int e = r >> 11, q = r & 2047, kb = q >> 7, nb = q & 127, n0 = nb * 32;
        const size_t drow = (size_t)e * 4096 + (size_t)(((n0 & 2047) >> 7) * 256 + (n0 >> 11) * 128 + (n0 & 127));
        c.src = F.w_gu + (size_t)e * 2048 * 4096 + (size_t)(kb * 128) * 4096 + n0; c.ldw = 4096; c.dst = F.WGU + drow * 2048 + kb * 128; c.t6 = 1; }
    else { r -= NE * 2048; const int e = r >> 10, q = r & 1023, kb = q >> 6, nb = q & 63;
        c.src = F.w_down + (size_t)e * 2048 * 2048 + (size_t)(kb * 128) * 2048 + nb * 32; c.ldw = 2048; c.dst = F.WD + ((size_t)e * 2048 + nb * 32) * 2048 + kb * 128; c.t6 = 0; }
    return c;
}
__device__ __forceinline__ void cv_load(f32x4 (&v)[16], const CvItem& c, int lane) {
    const float* p = c.src + (size_t)(16 * (lane >> 3)) * c.ldw + 4 * (lane & 7);
#pragma unroll
    for (int i = 0; i < 16; ++i) v[i] = __builtin_nontemporal_load((const f32x4*)(p + (size_t)i * c.ldw));
}
__device__ __forceinline__ void cv_proc(const f32x4 (&v)[16], const CvItem& c, LAS float* scr, int lane) {
    (void)scr;
    if (c.t6) {
        const bool odd = (lane >> 3) & 1;
        float lo[2][16], hi[2][16];
#pragma unroll
        for (int i = 0; i < 16; ++i) {
            const float sx = odd ? v[i].x : v[i].z, sy = odd ? v[i].y : v[i].w, ox = odd ? v[i].z : v[i].x, oy = odd ? v[i].w : v[i].y;
            const float rx = __int_as_float(__builtin_amdgcn_mov_dpp(__float_as_int(sx), 0x128, 0xf, 0xf, true)), ry = __int_as_float(__builtin_amdgcn_mov_dpp(__float_as_int(sy), 0x128, 0xf, 0xf, true));
            lo[0][i] = odd ? rx : ox; hi[0][i] = odd ? ox : rx; lo[1][i] = odd ? ry : oy; hi[1][i] = odd ? oy : ry; }
        u8* d6 = c.dst + (size_t)(4 * (lane & 7) + (odd ? 2 : 0)) * 2048 + 16 * (lane >> 4);
#pragma unroll
        for (int cc = 0; cc < 2; ++cc) { float hv[32];
#pragma unroll
            for (int j = 0; j < 16; ++j) { hv[j] = lo[cc][j]; hv[16 + j] = hi[cc][j]; }
            v6u p; unsigned eb; mx6_pack(hv, p, eb);
            __builtin_nontemporal_store((v4u){p[0], p[1], p[2], p[3]}, (v4u*)(d6 + (size_t)cc * 2048)); __builtin_nontemporal_store((v4u){p[4], p[5], eb, 0u}, (v4u*)(d6 + (size_t)cc * 2048 + 64)); }
        return; }
    u8* d = c.dst + (size_t)(4 * (lane & 7)) * 2048 + 16 * (lane >> 3);
#pragma unroll
    for (int cc = 0; cc < 4; ++cc) { v4u o;
        o.x = pk4_fp8(v[0][cc] * SW8, v[1][cc] * SW8, v[2][cc] * SW8, v[3][cc] * SW8); o.y = pk4_fp8(v[4][cc] * SW8, v[5][cc] * SW8, v[6][cc] * SW8, v[7][cc] * SW8);
        o.z = pk4_fp8(v[8][cc] * SW8, v[9][cc] * SW8, v[10][cc] * SW8, v[11][cc] * SW8); o.w = pk4_fp8(v[12][cc] * SW8, v[13][cc] * SW8, v[14][cc] * SW8, v[15][cc] * SW8);
        __builtin_nontemporal_store(o, (v4u*)(d + (size_t)cc * 2048)); }
}
__device__ __forceinline__ void convert_moe(Frame& F, int gw, int ngw, int lo, int hi) {
    f32x4 va[16], vb[16];
    int it = lo + gw;
    if (it >= hi) return;
    CvItem ca = cv_decode(F, it), cb = ca;
    cv_load(va, ca, F.lane);
    for (;;) {
        const bool hb = it + ngw < hi;
        if (hb) { cb = cv_decode(F, it + ngw); cv_load(vb, cb, F.lane); }
        cv_proc(va, ca, nullptr, F.lane);
        if (!hb) break;
        it += ngw;
        const bool ha = it + ngw < hi;
        if (ha) { ca = cv_decode(F, it + ngw); cv_load(va, ca, F.lane); }
        cv_proc(vb, cb, nullptr, F.lane);
        if (!ha) break;
        it += ngw;
    }
}

#ifdef INPROJ_F6
__device__ __forceinline__ void p0_win6(Frame& F) {
    const int gw = F.vcu * NWAVES + F.wave, NGW = F.G * NWAVES;
    for (int r = gw; r < 4096; r += NGW) {
        const int kb = r >> 8, nb = r & 255, n0 = nb * 32, part = n0 >> 10, cl = n0 & 255;
        const bool prm = (part >= 3 && part <= 5);
        const size_t drow = prm ? (size_t)((n0 & ~255) + 128 * ((cl >> 5) & 1) + 32 * ((cl >> 7) * 2 + ((cl >> 6) & 1))) : (size_t)n0;
        CvItem c; c.src = F.w_in + (size_t)(kb * 128) * 8192 + n0; c.ldw = 8192; c.dst = (u8*)F.WIN + drow * 2048 + kb * 128; c.t6 = 1;
        f32x4 v[16]; cv_load(v, c, F.lane); cv_proc(v, c, nullptr, F.lane);
    }
}
#endif

__device__ __forceinline__ void p1_build_vec(Frame& F, int bb, int sh_off, int sc_off, const float* gain, bool from_partials) {
    LAS float* Av = (LAS float*)(F.lds); LAS float* Bv = Av + D;
    for (int c = F.tid; c < D; c += 512) {
        float sh, sc;
        if (from_partials) { sh = F.b_ada[sh_off + c]; sc = F.b_ada[sc_off + c];
#pragma unroll
            for (int ks = 0; ks < 4; ++ks) { sh += F.MODP[(size_t)(ks * 9 + bb) * (6 * D) + sh_off + c]; sc += F.MODP[(size_t)(ks * 9 + bb) * (6 * D) + sc_off + c]; } }
        else { sh = F.MODF[(size_t)bb * (6 * D) + sh_off + c]; sc = F.MODF[(size_t)bb * (6 * D) + sc_off + c]; }
        Av[c] = gain[c] * (1.f + sc); Bv[c] = sh; }
    __syncthreads();
}
__device__ __forceinline__ void norm_row_bf16(Frame& F, const float* xrow, bf16* orow) {
    const LAS f32x4* Av = (const LAS f32x4*)(F.lds); const LAS f32x4* Bv = Av + D / 4;
    const f32x4* xr = (const f32x4*)xrow + F.lane;
    f32x4 v[8]; float s = 0.f;
#pragma unroll
    for (int j = 0; j < 8; ++j) { v[j] = xr[64 * j]; s += (v[j].x * v[j].x + v[j].y * v[j].y) + (v[j].z * v[j].z + v[j].w * v[j].w); }
    const float rstd = rsqrtf(wave_sum(s) * (1.f / D) + EPS);
    v2u* o8 = (v2u*)orow + F.lane;
#pragma unroll
    for (int j = 0; j < 8; ++j) { const f32x4 a = Av[F.lane + 64 * j], b = Bv[F.lane + 64 * j]; const f32x4 y = v[j] * rstd * a + b;
        v2u o; o.x = pk2(y.x, y.y); o.y = pk2(y.z, y.w); o8[64 * j] = o; }
}
#ifdef INPROJ_F6
__device__ __forceinline__ void norm_row_fp6(Frame& F, const float* xrow, u8* orow) {
    const LAS f32x4* Av = (const LAS f32x4*)(F.lds); const LAS f32x4* Bv = Av + D / 4;
    const f32x4* xr = (const f32x4*)xrow + F.lane;
    f32x4 v[8]; float s = 0.f;
#pragma unroll
    for (int j = 0; j < 8; ++j) { v[j] = xr[64 * j]; s += (v[j].x * v[j].x + v[j].y * v[j].y) + (v[j].z * v[j].z + v[j].w * v[j].w); }
    const float rstd = rsqrtf(wave_sum(s) * (1.f / D) + EPS);
    LAS float* scr = (LAS float*)(F.lds + 16384 + F.wave * 9216);
#pragma unroll
    for (int j = 0; j < 8; ++j) { const f32x4 a = Av[F.lane + 64 * j], b = Bv[F.lane + 64 * j]; const int cix = 4 * (F.lane + 64 * j);
        *(LAS f32x4*)(scr + cix + 4 * (cix >> 5)) = v[j] * rstd * a + b; }
    LDS_WAIT();
    float hv[32];
#pragma unroll
    for (int q = 0; q < 8; ++q) { const f32x4 t = *(const LAS f32x4*)(scr + 36 * F.lane + 4 * q); hv[4 * q] = t.x; hv[4 * q + 1] = t.y; hv[4 * q + 2] = t.z; hv[4 * q + 3] = t.w; }
    v6u p; unsigned eb; mx6_pack(hv, p, eb);
    u8* o = orow + (F.lane >> 2) * 128 + 16 * (F.lane & 3);
    *(v4u*)o = (v4u){p[0], p[1], p[2], p[3]}; *(v4u*)(o + 64) = (v4u){p[4], p[5], eb, 0u};
    LDS_WAIT();
}
#define NORM_ROW_IN(F_, src_, row_) norm_row_fp6(F_, src_, (u8*)(F_).HXN + (size_t)(row_) * 2048)
#else
#define NORM_ROW_IN(F_, src_, row_) norm_row_bf16(F_, src_, (F_).HXN + (size_t)(row_) * D)
#endif
__device__ __forceinline__ void p1_norm(Frame& F) {
    for (int i = F.vcu * 512 + F.tid; i < 9 * 6 * D; i += F.G * 512) { float s = F.b_ada[i % (6 * D)];
#pragma unroll
        for (int ks = 0; ks < 4; ++ks) s += F.MODP[(size_t)ks * 9 * 6 * D + i];
        F.MODF[i] = s; }
    for (int blk = F.vcu; blk < 256; blk += F.G) {
        const int bb = blk >> 5;
        p1_build_vec(F, bb, 0, D, F.norm_mix, true);
        for (int r = F.wave; r < 64; r += NWAVES) { const int row = blk * 64 + r; NORM_ROW_IN(F, F.x + (size_t)row * D, row); }
        __syncthreads();
        p1_build_vec(F, 8, 0, D, F.norm_mix, true);
        { const int row = blk * 8 + F.wave; NORM_ROW_IN(F, F.ctx + (size_t)row * D, T + row); }
        __syncthreads();
    }
}

struct InProjOrder {
    static constexpr bool SPARSE_A = false;
    pg8::StaticOrder so; int G, c;
    __device__ void init(int G_, int c_) { so.init(T, 8192, G_, c_); G = G_; c = c_; }
    __device__ bool next(int i, pg8::Unit& u) const {
        const int L = i * G + c;
        if (L < 2048) return so.next(i, u);
        const int idx = L - 2048; if (idx >= 160) return false;
        const int q = idx % 20; u.pm = 64 + idx / 20; u.pn = q < 8 ? 4 + q : 8 + q; return true;
    }
    __device__ __forceinline__ void a_ready(const pg8::Unit&) const {}
    __device__ __forceinline__ void done(const pg8::Unit&) const {}
};
struct EpiInProj {
    static constexpr bool PERM = true, AFTER_DRAIN = false;
    bf16* PX; const float* lbt;
    __device__ __forceinline__ void operator()(const f32x4 (&acc)[2][2][4][2], const pg8::Unit& u, int wr, int wc, int fr, int fq) const {
        const int row0 = u.pm * 256 + wr * 64 + fr, part = u.pn >> 2;
        if (part >= 3 && part <= 5) {
            const int axis = wc & 1, cbase = u.pn * 256 + (wc >> 1) * 128 + axis * 64 + 8 * fq;
            const int hh = (u.pn & 3) * 2 + (wc >> 1), cc0 = axis * 64 + 8 * fq, sk = (part == 3) ? SQH : (part == 4 ? SKF : SKB), sg = (part == 4) ? SGF : SGB;
            const bool lat = u.pm < 64, gate = part != 3;
            float invf[8], lb1[8], lb2[8];
#pragma unroll
            for (int i = 0; i < 8; ++i) { invf[i] = __expf(-(float)(8 * fq + i) * 0.28782313662425574f); lb1[i] = 0.f; lb2[i] = 0.f; }
            if (gate) {
#pragma unroll
                for (int i = 0; i < 8; ++i) { const int c1 = cbase + i - 4096; lb1[i] = rcp_f(1.f + __expf(lbt[2048 + c1] - lbt[c1])); lb2[i] = rcp_f(1.f + __expf(lbt[2048 + c1 + 32] - lbt[c1 + 32])); } }
#pragma unroll
            for (int ai = 0; ai < 2; ++ai) {
                const float prow = (float)(((u.pm * 256 + ai * 128 + wr * 64) & 2047) >> 6);
#pragma unroll
                for (int m = 0; m < 4; ++m) {
                    const float pos = axis ? (float)(16 * m + fr) : prow;
                    const int row = row0 + ai * 128 + m * 16; bf16* rowp = PX + hm_row(sk, row, hh) + cc0; bf16* rowg = PX + hm_row(sg, row, hh) + cc0;
                    float x1[8], x2[8];
#pragma unroll
                    for (int i = 0; i < 8; ++i) { x1[i] = acc[ai][0][m][i >> 2][i & 3]; x2[i] = acc[ai][1][m][i >> 2][i & 3]; }
                    if (gate) {
                        float g1[8], g2[8];
#pragma unroll
                        for (int i = 0; i < 8; ++i) {
                            const float xa = fminf(fmaxf(x1[i], -30.f), 30.f), xb = fminf(fmaxf(x2[i], -30.f), 30.f);
                            const float sa = rcp_f(1.f + __expf(-xa)), sb = rcp_f(1.f + __expf(-xb));
                            g1[i] = __log2f(lb1[i] + (1.f - lb1[i]) * sa); g2[i] = __log2f(lb2[i] + (1.f - lb2[i]) * sb);
                            x1[i] = (1.f - lb1[i]) * (1.f - sa); x2[i] = (1.f - lb2[i]) * (1.f - sb); }
                        v4u w; w.x = pk2(g1[0], g1[1]); w.y = pk2(g1[2], g1[3]); w.z = pk2(g1[4], g1[5]); w.w = pk2(g1[6], g1[7]); *(v4u*)(rowg) = w;
                        w.x = pk2(g2[0], g2[1]); w.y = pk2(g2[2], g2[3]); w.z = pk2(g2[4], g2[5]); w.w = pk2(g2[6], g2[7]); *(v4u*)(rowg + 32) = w;
                    }
                    if (lat) {
#pragma unroll
                        for (int i = 0; i < 8; ++i) { const float a = pos * invf[i], cs = __cosf(a), sn = __sinf(a); const float o1 = x1[i] * cs - x2[i] * sn, o2 = x2[i] * cs + x1[i] * sn; x1[i] = o1; x2[i] = o2; } }
                    v4u w; w.x = pk2(x1[0], x1[1]); w.y = pk2(x1[2], x1[3]); w.z = pk2(x1[4], x1[5]); w.w = pk2(x1[6], x1[7]); *(v4u*)(rowp) = w;
                    w.x = pk2(x2[0], x2[1]); w.y = pk2(x2[2], x2[3]); w.z = pk2(x2[4], x2[5]); w.w = pk2(x2[6], x2[7]); *(v4u*)(rowp + 32) = w;
                    __builtin_amdgcn_sched_barrier(0);
                }
            }
        } else {
            const float sc = (part == 0) ? 0.08838834764831845f : 1.f;
            const int strm = (part == 6) ? SIH : part, cp = (u.pn & 3) * 256 + wc * 32 + 8 * fq;
#pragma unroll
            for (int ai = 0; ai < 2; ++ai)
#pragma unroll
                for (int m = 0; m < 4; ++m) { const int row = row0 + ai * 128 + m * 16;
#pragma unroll
                    for (int bj = 0; bj < 2; ++bj) { const f32x4 v0 = acc[ai][bj][m][0] * sc, v1 = acc[ai][bj][m][1] * sc;
                        v4u w; w.x = pk2(v0[0], v0[1]); w.y = pk2(v0[2], v0[3]); w.z = pk2(v1[0], v1[1]); w.w = pk2(v1[2], v1[3]);
                        const int cq = cp + bj * 128;
                        bf16* dst = (part == 7) ? PX + HM_GATE0 + (size_t)row * MIXG + cq : PX + hm_row(strm, row, cq >> 7) + (cq & 127);
                        *(v4u*)dst = w; } __builtin_amdgcn_sched_barrier(0); }
        }
    }
};

#define LDS_BAR() do { asm volatile("s_waitcnt lgkmcnt(0)" ::: "memory"); __builtin_amdgcn_s_barrier(); asm volatile("" ::: "memory"); } while (0)
#define MFMA16(a, b, c) __builtin_amdgcn_mfma_f32_16x16x32_bf16((a), (b), (c), 0, 0, 0)
struct GlaRegs { unsigned pq[8], pk[8], pg[8]; v4u pv[2]; };
__device__ __forceinline__ void gla_load(Frame& F, GlaRegs& R, int n, int b, int h, int dir) {
    const int lat = n >= 4, s0 = lat ? 64 * (n - 4) : 64 * n, sk = dir ? SKB : SKF, sg = dir ? SGB : SGF;
    const bf16* bq = F.PX + hm_lat(SQH, b, h) + 2 * F.lane;
    const bf16* bk = F.PX + (lat ? hm_lat(sk, b, h) : hm_ctx(sk, b, h)) + 2 * F.lane;
    const bf16* bg = F.PX + (lat ? hm_lat(sg, b, h) : hm_ctx(sg, b, h)) + 2 * F.lane;
    const bf16* bv = F.PX + (lat ? hm_lat(SIH, b, h) : hm_ctx(SIH, b, h));
#pragma unroll
    for (int i = 0; i < 8; ++i) { const int s = s0 + 8 * F.wave + i; const int tok = lat ? (dir ? 2047 - s : s) : (dir ? 255 - s : s);
        R.pq[i] = lat ? *(const unsigned*)(bq + (size_t)tok * HD) : 0u; R.pk[i] = *(const unsigned*)(bk + (size_t)tok * HD); R.pg[i] = *(const unsigned*)(bg + (size_t)tok * HD); }
#pragma unroll
    for (int j = 0; j < 2; ++j) { const int p = F.tid + 512 * j, Rr = p >> 4, ch = p & 15, s = s0 + Rr; const int tok = lat ? (dir ? 2047 - s : s) : (dir ? 255 - s : s);
        R.pv[j] = *(const v4u*)(bv + (size_t)tok * HD + ch * 8); }
}
__device__ __forceinline__ void gla_chunk(Frame& F, GlaRegs& R, f32x4 (&S)[8], int n, int b, int h, int dir, bf16* OUT) {
    const int lane = F.lane, wave = F.wave, tid = F.tid, kq = lane >> 4, fr = lane & 15;
    LAS unsigned char* L = F.lds;
    constexpr int PIT = 272;
    constexpr int O_QE = 0, O_QD = 17408, O_KD = 34816, O_V = 52224, O_KEX = 69632, O_ATT = 113152, O_SUB = 122368, O_DECL = 126464;
    const bool lat = n >= 4;
    const int s0 = lat ? 64 * (n - 4) : 64 * n;
#pragma unroll
    for (int j = 0; j < 2; ++j) { const int p = tid + 512 * j, Rr = p >> 4, ch = p & 15; *(LAS v4u*)(L + O_V + Rr * PIT + ch * 16) = R.pv[j]; }
    float qa[8], qb[8], ka[8], kb[8], ca[8], cb[8];
    float ra = 0.f, rb = 0.f;
#pragma unroll
    for (int i = 0; i < 8; ++i) { qa[i] = bflo(R.pq[i]); qb[i] = bfhi(R.pq[i]); ka[i] = bflo(R.pk[i]); kb[i] = bfhi(R.pk[i]); ra += bflo(R.pg[i]); rb += bfhi(R.pg[i]); ca[i] = ra; cb[i] = rb; }
    *(LAS f32x2*)(L + O_SUB + (wave * 128 + 2 * lane) * 4) = (f32x2){ra, rb};
    if (n + 2 < 36) gla_load(F, R, n + 2, b, h, dir);
    LDS_BAR();
    {
        float refa[4], refb[4], pa = 0.f, pb = 0.f, ta = 0.f, tb = 0.f;
#pragma unroll
        for (int w = 0; w < 8; ++w) { const f32x2 sv = *(const LAS f32x2*)(L + O_SUB + (w * 128 + 2 * lane) * 4);
            if ((w & 1) == 0) { refa[w >> 1] = ta; refb[w >> 1] = tb; }
            if (w < wave) { pa += sv.x; pb += sv.y; }
            ta += sv.x; tb += sv.y; }
        const int I = wave >> 1;
        float rIa = refa[0], rIb = refb[0];
#pragma unroll
        for (int q = 1; q < 4; ++q) if (I == q) { rIa = refa[q]; rIb = refb[q]; }
        const float eRa = __builtin_amdgcn_exp2f(rIa), eRb = __builtin_amdgcn_exp2f(rIb), eTa = __builtin_amdgcn_exp2f(ta - rIa), eTb = __builtin_amdgcn_exp2f(tb - rIb);
        float Rqa[4], Rqb[4];
#pragma unroll
        for (int q = 0; q < 4; ++q) { Rqa[q] = __builtin_amdgcn_exp2f(refa[q] - rIa); Rqb[q] = __builtin_amdgcn_exp2f(refb[q] - rIb); }
        const float da0 = pa - rIa, db0 = pb - rIb;
#pragma unroll
        for (int i = 0; i < 8; ++i) {
            const int Rr = 8 * wave + i;
            const float ea = __builtin_amdgcn_exp2f(da0 + ca[i]), eb = __builtin_amdgcn_exp2f(db0 + cb[i]);
            const float kra = ka[i] * __builtin_amdgcn_rcpf(ea), krb = kb[i] * __builtin_amdgcn_rcpf(eb);
            *(LAS unsigned*)(L + O_KD + Rr * PIT + 4 * lane) = pk2(kra * eTa, krb * eTb);
            if (lat) {
                const float qea = qa[i] * ea, qeb = qb[i] * eb;
                *(LAS unsigned*)(L + O_QE + Rr * PIT + 4 * lane) = pk2(qea, qeb);
                *(LAS unsigned*)(L + O_QD + Rr * PIT + 4 * lane) = pk2(qea * eRa, qeb * eRb);
#pragma unroll
                for (int Ip = 0; Ip < 4; ++Ip) if (Ip >= I) {
                    const int row = 16 * (Ip * (Ip + 1) / 2 + I) + (Rr & 15);
                    *(LAS unsigned*)(L + O_KEX + row * PIT + 4 * lane) = pk2(kra * Rqa[Ip], krb * Rqb[Ip]); }
            }
        }
        if (wave == 0) *(LAS f32x2*)(L + O_DECL + 8 * lane) = (f32x2){__builtin_amdgcn_exp2f(ta), __builtin_amdgcn_exp2f(tb)};
    }
    LDS_BAR();
    if (lat) {
        for (int tt = wave; tt < 10; tt += 8) {
            const int I = (tt >= 6) ? 3 : (tt >= 3) ? 2 : (tt >= 1) ? 1 : 0, J = tt - I * (I + 1) / 2;
            f32x4 X = (f32x4){0.f, 0.f, 0.f, 0.f};
#pragma unroll
            for (int ks = 0; ks < 4; ++ks) {
                const bf16x8 a = *(const LAS bf16x8*)(L + O_KEX + (16 * tt + fr) * PIT + ks * 64 + kq * 16);
                const bf16x8 bq = *(const LAS bf16x8*)(L + O_QE + (16 * I + fr) * PIT + ks * 64 + kq * 16);
                X = MFMA16(a, bq, X); }
            if (J == I) {
#pragma unroll
                for (int r = 0; r < 4; ++r) if (4 * kq + r > fr) X[r] = 0.f; }
            v2u o; o.x = pk2(X[0], X[1]); o.y = pk2(X[2], X[3]);
            *(LAS v2u*)(L + O_ATT + (16 * I + fr) * 144 + (16 * J + 4 * kq) * 2) = o;
        }
    }
    LDS_BAR();
    {
        const int q4 = fr >> 2, pp = fr & 3;
        bf16x8 Vf[2];
#pragma unroll
        for (int p = 0; p < 2; ++p) { const LAS unsigned char* vb = L + O_V + (32 * p + 8 * kq + q4) * PIT + (16 * wave + 4 * pp) * 2;
            Vf[p] = cat8(tr_read(vb), tr_read(vb + 4 * PIT)); }
        if (lat) {
            bf16x8 Sb[4];
#pragma unroll
            for (int ks = 0; ks < 4; ++ks) Sb[ks] = mk8(pk2(S[2 * ks][0], S[2 * ks][1]), pk2(S[2 * ks][2], S[2 * ks][3]), pk2(S[2 * ks + 1][0], S[2 * ks + 1][1]), pk2(S[2 * ks + 1][2], S[2 * ks + 1][3]));
#pragma unroll
            for (int I = 0; I < 4; ++I) {
                f32x4 o = (f32x4){0.f, 0.f, 0.f, 0.f};
#pragma unroll
                for (int p = 0; p < 2; ++p) if (p <= (I >> 1)) { const bf16x8 a = *(const LAS bf16x8*)(L + O_ATT + (16 * I + fr) * 144 + p * 64 + kq * 16); o = MFMA16(a, Vf[p], o); }
#pragma unroll
                for (int ks = 0; ks < 4; ++ks) { const LAS unsigned char* qp = L + O_QD + (16 * I + fr) * PIT + (32 * ks + 4 * kq) * 2;
                    const v2u lo = *(const LAS v2u*)qp, hi = *(const LAS v2u*)(qp + 32);
                    o = MFMA16(mk8(lo.x, lo.y, hi.x, hi.y), Sb[ks], o); }
#pragma unroll
                for (int j = 0; j < 2; ++j) {
                    const bool oddl = fr & 1;
                    const float snd = oddl ? o[j] : o[2 + j], own = oddl ? o[2 + j] : o[j];
                    const float rcv = __int_as_float(__builtin_amdgcn_mov_dpp(__float_as_int(snd), 0xB1, 0xf, 0xf, true));
                    const int s = s0 + 16 * I + 4 * kq + (oddl ? 2 : 0) + j, tok = dir ? 2047 - s : s;
                    *(unsigned*)(OUT + (size_t)(b * SEQ + tok) * MIXG + h * HD + 16 * wave + (fr & ~1)) = oddl ? pk2(rcv, own) : pk2(own, rcv); }
            }
        }
#pragma unroll
        for (int dkb = 0; dkb < 8; ++dkb) {
            const f32x4 dec = *(const LAS f32x4*)(L + O_DECL + (16 * dkb + 4 * kq) * 4);
            f32x4 s = S[dkb] * dec;
#pragma unroll
            for (int p = 0; p < 2; ++p) { const LAS unsigned char* kb_ = L + O_KD + (32 * p + 8 * kq + q4) * PIT + (16 * dkb + 4 * pp) * 2;
                s = MFMA16(cat8(tr_read(kb_), tr_read(kb_ + 4 * PIT)), Vf[p], s); }
            S[dkb] = s;
        }
    }
    LDS_BAR();
}
__device__ __forceinline__ void gla_chain(Frame& F, int chain) {
    const int b = chain >> 4, h = (chain >> 1) & 7, dir = chain & 1;
    for (int i = F.tid; i < 9216 / 4; i += 512) ((LAS unsigned*)(F.lds + 113152))[i] = 0u;
    f32x4 S[8];
#pragma unroll
    for (int i = 0; i < 8; ++i) S[i] = (f32x4){0.f, 0.f, 0.f, 0.f};
    bf16* OUT = dir ? F.OB : F.OF;
    GlaRegs R0, R1;
    gla_load(F, R0, 0, b, h, dir); gla_load(F, R1, 1, b, h, dir);
    for (int n = 0; n < 36; n += 2) { gla_chunk(F, R0, S, n, b, h, dir, OUT); gla_chunk(F, R1, S, n + 1, b, h, dir, OUT); }
}

__device__ __forceinline__ void attn_run(Frame& F, int ubase, int ustride, int ucnt) {
    const int lane = F.lane, wave = F.wave, tid = F.tid, kq = lane >> 4, fr = lane & 15, j = wave & 3, role = wave >> 2;
    LAS unsigned char* L = F.lds;
    constexpr int PIT = 272;
    constexpr int PITV = 288;
    constexpr int O_KW = 0, O_VW = 34816, O_KC = 71680, O_VC = 89088, O_RPB = 107520, O_MG = 0;
    const int kc0 = min(max(16 * j - 8, 0), 32), qcol = 16 * j + fr, cs = min(max(qcol - 8, 0), 48);
    const int q4 = fr >> 2, pp = fr & 3;
    unsigned inmask = 0u; const int dbase = kc0 + 4 * kq - qcol + 15;
#pragma unroll
    for (int e = 0; e < 8; ++e) { const int kc = kc0 + 16 * (e >> 2) + 4 * kq + (e & 3); inmask |= ((kc >= cs) && (kc < cs + 16)) ? (1u << e) : 0u; }
    v4u st[1][8], sc4[4];
    const unsigned tb = (unsigned)(((tid >> 4) * HD + (tid & 15) * 8) * 2);
#define ATT_LD16(basep_) (*(const v4u*)((const char*)(basep_) + tb))
#define ATT_LOAD(set_, u_, s_) do { const int b_ = (u_) >> 8, h_ = ((u_) >> 5) & 7, r_ = (u_) & 31, k0_ = min(max(r_ - 4, 0), 24); \
        const bf16* kb_ = F.PX + hm_lat(SKN, b_, h_) + (size_t)((k0_ + 2 * (s_)) * 64) * HD; const bf16* vb_ = F.PX + hm_lat(SVN, b_, h_) + (size_t)((k0_ + 2 * (s_)) * 64) * HD; \
        _Pragma("unroll") for (int m = 0; m < 4; ++m) { st[set_][m] = ATT_LD16(kb_ + 32 * m * HD); st[set_][4 + m] = ATT_LD16(vb_ + 32 * m * HD); } } while (0)
#define ATT_LOADC(u_, s_) do { const int b_ = (u_) >> 8, h_ = ((u_) >> 5) & 7; \
        const bf16* kc_ = F.PX + hm_ctx(SKN, b_, h_) + (size_t)(64 * (s_)) * HD; const bf16* vc_ = F.PX + hm_ctx(SVN, b_, h_) + (size_t)(64 * (s_)) * HD; \
        _Pragma("unroll") for (int m = 0; m < 2; ++m) { sc4[m] = ATT_LD16(kc_ + 32 * m * HD); sc4[2 + m] = ATT_LD16(vc_ + 32 * m * HD); } } while (0)
#define ATT_QLOAD(dst_, u_) do { const int b_ = (u_) >> 8, h_ = ((u_) >> 5) & 7, r_ = (u_) & 31; const bf16* qp = F.PX + hm_lat(SQN, b_, h_) + (size_t)(r_ * 64 + qcol) * HD + 8 * kq; \
        _Pragma("unroll") for (int ks = 0; ks < 4; ++ks) dst_[ks] = *(const bf16x8*)(qp + 32 * ks); } while (0)
    if (ucnt <= 0) return;
    const int u0 = ubase;
    ATT_LOAD(0, u0, 0); ATT_LOADC(u0, 0);
    bf16x8 qf[4];
    ATT_QLOAD(qf, u0);
    int hcur = -1;
    for (int ui = 0; ui < ucnt; ++ui) {
        const int u = ubase + ui * ustride, un = u + ustride; const bool more = ui + 1 < ucnt;
        const int b = u >> 8, h = (u >> 5) & 7, r = u & 31, kr0 = min(max(r - 4, 0), 24);
        if (h != hcur) { LDS_BAR(); for (int i = tid; i < 465; i += 512) ((LAS float*)(L + O_RPB))[i] = F.rpb[h * 465 + i]; hcur = h; }
        f32x4 O[8];
#pragma unroll
        for (int i = 0; i < 8; ++i) O[i] = (f32x4){0.f, 0.f, 0.f, 0.f};
        float mrun = -1e30f, lrun = 0.f;
#pragma unroll
        for (int s = 0; s < 4; ++s) {
            LDS_BAR();
#pragma unroll
            for (int m = 0; m < 8; ++m) { const int p = tid + 512 * (m & 3), R = p >> 4, ch = p & 15; *(LAS v4u*)(L + ((m < 4) ? O_KW + R * PIT : O_VW + R * PITV) + ch * 16) = st[0][m]; }
#pragma unroll
            for (int m = 0; m < 4; ++m) { const int p = tid + 512 * (m & 1), R = p >> 4, ch = p & 15; *(LAS v4u*)(L + ((m < 2) ? O_KC + R * PIT : O_VC + R * PITV) + ch * 16) = sc4[m]; }
            if (s < 3) ATT_LOAD(0, u, s + 1); else if (more) ATT_LOAD(0, un, 0);
            if (s < 3) ATT_LOADC(u, s + 1); else if (more) ATT_LOADC(un, 0);
            LDS_BAR();
            const LAS unsigned char* Kt = L + (role ? O_KC : O_KW);
            const LAS unsigned char* Vt = L + (role ? O_VC : O_VW);
            const int kb0 = role ? 0 : kc0, kb1 = role ? 32 : 64 + kc0;
            f32x4 sc[2][2];
#pragma unroll
            for (int g = 0; g < 2; ++g)
#pragma unroll
                for (int cb = 0; cb < 2; ++cb) { f32x4 a = (f32x4){0.f, 0.f, 0.f, 0.f};
#pragma unroll
                    for (int ks = 0; ks < 4; ++ks) a = MFMA16(*(const LAS bf16x8*)(Kt + ((g ? kb1 : kb0) + 16 * cb + fr) * PIT + ks * 64 + kq * 16), qf[ks], a);
                    sc[g][cb] = a; }
            if (s == 3 && more) { asm volatile("" ::: "memory"); ATT_QLOAD(qf, un); }
            if (role == 0) {
#pragma unroll
                for (int g = 0; g < 2; ++g) { const int drow = (kr0 + 2 * s + g) - r + 7; float bias[8];
#pragma unroll
                    for (int e = 0; e < 8; ++e) bias[e] = ((const LAS float*)(L + O_RPB))[drow * 31 + min(max(dbase + 16 * (e >> 2) + (e & 3), 0), 30)];
#pragma unroll
                    for (int e = 0; e < 8; ++e) { asm volatile("" : "+v"(bias[e])); const float v = sc[g][e >> 2][e & 3] + bias[e]; sc[g][e >> 2][e & 3] = ((inmask >> e) & 1u) ? v : -1e30f; } }
            }
            float mx = -1e30f;
#pragma unroll
            for (int g = 0; g < 2; ++g)
#pragma unroll
                for (int e = 0; e < 8; ++e) mx = fmaxf(mx, sc[g][e >> 2][e & 3]);
            mx = fmaxf(mx, __shfl_xor(mx, 16)); mx = fmaxf(mx, __shfl_xor(mx, 32));
            const float mnew = (mx > mrun + 6.f) ? mx : mrun, alpha = __expf(mrun - mnew);
            const bool resc = __any(mnew != mrun);
            float p[2][8], ps = 0.f;
#pragma unroll
            for (int g = 0; g < 2; ++g)
#pragma unroll
                for (int e = 0; e < 8; ++e) { p[g][e] = __expf(sc[g][e >> 2][e & 3] - mnew); ps += p[g][e]; }
            lrun = lrun * alpha + ps; mrun = mnew;
            bf16x8 pf[2];
#pragma unroll
            for (int g = 0; g < 2; ++g) pf[g] = mk8(pk2(p[g][0], p[g][1]), pk2(p[g][2], p[g][3]), pk2(p[g][4], p[g][5]), pk2(p[g][6], p[g][7]));
            if (resc) {
#pragma unroll
                for (int dvb = 0; dvb < 8; ++dvb) O[dvb] = O[dvb] * alpha; }
#pragma unroll
            for (int dvb = 0; dvb < 8; ++dvb) { f32x4 o = O[dvb];
#pragma unroll
                for (int g = 0; g < 2; ++g) { const LAS unsigned char* vb = Vt + ((g ? kb1 : kb0) + 4 * kq + q4) * PITV + (16 * dvb + 4 * pp) * 2;
                    o = MFMA16(cat8(tr_read(vb), tr_read(vb + 16 * PITV)), pf[g], o); }
                O[dvb] = o; }
        }
        lrun += __shfl_xor(lrun, 16); lrun += __shfl_xor(lrun, 32);
        LDS_BAR();
        if (role == 1) {
            LAS float* mg = (LAS float*)(L + O_MG + j * 8704);
#pragma unroll
            for (int dvb = 0; dvb < 8; ++dvb)
#pragma unroll
                for (int q = 0; q < 4; ++q) mg[(dvb * 4 + q) * 64 + lane] = O[dvb][q];
            mg[2048 + lane] = mrun; mg[2048 + 64 + lane] = lrun;
        }
        LDS_BAR();
        if (role == 0) {
            const LAS float* mg = (const LAS float*)(L + O_MG + j * 8704);
            const float m2 = mg[2048 + lane], l2 = mg[2048 + 64 + lane];
            const float m = fmaxf(mrun, m2), a1 = __expf(mrun - m), a2 = __expf(m2 - m), inv = rcp_f(lrun * a1 + l2 * a2);
            u8* op = (u8*)F.A2 + (size_t)(b * SEQ + r * 64 + qcol) * D + h * HD + 4 * kq;
#pragma unroll
            for (int dvb = 0; dvb < 8; ++dvb) { float o[4];
#pragma unroll
                for (int q = 0; q < 4; ++q) o[q] = (O[dvb][q] * a1 + mg[(dvb * 4 + q) * 64 + lane] * a2) * inv;
                *(unsigned*)(op + 16 * dvb) = pk4_fp8(o[0] * SA8, o[1] * SA8, o[2] * SA8, o[3] * SA8); }
        }
    }
#undef ATT_LOAD
#undef ATT_LOADC
#undef ATT_LD16
#undef ATT_QLOAD
}
__device__ __forceinline__ void p3_mixer(Frame& F) {
    for (int ch = (int)blockIdx.x; ch < 128; ch += F.G) { gla_chain(F, ch); }
    for (;;) {
        __syncthreads();
        if (F.tid == 0) F.MISC[0] = __hip_atomic_fetch_add((unsigned*)(F.ctl + CW_ATTQ), 1u, RLX_AGENT);
        __syncthreads();
        const int c = (int)F.MISC[0];
        if (c >= NB * HEADS * 32 / 4) break;
        attn_run(F, 4 * c, 1, 4);
    }
}

__device__ __forceinline__ void p4_hg_out(Frame& F) {
    const int gw = F.vcu * NWAVES + F.wave, NGW = F.G * NWAVES, lane = F.lane;
    for (int t = gw; t < T; t += NGW) {
        const v4u* pf = (const v4u*)(F.OF + (size_t)t * MIXG + 16 * lane); const v4u* pb = (const v4u*)(F.OB + (size_t)t * MIXG + 16 * lane);
        const v4u f0 = pf[0], f1 = pf[1], b0 = pb[0], b1 = pb[1];
        const unsigned fu[8] = {f0.x, f0.y, f0.z, f0.w, f1.x, f1.y, f1.z, f1.w}, bu[8] = {b0.x, b0.y, b0.z, b0.w, b1.x, b1.y, b1.z, b1.w};
        f32x4 o[4]; float ss = 0.f;
#pragma unroll
        for (int i = 0; i < 4; ++i) { o[i] = (f32x4){bflo(fu[2 * i]) + bflo(bu[2 * i]), bfhi(fu[2 * i]) + bfhi(bu[2 * i]), bflo(fu[2 * i + 1]) + bflo(bu[2 * i + 1]), bfhi(fu[2 * i + 1]) + bfhi(bu[2 * i + 1])};
            ss += (o[i].x * o[i].x + o[i].y * o[i].y) + (o[i].z * o[i].z + o[i].w * o[i].w); }
        ss += __shfl_xor(ss, 1); ss += __shfl_xor(ss, 2); ss += __shfl_xor(ss, 4);
        const float rstd = rsqrtf(ss * (1.f / HD) + EPS);
        const v4u* gp = (const v4u*)(F.PX + HM_GATE0 + (size_t)t * MIXG + 16 * lane);
        const v4u g0 = gp[0], g1 = gp[1];
        const unsigned gu[8] = {g0.x, g0.y, g0.z, g0.w, g1.x, g1.y, g1.z, g1.w};
        const f32x4* hp = (const f32x4*)(F.hg_norm + ((16 * lane) & 127));
        unsigned ow[4];
#pragma unroll
        for (int i = 0; i < 4; ++i) { const f32x4 gn = hp[i]; const f32x4 y = o[i] * rstd * gn;
            const float ga = bflo(gu[2 * i]), gb = bfhi(gu[2 * i]), gc = bflo(gu[2 * i + 1]), gd = bfhi(gu[2 * i + 1]);
            ow[i] = pk4_fp8(y.x * silu_f(ga) * SA8, y.y * silu_f(gb) * SA8, y.z * silu_f(gc) * SA8, y.w * silu_f(gd) * SA8); }
        *(v4u*)((u8*)F.A2 + (size_t)t * D + MIXG + 16 * lane) = (v4u){ow[0], ow[1], ow[2], ow[3]};
    }
}

struct EpiOutProj {
    static constexpr bool PERM = true, AFTER_DRAIN = false;
    const float* x; bf16* X1; const float* modf; float ascale;
    __device__ __forceinline__ void operator()(const f32x4 (&acc)[2][2][4][2], const pg8::Unit& u, int wr, int wc, int fr, int fq) const {
        const int row0 = u.pm * 256 + wr * 64 + fr, col0 = u.pn * 256 + wc * 32 + 8 * fq;
        const float* g1 = modf + (size_t)(u.pm >> 3) * (6 * D) + 2 * D;
        f32x4 gv[2][2];
#pragma unroll
        for (int bj = 0; bj < 2; ++bj)
#pragma unroll
            for (int n = 0; n < 2; ++n) gv[bj][n] = *(const f32x4*)(g1 + col0 + bj * 128 + n * 4) * ascale;
#pragma unroll
        for (int ai = 0; ai < 2; ++ai)
#pragma unroll
            for (int m = 0; m < 4; ++m) { const size_t ro = (size_t)(row0 + ai * 128 + m * 16) * D + col0;
#pragma unroll
                for (int bj = 0; bj < 2; ++bj) { const f32x4 x0 = *(const f32x4*)(x + ro + bj * 128), x1 = *(const f32x4*)(x + ro + bj * 128 + 4);
                    const f32x4 v0 = x0 + gv[bj][0] * acc[ai][bj][m][0], v1 = x1 + gv[bj][1] * acc[ai][bj][m][1];
                    v4u w; w.x = pk2(v0[0], v0[1]); w.y = pk2(v0[2], v0[3]); w.z = pk2(v1[0], v1[1]); w.w = pk2(v1[2], v1[3]);
                    *(v4u*)(X1 + ro + bj * 128) = w; } __builtin_amdgcn_sched_barrier(0); }
    }
};

__device__ __forceinline__ void p6_router(Frame& F) {
    const int lane = F.lane, wave = F.wave, tid = F.tid, kq = lane >> 4, fr = lane & 15, g = wave & 3, kh = wave >> 2;
    LAS unsigned char* L = F.lds;
    constexpr int O_SSQ = 16384, O_LG = 16384 + 512, O_HIST = O_LG + 2 * 64 * 33 * 4, O_BASE = O_HIST + 128, O_SLOT = O_BASE + 128;
    for (int blk = F.vcu; blk < 256; blk += F.G) {
        const int bb = blk >> 5;
        p1_build_vec(F, bb, 3 * D, 4 * D, F.norm_ffn, false);
        if (tid < 32) ((LAS unsigned*)(L + O_HIST))[tid] = 0u;
        const int row = blk * 64 + g * 16 + fr;
        const bf16* xr = F.X1 + (size_t)row * D + kh * 1024 + 32 * kq;
        float ss = 0.f;
#pragma unroll 8
        for (int s = 0; s < 32; ++s) { const v4u xw = *(const v4u*)(xr + 128 * (s >> 2) + 8 * (s & 3)); const f32x4 a = (f32x4){bflo(xw.x), bfhi(xw.x), bflo(xw.y), bfhi(xw.y)}, c = (f32x4){bflo(xw.z), bfhi(xw.z), bflo(xw.w), bfhi(xw.w)};
            ss += (a.x * a.x + a.y * a.y) + (a.z * a.z + a.w * a.w) + (c.x * c.x + c.y * c.y) + (c.z * c.z + c.w * c.w); }
        ss += __shfl_xor(ss, 16); ss += __shfl_xor(ss, 32);
        if (kq == 0) ((LAS float*)(L + O_SSQ))[kh * 64 + g * 16 + fr] = ss;
        __syncthreads();
        const float rstd = rsqrtf((((LAS float*)(L + O_SSQ))[g * 16 + fr] + ((LAS float*)(L + O_SSQ))[64 + g * 16 + fr]) * (1.f / D) + EPS);
        f32x4 lg0 = (f32x4){0.f, 0.f, 0.f, 0.f}, lg1 = lg0;
        const LAS float* Av = (const LAS float*)L; const LAS float* Bv = Av + D;
        const bf16* wh = F.WRT + (size_t)fr * D + kh * 1024 + 32 * kq;
        u8* hrow = F.HX2 + (size_t)row * D + kh * 1024 + 16 * kq;
#pragma unroll 1
        for (int s = 0; s < 8; ++s) {
            float hv[32];
#pragma unroll
            for (int j = 0; j < 4; ++j) {
                const int k = kh * 1024 + 128 * s + 32 * kq + 8 * j;
                const v4u xw = *(const v4u*)(xr + 128 * s + 8 * j); const f32x4 a = (f32x4){bflo(xw.x), bfhi(xw.x), bflo(xw.y), bfhi(xw.y)}, c = (f32x4){bflo(xw.z), bfhi(xw.z), bflo(xw.w), bfhi(xw.w)};
                const f32x4 A0 = *(const LAS f32x4*)(Av + k), A1 = *(const LAS f32x4*)(Av + k + 4), B0 = *(const LAS f32x4*)(Bv + k), B1 = *(const LAS f32x4*)(Bv + k + 4);
                const f32x4 h0 = a * rstd * A0 + B0, h1 = c * rstd * A1 + B1;
                hv[8 * j] = h0.x; hv[8 * j + 1] = h0.y; hv[8 * j + 2] = h0.z; hv[8 * j + 3] = h0.w; hv[8 * j + 4] = h1.x; hv[8 * j + 5] = h1.y; hv[8 * j + 6] = h1.z; hv[8 * j + 7] = h1.w;
                const unsigned u0 = pk2(h0.x, h0.y), u1 = pk2(h0.z, h0.w), u2 = pk2(h1.x, h1.y), u3 = pk2(h1.z, h1.w);
                const unsigned l0 = pk2(h0.x - bflo(u0), h0.y - bfhi(u0)), l1 = pk2(h0.z - bflo(u1), h0.w - bfhi(u1)), l2 = pk2(h1.x - bflo(u2), h1.y - bfhi(u2)), l3 = pk2(h1.z - bflo(u3), h1.w - bfhi(u3));
                const bf16x8 hh = mk8(u0, u1, u2, u3), hl = mk8(l0, l1, l2, l3);
                const bf16x8 w0h = *(const bf16x8*)(wh + 128 * s + 8 * j), w1h = *(const bf16x8*)(wh + 16 * D + 128 * s + 8 * j);
                const bf16x8 w0l = *(const bf16x8*)(wh + NE * D + 128 * s + 8 * j), w1l = *(const bf16x8*)(wh + NE * D + 16 * D + 128 * s + 8 * j);
                lg0 = MFMA16(hh, w0h, lg0); lg0 = MFMA16(hh, w0l, lg0); lg0 = MFMA16(hl, w0h, lg0);
                lg1 = MFMA16(hh, w1h, lg1); lg1 = MFMA16(hh, w1l, lg1); lg1 = MFMA16(hl, w1h, lg1);
            }
            v6u p; unsigned eb; mx6_pack(hv, p, eb);
            *(v4u*)(hrow + 128 * s) = (v4u){p[0], p[1], p[2], p[3]}; *(v4u*)(hrow + 128 * s + 64) = (v4u){p[4], p[5], eb, 0u};
        }
        { LAS float* lg = (LAS float*)(L + O_LG) + kh * 64 * 33;
#pragma unroll
          for (int r = 0; r < 4; ++r) { lg[(g * 16 + 4 * kq + r) * 33 + fr] = lg0[r]; lg[(g * 16 + 4 * kq + r) * 33 + 16 + fr] = lg1[r]; } }
        __syncthreads();
        int e4[4] = {0, 0, 0, 0}; int pl4[4] = {0, 0, 0, 0};
        if (tid < 64) {
            LAS float* lg = (LAS float*)(L + O_LG) + tid * 33;
            for (int e = 0; e < 32; ++e) lg[e] = lg[e] + lg[64 * 33 + e] + F.b_router[e];
            float v4[4];
#pragma unroll
            for (int p = 0; p < 4; ++p) { float best = -3.0e38f; int bi = 0;
                for (int e = 0; e < 32; ++e) { const float v = lg[e]; const bool used = (p > 0 && e == e4[0]) || (p > 1 && e == e4[1]) || (p > 2 && e == e4[2]); if (!used && v > best) { best = v; bi = e; } }
                e4[p] = bi; v4[p] = best; }
            const float e1 = __expf(v4[1] - v4[0]), e2 = __expf(v4[2] - v4[0]), e3 = __expf(v4[3] - v4[0]), inv = 1.f / (1.f + e1 + e2 + e3);
            const int t = blk * 64 + tid;
            *(f32x4*)(F.RT_G + (size_t)t * 4) = (f32x4){inv, e1 * inv, e2 * inv, e3 * inv};
            *(int4*)(F.RT_E + (size_t)t * 4) = make_int4(e4[0], e4[1], e4[2], e4[3]);
#pragma unroll
            for (int p = 0; p < 4; ++p) pl4[p] = (int)__hip_atomic_fetch_add((LAS unsigned*)(L + O_HIST) + e4[p], 1u, __ATOMIC_RELAXED, __HIP_MEMORY_SCOPE_WORKGROUP);
        }
        __syncthreads();
        if (tid < 32) { const unsigned c = ((LAS unsigned*)(L + O_HIST))[tid]; ((LAS unsigned*)(L + O_BASE))[tid] = c ? __hip_atomic_fetch_add((unsigned*)(F.ctl + CW_CNT + 64 * tid), c, RLX_AGENT) : 0u; }
        __syncthreads();
        if (tid < 64) { const int t = blk * 64 + tid; const LAS unsigned* base = (const LAS unsigned*)(L + O_BASE);
            const int4 ps = make_int4((int)base[e4[0]] + pl4[0], (int)base[e4[1]] + pl4[1], (int)base[e4[2]] + pl4[2], (int)base[e4[3]] + pl4[3]);
            *(int4*)(F.RT_POS + (size_t)t * 4) = ps;
            LAS int* sl = (LAS int*)(L + O_SLOT) + tid * 4;
            sl[0] = e4[0] * T + ps.x; sl[1] = e4[1] * T + ps.y; sl[2] = e4[2] * T + ps.z; sl[3] = e4[3] * T + ps.w; }
        __syncthreads();
        for (int a0 = wave; a0 < 256; a0 += 4 * NWAVES) {
            v4u rv[4][2];
#pragma unroll
            for (int q = 0; q < 4; ++q) { const int a = a0 + q * NWAVES, t = blk * 64 + (a >> 2); const v4u* src = (const v4u*)(F.HX2 + (size_t)t * D) + lane; rv[q][0] = src[0]; rv[q][1] = src[64]; }
#pragma unroll
            for (int q = 0; q < 4; ++q) { const int a = a0 + q * NWAVES, slot = ((const LAS int*)(L + O_SLOT))[a]; v4u* dst = (v4u*)(F.XG + (size_t)slot * D) + lane; dst[0] = rv[q][0]; dst[64] = rv[q][1]; }
        }
        __syncthreads();
    }
}

__device__ __forceinline__ int moe_tables(Frame& F) {
    LAS unsigned char* tile_e = F.lds + TILE_OFF; LAS int* offt = (LAS int*)(F.lds + OFFT_OFF);
    if (F.tid < 32) { int off = 0, mine = 0;
        for (int e = 0; e < 32; ++e) { const int c = (int)__hip_atomic_load((unsigned*)(F.ctl + CW_CNT + 64 * e), RLX_AGENT); const int nt = (c + 255) >> 8; if (e < F.tid) off += nt; if (e == F.tid) mine = nt; }
        offt[F.tid] = off; for (int t = 0; t < mine; ++t) tile_e[off + t] = (unsigned char)F.tid;
        if (F.tid == 31) offt[32] = off + mine; }
    __syncthreads();
    return offt[32];
}
#ifndef MOE_NB
#define MOE_NB 2
#endif
struct MoeOrder {
    static constexpr bool SPARSE_A = true;
    int nM, nN, nwg, G, c; const LAS unsigned char* tile_e; const LAS int* offt; bool sparse;
    __device__ void init(int nM_, int nN_, int G_, int c_, const LAS unsigned char* te, const LAS int* ot, bool sp) { nM = nM_; nN = nN_; nwg = nM * nN; G = G_; c = c_; tile_e = te; offt = ot; sparse = sp; }
    __device__ bool next(int i, pg8::Unit& u) const {
        const long Lq = (long)i * G + c; if (Lq >= nwg) return false;
        int wgid = (int)Lq; { const int q = nwg / 8, r = nwg % 8, xcd = wgid % 8, off = wgid / 8; wgid = (xcd < r ? xcd * (q + 1) : r * (q + 1) + (xcd - r) * q) + off; }
        const int e = __builtin_amdgcn_readfirstlane((int)tile_e[wgid / nN]);
        const int t0 = __builtin_amdgcn_readfirstlane(offt[e]), nt = __builtin_amdgcn_readfirstlane(offt[e + 1]) - t0, r = wgid - t0 * nN, blk = nt * MOE_NB, q = r / blk, r2 = r - q * blk;
        u.pm = t0 + r2 % nt; u.pn = e * nN + MOE_NB * q + r2 / nt;
        u.pa = sparse ? e * (T / 256) + (u.pm - t0) : u.pm; return true;
    }
    __device__ __forceinline__ void a_ready(const pg8::Unit&) const {}
    __device__ __forceinline__ void done(const pg8::Unit&) const {}
};
struct EpiSwiglu {
    static constexpr bool PERM = true, AFTER_DRAIN = false;
    u8* H; const float* b_gu;
    __device__ __forceinline__ void operator()(const f32x4 (&acc)[2][2][4][2], const pg8::Unit& u, int wr, int wc, int fr, int fq) const {
        const int e = u.pn >> 4, pl = u.pn & 15, row0 = u.pm * 256 + wr * 64 + fr, ccol = pl * 128 + wc * 32 + 8 * fq;
        const float* bg = b_gu + (size_t)e * 4096 + ccol;
        const f32x4 bg0 = *(const f32x4*)bg, bg1 = *(const f32x4*)(bg + 4), bl0 = *(const f32x4*)(bg + 2048), bl1 = *(const f32x4*)(bg + 2052);
#pragma unroll
        for (int ai = 0; ai < 2; ++ai)
#pragma unroll
            for (int m = 0; m < 4; ++m) { float y[8];
#pragma unroll
                for (int i = 0; i < 8; ++i) { const float gl = acc[ai][0][m][i >> 2][i & 3] + ((i < 4) ? bg0[i & 3] : bg1[i & 3]); const float ln = acc[ai][1][m][i >> 2][i & 3] + ((i < 4) ? bl0[i & 3] : bl1[i & 3]);
                    const float xg = fminf(gl, 7.f), xl = fminf(fmaxf(ln, -7.f), 7.f); y[i] = xg * rcp_f(1.f + __builtin_amdgcn_exp2f(-2.4554669595930156f * xg)) * (xl * SH8 + SH8); }
                v2u w; w.x = pk4_fp8_nc(y[0], y[1], y[2], y[3]); w.y = pk4_fp8_nc(y[4], y[5], y[6], y[7]);
                *(v2u*)(H + (size_t)(row0 + ai * 128 + m * 16) * FF + ccol) = w; __builtin_amdgcn_sched_barrier(0); }
    }
};
struct EpiDown {
    static constexpr bool PERM = true, AFTER_DRAIN = false;
    u8* Y; const float* b_down;
    __device__ __forceinline__ void operator()(const f32x4 (&acc)[2][2][4][2], const pg8::Unit& u, int wr, int wc, int fr, int fq) const {
        const int e = u.pn >> 3, pl = u.pn & 7, row0 = u.pm * 256 + wr * 64 + fr, col0 = pl * 256 + wc * 32 + 8 * fq;
        f32x4 bv[2][2];
#pragma unroll
        for (int bj = 0; bj < 2; ++bj)
#pragma unroll
            for (int n = 0; n < 2; ++n) bv[bj][n] = *(const f32x4*)(b_down + (size_t)e * D + col0 + bj * 128 + 4 * n);
#pragma unroll
        for (int ai = 0; ai < 2; ++ai)
#pragma unroll
            for (int m = 0; m < 4; ++m) { u8* rowp = Y + (size_t)(row0 + ai * 128 + m * 16) * D + col0;
#pragma unroll
                for (int bj = 0; bj < 2; ++bj) { const f32x4 v0 = (acc[ai][bj][m][0] * (1.f / (SH8 * SW8)) + bv[bj][0]) * SY8, v1 = (acc[ai][bj][m][1] * (1.f / (SH8 * SW8)) + bv[bj][1]) * SY8;
                    v2u w; w.x = pk4_fp8(v0[0], v0[1], v0[2], v0[3]); w.y = pk4_fp8(v1[0], v1[1], v1[2], v1[3]);
                    *(v2u*)(rowp + bj * 128) = w; } __builtin_amdgcn_sched_barrier(0); }
    }
};
__device__ __forceinline__ void p10_final(Frame& F, float oscale) {
    const int lane = (int)__builtin_amdgcn_mbcnt_hi(~0u, __builtin_amdgcn_mbcnt_lo(~0u, 0u));
    const int gw = F.vcu * NWAVES + F.wave, NGW = F.G * NWAVES;
    (void)moe_tables(F);
    const LAS int* offt = (const LAS int*)(F.lds + OFFT_OFF);
    for (int t = gw; t < T; t += NGW) {
        const int4 ee = *(const int4*)(F.RT_E + (size_t)t * 4), pp = *(const int4*)(F.RT_POS + (size_t)t * 4);
        const int4 sl = make_int4(offt[ee.x] * 256 + pp.x, offt[ee.y] * 256 + pp.y, offt[ee.z] * 256 + pp.z, offt[ee.w] * 256 + pp.w); const f32x4 gt = *(const f32x4*)(F.RT_G + (size_t)t * 4);
        const float* g2 = F.MODF + (size_t)(t >> 11) * (6 * D) + 5 * D;
        const v2u* xr = (const v2u*)(F.X1 + (size_t)t * D) + lane;
        const unsigned* y0 = (const unsigned*)(F.Y + (size_t)sl.x * D) + lane; const unsigned* y1 = (const unsigned*)(F.Y + (size_t)sl.y * D) + lane;
        const unsigned* y2 = (const unsigned*)(F.Y + (size_t)sl.z * D) + lane; const unsigned* y3 = (const unsigned*)(F.Y + (size_t)sl.w * D) + lane;
        const f32x4 gs = gt * (1.f / SY8);
        f32x4 v[8]; float ss = 0.f;
#pragma unroll
        for (int j = 0; j < 8; ++j) { const unsigned a = y0[64 * j], b = y1[64 * j], c = y2[64 * j], d = y3[64 * j];
            const f32x2 al = __builtin_amdgcn_cvt_pk_f32_fp8(a, false), ah = __builtin_amdgcn_cvt_pk_f32_fp8(a, true), bl = __builtin_amdgcn_cvt_pk_f32_fp8(b, false), bh = __builtin_amdgcn_cvt_pk_f32_fp8(b, true);
            const f32x2 cl = __builtin_amdgcn_cvt_pk_f32_fp8(c, false), ch = __builtin_amdgcn_cvt_pk_f32_fp8(c, true), dl = __builtin_amdgcn_cvt_pk_f32_fp8(d, false), dh = __builtin_amdgcn_cvt_pk_f32_fp8(d, true);
            f32x4 m;
            m.x = gs.x * al.x + gs.y * bl.x + gs.z * cl.x + gs.w * dl.x;
            m.y = gs.x * al.y + gs.y * bl.y + gs.z * cl.y + gs.w * dl.y;
            m.z = gs.x * ah.x + gs.y * bh.x + gs.z * ch.x + gs.w * dh.x;
            m.w = gs.x * ah.y + gs.y * bh.y + gs.z * ch.y + gs.w * dh.y;
            const f32x4 gg = *((const f32x4*)g2 + lane + 64 * j);
            const v2u xw = xr[64 * j]; const f32x4 xv = (f32x4){bflo(xw.x), bfhi(xw.x), bflo(xw.y), bfhi(xw.y)};
            v[j] = xv + gg * m; ss += (v[j].x * v[j].x + v[j].y * v[j].y) + (v[j].z * v[j].z + v[j].w * v[j].w); }
        const float rstd = rsqrtf(wave_sum(ss) * (1.f / D) + EPS) * oscale;
        f32x4* op = (f32x4*)(F.out + (size_t)t * D) + lane;
#pragma unroll
        for (int j = 0; j < 8; ++j) op[64 * j] = v[j] * rstd * *((const f32x4*)F.norm_final + lane + 64 * j);
    }
}
#ifdef INPROJ_F6
#define P0_WIN6(F_) p0_win6(F_)
#define INPROJ_MODE 2
#else
#define P0_WIN6(F_) do {} while (0)
#define INPROJ_MODE 0
#endif

struct Args { const float* in[20]; float* out; unsigned char* ws; int ph_lo, ph_hi, li, pad; };
__global__ void __launch_bounds__(NWAVES * 64, 2) mk_fwd(Args args) {
    extern __shared__ __attribute__((aligned(16))) unsigned char lds[];
    Frame F;
    F.lds = (LAS unsigned char*)lds;
    F.MISC = (volatile LAS unsigned*)(F.lds + MISC_OFF);
    F.tid = threadIdx.x; F.lane = F.tid & 63; F.wave = __builtin_amdgcn_readfirstlane(F.tid >> 6);
    F.G = gridDim.x; { const int bx = blockIdx.x; F.vcu = (F.G % 8 == 0) ? (bx % 8) * (F.G / 8) + bx / 8 : bx; }
    unsigned char* ws = args.ws;
    F.ctl = (gu32*)(ws + WS_CTL);
    F.x = args.in[0]; F.c = args.in[1]; F.ctx = args.in[2]; F.c_ctx = args.in[3]; F.w_ada = args.in[4]; F.b_ada = args.in[5]; F.norm_mix = args.in[6]; F.norm_ffn = args.in[7];
    F.w_in = args.in[8]; F.lb_table = args.in[9]; F.hg_norm = args.in[10]; F.rpb = args.in[11]; F.w_out = args.in[12]; F.w_router = args.in[13]; F.b_router = args.in[14];
    F.w_gu = args.in[15]; F.b_gu = args.in[16]; F.w_down = args.in[17]; F.b_down = args.in[18]; F.norm_final = args.in[19]; F.out = args.out;
    F.MODP = (float*)(ws + WS_MODP); F.MODF = (float*)(ws + WS_MODF); F.OF = (bf16*)(ws + WS_OF); F.OB = (bf16*)(ws + WS_OB); F.X1 = (bf16*)(ws + WS_X1);
    F.WRT = (bf16*)(ws + WS_WRT); F.WIN = (bf16*)(ws + WS_WIN); F.WOUT = (bf16*)(ws + WS_WOUT); F.HXN = (bf16*)(ws + WS_HXN); F.PX = (bf16*)(ws + WS_PX); F.A2 = (bf16*)(ws + WS_A2);
    F.HX2 = (u8*)(ws + WS_HX2); F.XG = (u8*)(ws + WS_XG); F.H = (u8*)(ws + WS_H); F.Y = (u8*)(ws + WS_Y); F.WGU = (u8*)(ws + WS_WGU); F.WD = (u8*)(ws + WS_WD);
    F.RT_E = (int*)(ws + WS_RT); F.RT_POS = F.RT_E + T * 4; F.RT_G = (float*)(F.RT_POS + T * 4); F.RT_SLOT = (int*)(F.RT_G + T * 4);
    for (int u = F.tid; u < (LDS_BYTES - LDSCTL_OFF) / 4; u += NWAVES * 64) ((LAS unsigned*)(F.lds + LDSCTL_OFF))[u] = 0u;
    __syncthreads();
    const int NC = (N_LAUNCHES == 1 && F.G >= 256) ? NCONV : 0, NW = F.G - NC;
    const bool conv = (int)blockIdx.x >= NW;
    XcdBarrier barA, barW; barA.bar = (unsigned*)(F.ctl + CW_BAR); barA.x = 0; barA.st = nullptr; barA.total = 0; barW = barA;
    if (N_LAUNCHES == 1) { barA = xcd_barrier_post((unsigned*)(F.ctl + CW_BAR + args.li * 20480), F.MISC + 8, (unsigned)F.G);
        if (!conv) barW = xcd_barrier_post((unsigned*)(F.ctl + CW_BAR2 + args.li * 20480), F.MISC + 10, (unsigned)NW); }
#define GRID_BAR_A() do { if (N_LAUNCHES == 1) xcd_barrier(barA); } while (0)
#define GRID_BAR_W() do { if (N_LAUNCHES == 1) xcd_barrier(barW); } while (0)
#if defined(TPROBE)
    if (blockIdx.x == 0 && F.tid == 0) __hip_atomic_store((unsigned*)(F.ctl + 20000), (unsigned)__builtin_amdgcn_s_memrealtime(), RLX_AGENT);
#define TSTAMP(k) do { if (F.tid == 0) { unsigned t0_; int sp_ = 0; do { t0_ = __hip_atomic_load((unsigned*)(F.ctl + 20000), RLX_AGENT); } while (t0_ == 0u && ++sp_ < 1000000); \
        __hip_atomic_fetch_max((unsigned*)(F.ctl + 20064 + 64 * (k)), (unsigned)__builtin_amdgcn_s_memrealtime() - t0_, RLX_AGENT); } } while (0)
#else
#define TSTAMP(k) do {} while (0)
#endif
    const int lo = args.ph_lo, hi = args.ph_hi;
#define IN(k) (lo <= (k) && (k) < hi)
#define BOTH(k) (IN(k) && IN((k) + 1))
    constexpr int CV_N = NE * 2048 + NE * 1024;
    const int cvA = (NC > 0) ? CVA_PER_WAVE * F.G * NWAVES : 0;
    if (conv && args.ph_lo > 0) {} else
    if (conv) { convert_moe(F, (int)blockIdx.x * NWAVES + F.wave, F.G * NWAVES, 0, cvA); convert_moe(F, ((int)blockIdx.x - NW) * NWAVES + F.wave, NC * NWAVES, cvA, CV_N); TSTAMP(0); }
    else {
        const int Gall = F.G, vall = F.vcu;
        F.G = NW; { const int bx = blockIdx.x; F.vcu = (NW % 8 == 0) ? (bx % 8) * (NW / 8) + bx / 8 : bx; }
        if (IN(0)) { p0_prologue(F, NC == 0); P0_WIN6(F); convert_moe(F, (int)blockIdx.x * NWAVES + F.wave, Gall * NWAVES, 0, cvA); TSTAMP(1); if (BOTH(0)) GRID_BAR_W(); }
        if (IN(1)) { p1_norm(F); TSTAMP(2); if (BOTH(1)) GRID_BAR_W(); }
        if (IN(2)) {
            pg8::Gemm g{F.HXN, F.WIN, MTOT, 8192, D}; InProjOrder S; S.init(F.G, (int)blockIdx.x);
            EpiInProj E{F.PX, F.lb_table};
            pg8::gemm_phase<EpiInProj, InProjOrder, PG8_ALIGN, PG8_SP2, INPROJ_MODE>(F.lds + RING_OFF, g, S, E);
            TSTAMP(3); if (BOTH(2)) GRID_BAR_W();
        }
        if (IN(3)) { p3_mixer(F); TSTAMP(4); if (BOTH(3)) GRID_BAR_W(); }
        if (IN(4)) { p4_hg_out(F); TSTAMP(5); }
        F.G = Gall; F.vcu = vall;
    }
    if (BOTH(4)) GRID_BAR_A();
    if (IN(5)) {
        pg8::Gemm g{F.A2, F.WOUT, T, D, D}; pg8::StaticOrder S; S.init(T, D, F.G, (int)blockIdx.x);
        EpiOutProj E{F.x, F.X1, F.MODF, 1.f / (SA8 * SW8)};
        pg8::gemm_phase<EpiOutProj, pg8::StaticOrder, PG8_ALIGN, PG8_SP2, 1>(F.lds + RING_OFF, g, S, E);
        TSTAMP(6); if (BOTH(5)) GRID_BAR_A();
    }
    if (IN(6)) { p6_router(F); TSTAMP(7); if (BOTH(6)) GRID_BAR_A(); }
    if (IN(8)) {
        const int NT = moe_tables(F);
        pg8::Gemm g{(const bf16*)F.XG, (const bf16*)F.WGU, NE * T, NE * 4096, D}; MoeOrder S; S.init(NT, 16, F.G, (int)blockIdx.x, F.lds + TILE_OFF, (const LAS int*)(F.lds + OFFT_OFF), true);
        EpiSwiglu E{F.H, F.b_gu};
        pg8::gemm_phase<EpiSwiglu, MoeOrder, PG8_ALIGN, PG8_SP2, 2>(F.lds + RING_OFF, g, S, E);
        TSTAMP(9); if (BOTH(8)) GRID_BAR_A();
    }
    if (IN(9)) {
        const int NT = moe_tables(F);
        pg8::Gemm g{(const bf16*)F.H, (const bf16*)F.WD, CAP, NE * 2048, FF}; MoeOrder S; S.init(NT, 8, F.G, (int)blockIdx.x, F.lds + TILE_OFF, (const LAS int*)(F.lds + OFFT_OFF), false);
        EpiDown E{F.Y, F.b_down};
        pg8::gemm_phase<EpiDown, MoeOrder, PG8_ALIGN, PG8_SP2, 1>(F.lds + RING_OFF, g, S, E);
        TSTAMP(10); if (BOTH(9)) GRID_BAR_A();
    }
#if defined(TPROBE)
    if (IN(10)) { const unsigned tk = __hip_atomic_load((unsigned*)(F.ctl + 20064 + 64 * TPROBE), RLX_AGENT); p10_final(F, 1.f + (float)tk * 1e-6f); }
#else
    if (IN(10)) { p10_final(F, 1.f); }
#endif
#undef IN
#undef BOTH
}

extern "C" void kernel_launch(void* const* d_in, const int* in_sizes, int n_in, void* d_out, int out_size, void* d_ws, size_t ws_size, hipStream_t stream) {
    static int grid = 0;
    if (grid == 0) {
        if (n_in != 20 || out_size != T * D || ws_size < WS_END) { fprintf(stderr, "kernel_launch: unexpected shapes (n_in %d out %d ws %zu)\n", n_in, out_size, ws_size); grid = -1; return; }
        int dev = 0, cus = 0, per_cu = 0;
        if (hipGetDevice(&dev) != hipSuccess || hipDeviceGetAttribute(&cus, hipDeviceAttributeMultiprocessorCount, dev) != hipSuccess) { grid = -1; return; }
        if (hipFuncSetAttribute((const void*)mk_fwd, hipFuncAttributeMaxDynamicSharedMemorySize, LDS_BYTES) != hipSuccess) { fprintf(stderr, "kernel_launch: hipFuncSetAttribute failed\n"); grid = -1; return; }
        if (hipOccupancyMaxActiveBlocksPerMultiprocessor(&per_cu, (const void*)mk_fwd, NWAVES * 64, LDS_BYTES) != hipSuccess || per_cu < 1)
            fprintf(stderr, "kernel_launch: occupancy query reports %d workgroups per CU\n", per_cu);
        (void)hipGetLastError();
        grid = cus;
    }
    if (grid < 0) return;
    if (hipMemsetAsync((char*)d_ws + WS_CTL, 0, CTL_ZERO_BYTES, stream) != hipSuccess) return;
    Args a{};
    for (int i = 0; i < 20; ++i) a.in[i] = (const float*)d_in[i];
    a.out = (float*)d_out; a.ws = (unsigned char*)d_ws;
#if defined(PROBE_CUT)
    for (int li = 0; li < 2; ++li) {
        a.ph_lo = li == 0 ? 0 : PROBE_CUT; a.ph_hi = li == 0 ? PROBE_CUT + 1 : NPHASE; a.li = li; a.pad = 0;
        hipLaunchKernelGGL(mk_fwd, dim3(grid), dim3(NWAVES * 64), LDS_BYTES, stream, a);
    }
#else
    for (int li = 0; li < N_LAUNCHES; ++li) {
        a.ph_lo = (N_LAUNCHES == 1) ? 0 : li; a.ph_hi = (N_LAUNCHES == 1) ? NPHASE : li + 1; a.li = li; a.pad = 0;
        hipLaunchKernelGGL(mk_fwd, dim3(grid), dim3(NWAVES * 64), LDS_BYTES, stream, a);
        const hipError_t le = hipPeekAtLastError();
        if (le != hipSuccess) { fprintf(stderr, "kernel_launch: launch %d failed: %s\n", li, hipGetErrorName(le)); break; }
    }
#endif
}
```
